# Optimizing an MI355X kernel written in HIP

```python
import jax
import jax.numpy as jnp
from jax import lax
import numpy as np

D_MODEL = 1024
BATCH = 8
SEQ = 8192
DEPTH = 2

HEAD_DIM = 64
GRID_W = 64
BLOCK = 128
ROPE_THETA = 10000.0
EPS = 1e-6
NEG_INF = -1e30
A_HEADS = 6
A_KV_HEADS = 2
B_HEADS = 6
B_KV_HEADS = 2
WINDOW = 128
C_HEADS = 4
C_Q_LORA = 256
C_KV_LORA = 128
C_NOPE = 64
C_ROPE = 32
C_V = 64
A_WIDTH = A_HEADS * HEAD_DIM
B_WIDTH = B_HEADS * HEAD_DIM
C_WIDTH = C_HEADS * C_V
MIX = A_WIDTH + B_WIDTH + C_WIDTH
A_IN = (A_HEADS + 2 * A_KV_HEADS) * HEAD_DIM
B_IN = (B_HEADS + 2 * B_KV_HEADS) * HEAD_DIM
C_IN = C_Q_LORA + C_KV_LORA + C_ROPE
IN_W = A_IN + B_IN + C_IN
N_EXPERTS = 256
TOP_K = 8
N_GROUPS = 8
TOPK_GROUPS = 4
EXPERT_FF = 256
SHARED_FF = 256
ROUTED_SCALE = 2.5
MOE_BLOCK = 128

kernel_name = 'hybrid_parallel_heads_mla_swa_axial_moe_encoder'


def rms_norm(x, g):
    xf = x.astype(jnp.float32)
    y = xf * lax.rsqrt(jnp.mean(xf * xf, axis=-1, keepdims=True) + EPS)
    return (y * g.astype(jnp.float32)).astype(x.dtype)


def rope_cos_sin(pos, dim):
    inv = ROPE_THETA ** (-jnp.arange(0, dim, 2, dtype=jnp.float32) / dim)
    ang = pos.astype(jnp.float32)[:, None] * inv[None, :]
    return jnp.cos(ang), jnp.sin(ang)


def apply_rope(x, cos, sin):
    half = x.shape[-1] // 2
    shp = (cos.shape[0],) + (1,) * (x.ndim - 3) + (half,)
    cos = cos.reshape(shp).astype(x.dtype)
    sin = sin.reshape(shp).astype(x.dtype)
    x1, x2 = x[..., :half], x[..., half:]
    return jnp.concatenate([x1 * cos - x2 * sin, x1 * sin + x2 * cos], axis=-1)


def axial_rope(x, row_ids, col_ids):
    half = HEAD_DIM // 2
    cr, sr = rope_cos_sin(row_ids, half)
    cc, sc = rope_cos_sin(col_ids, half)
    return jnp.concatenate([apply_rope(x[..., :half], cr, sr), apply_rope(x[..., half:], cc, sc)], axis=-1)


def mixer_a(p, row_ids, col_ids, q_g, k_g):
    bsz, seq, _ = p.shape
    grp = A_HEADS // A_KV_HEADS
    kv_w = A_KV_HEADS * HEAD_DIM
    q = p[..., :A_WIDTH].reshape(bsz, seq, A_KV_HEADS, grp, HEAD_DIM)
    k = p[..., A_WIDTH:A_WIDTH + kv_w].reshape(bsz, seq, A_KV_HEADS, HEAD_DIM)
    v = p[..., A_WIDTH + kv_w:].reshape(bsz, seq, A_KV_HEADS, HEAD_DIM)
    q = axial_rope(rms_norm(q, q_g), row_ids, col_ids)
    k = axial_rope(rms_norm(k, k_g), row_ids, col_ids)
    scale = HEAD_DIM ** -0.5
    nq = seq // BLOCK
    qb = jnp.moveaxis(q.reshape(bsz, nq, BLOCK, A_KV_HEADS, grp, HEAD_DIM), 1, 0)

    def attend(qi):
        s = jnp.einsum('bqhgd,bkhd->bhgqk', qi, k, preferred_element_type=jnp.float32) * scale
        pr = jax.nn.softmax(s, axis=-1).astype(v.dtype)
        return jnp.einsum('bhgqk,bkhd->bqhgd', pr, v)

    o = lax.map(attend, qb)
    return jnp.moveaxis(o, 0, 1).reshape(bsz, seq, A_WIDTH)


def mixer_b(p, sink):
    bsz, seq, _ = p.shape
    grp = B_HEADS // B_KV_HEADS
    kv_w = B_KV_HEADS * HEAD_DIM
    nb = seq // BLOCK
    q = p[..., :B_WIDTH].reshape(bsz, nb, BLOCK, B_KV_HEADS, grp, HEAD_DIM)
    k = p[..., B_WIDTH:B_WIDTH + kv_w].reshape(bsz, seq, B_KV_HEADS, HEAD_DIM)
    v = p[..., B_WIDTH + kv_w:].reshape(bsz, seq, B_KV_HEADS, HEAD_DIM)

    def band(t):
        tp = jnp.pad(t, ((0, 0), (BLOCK, BLOCK), (0, 0), (0, 0))).reshape(bsz, nb + 2, BLOCK, B_KV_HEADS, HEAD_DIM)
        return jnp.concatenate([tp[:, :-2], tp[:, 1:-1], tp[:, 2:]], axis=2)

    kw, vw = band(k), band(v)
    s = jnp.einsum('bnqhgd,bnkhd->bnhgqk', q, kw, preferred_element_type=jnp.float32) * HEAD_DIM ** -0.5
    rel = jnp.arange(3 * BLOCK)[None, :] - BLOCK - jnp.arange(BLOCK)[:, None]
    dist = jnp.abs(rel).astype(jnp.float32)
    key_pos = jnp.arange(nb)[:, None] * BLOCK - BLOCK + jnp.arange(3 * BLOCK)[None, :]
    in_range = (key_pos >= 0) & (key_pos < seq)
    valid = (jnp.abs(rel) <= WINDOW)[None, :, :] & in_range[:, None, :]
    slopes = jnp.exp2(-8.0 * jnp.arange(1, B_HEADS + 1, dtype=jnp.float32) / B_HEADS).reshape(B_KV_HEADS, grp)
    s = s - slopes[:, :, None, None] * dist
    s = jnp.where(valid[None, :, None, None], s, NEG_INF)
    sk = sink.astype(jnp.float32).reshape(B_KV_HEADS, grp)[None, None, :, :, None, None]
    m = jnp.maximum(jnp.max(s, axis=-1, keepdims=True), sk)
    e = jnp.exp(s - m)
    pr = (e / (jnp.sum(e, axis=-1, keepdims=True) + jnp.exp(sk - m))).astype(vw.dtype)
    o = jnp.einsum('bnhgqk,bnkhd->bnqhgd', pr, vw)
    return o.reshape(bsz, seq, B_WIDTH)


def mixer_c(p, pos, qn_g, kvn_g, w_uq, w_uk, w_uv):
    bsz, seq, _ = p.shape
    cq = rms_norm(p[..., :C_Q_LORA], qn_g)
    ckv = rms_norm(p[..., C_Q_LORA:C_Q_LORA + C_KV_LORA], kvn_g)
    kr = p[..., C_Q_LORA + C_KV_LORA:]
    q = jnp.einsum('bsr,re->bse', cq, w_uq).reshape(bsz, seq, C_HEADS, C_NOPE + C_ROPE)
    k_nope = jnp.einsum('bsr,re->bse', ckv, w_uk).reshape(bsz, seq, C_HEADS, C_NOPE)
    v = jnp.einsum('bsr,re->bse', ckv, w_uv).reshape(bsz, seq, C_HEADS, C_V)
    cos, sin = rope_cos_sin(pos, C_ROPE)
    q_nope = q[..., :C_NOPE]
    q_rope = apply_rope(q[..., C_NOPE:], cos, sin)
    k_rope = apply_rope(kr, cos, sin)
    scale = (C_NOPE + C_ROPE) ** -0.5
    nq = seq // BLOCK
    qnb = jnp.moveaxis(q_nope.reshape(bsz, nq, BLOCK, C_HEADS, C_NOPE), 1, 0)
    qrb = jnp.moveaxis(q_rope.reshape(bsz, nq, BLOCK, C_HEADS, C_ROPE), 1, 0)

    def attend(blk):
        qn, qr = blk
        s = (jnp.einsum('bqhd,bkhd->bhqk', qn, k_nope, preferred_element_type=jnp.float32)
             + jnp.einsum('bqhr,bkr->bhqk', qr, k_rope, preferred_element_type=jnp.float32)) * scale
        pr = jax.nn.softmax(s, axis=-1).astype(v.dtype)
        return jnp.einsum('bhqk,bkhd->bqhd', pr, v)

    o = lax.map(attend, (qnb, qrb))
    return jnp.moveaxis(o, 0, 1).reshape(bsz, seq, C_WIDTH)


def moe_ffn(h, router_w, router_b, w1, w3, w2, sw1, sw3, sw2):
    bsz, seq, d = h.shape
    n_tok = bsz * seq
    xt = h.reshape(n_tok, d)
    scores = jax.nn.sigmoid(jnp.einsum('nd,de->ne', xt, router_w, preferred_element_type=jnp.float32))
    choice = scores + router_b.astype(jnp.float32)
    per_grp = N_EXPERTS // N_GROUPS
    grp_score = jnp.sum(lax.top_k(choice.reshape(n_tok, N_GROUPS, per_grp), 2)[0], axis=-1)
    grp_idx = lax.top_k(grp_score, TOPK_GROUPS)[1]
    grp_keep = jnp.any(grp_idx[:, :, None] == jnp.arange(N_GROUPS)[None, None, :], axis=1)
    masked = jnp.where(jnp.repeat(grp_keep, per_grp, axis=1), choice, NEG_INF)
    top_idx = lax.top_k(masked, TOP_K)[1]
    top_w = jnp.take_along_axis(scores, top_idx, axis=-1)
    top_w = top_w / jnp.sum(top_w, axis=-1, keepdims=True) * ROUTED_SCALE
    n_assign = n_tok * TOP_K
    e_flat = top_idx.reshape(n_assign).astype(jnp.int32)
    tok_flat = jnp.repeat(jnp.arange(n_tok, dtype=jnp.int32), TOP_K)
    w_flat = top_w.reshape(n_assign)
    order = jnp.argsort(e_flat)
    e_s, tok_s, w_s = e_flat[order], tok_flat[order], w_flat[order]
    counts = jnp.bincount(e_flat, length=N_EXPERTS).astype(jnp.int32)
    starts = jnp.cumsum(counts) - counts
    padded = (counts + MOE_BLOCK - 1) // MOE_BLOCK * MOE_BLOCK
    pends = jnp.cumsum(padded)
    pstarts = pends - padded
    dest = pstarts[e_s] + jnp.arange(n_assign, dtype=jnp.int32) - starts[e_s]
    n_blocks = -(-n_assign // MOE_BLOCK) + N_EXPERTS
    buf_len = n_blocks * MOE_BLOCK
    buf_tok = jnp.zeros((buf_len,), jnp.int32).at[dest].set(tok_s)
    buf_w = jnp.zeros((buf_len,), jnp.float32).at[dest].set(w_s)
    block_start = jnp.arange(n_blocks, dtype=jnp.int32) * MOE_BLOCK
    block_exp = jnp.minimum(jnp.searchsorted(pends, block_start, side='right'), N_EXPERTS - 1).astype(jnp.int32)

    def step(acc, blk):
        tok, wt, e = blk
        xb = xt[tok]
        hid = jax.nn.silu(xb @ w1[e]) * (xb @ w3[e])
        y = (hid @ w2[e]).astype(jnp.float32) * wt[:, None]
        return acc.at[tok].add(y), None

    routed, _ = lax.scan(step, jnp.zeros((n_tok, d), jnp.float32),
                         (buf_tok.reshape(n_blocks, MOE_BLOCK), buf_w.reshape(n_blocks, MOE_BLOCK), block_exp))
    shared = (jax.nn.silu(xt @ sw1) * (xt @ sw3)) @ sw2
    return (routed.astype(h.dtype) + shared).reshape(bsz, seq, d)


def setup_inputs(seed: int = 0) -> dict:
    key = jax.random.key(seed)
    ks = jax.random.split(key, 26)

    def nrm(k, shape, scale):
        return jax.random.normal(k, shape, jnp.float32) * scale

    def gain(k, shape):
        return 1.0 + 0.05 * jax.random.normal(k, shape, jnp.float32)

    L, D, E, F = DEPTH, D_MODEL, N_EXPERTS, EXPERT_FF
    return {
        'x': nrm(ks[0], (BATCH, SEQ, D), 1.0),
        'c': nrm(ks[1], (BATCH, D), 1.0),
        'mod_w': nrm(ks[2], (L, D, 6 * D), 0.5 * D ** -0.5),
        'mod_b': nrm(ks[3], (L, 6 * D), 0.02),
        'norm1_g': gain(ks[4], (L, D)),
        'norm2_g': gain(ks[5], (L, D)),
        'w_in': nrm(ks[6], (L, D, IN_W), D ** -0.5),
        'a_qnorm_g': gain(ks[7], (L, HEAD_DIM)),
        'a_knorm_g': gain(ks[8], (L, HEAD_DIM)),
        'b_sink': nrm(ks[9], (L, B_HEADS), 0.5),
        'c_qnorm_g': gain(ks[10], (L, C_Q_LORA)),
        'c_kvnorm_g': gain(ks[11], (L, C_KV_LORA)),
        'c_w_uq': nrm(ks[12], (L, C_Q_LORA, C_HEADS * (C_NOPE + C_ROPE)), C_Q_LORA ** -0.5),
        'c_w_uk': nrm(ks[13], (L, C_KV_LORA, C_HEADS * C_NOPE), C_KV_LORA ** -0.5),
        'c_w_uv': nrm(ks[14], (L, C_KV_LORA, C_HEADS * C_V), C_KV_LORA ** -0.5),
        'out_norm_g': gain(ks[15], (L, MIX)),
        'w_out': nrm(ks[16], (L, MIX, D), MIX ** -0.5),
        'router_w': nrm(ks[17], (L, D, E), D ** -0.5),
        'router_b': nrm(ks[18], (L, E), 0.01),
        'exp_w1': nrm(ks[19], (L, E, D, F), D ** -0.5),
        'exp_w3': nrm(ks[20], (L, E, D, F), D ** -0.5),
        'exp_w2': nrm(ks[21], (L, E, F, D), F ** -0.5),
        'sh_w1': nrm(ks[22], (L, D, SHARED_FF), D ** -0.5),
        'sh_w3': nrm(ks[23], (L, D, SHARED_FF), D ** -0.5),
        'sh_w2': nrm(ks[24], (L, SHARED_FF, D), SHARED_FF ** -0.5),
        'final_g': gain(ks[25], (D,)),
    }


def reference(x, c, mod_w, mod_b, norm1_g, norm2_g, w_in, a_qnorm_g, a_knorm_g, b_sink,
              c_qnorm_g, c_kvnorm_g, c_w_uq, c_w_uk, c_w_uv, out_norm_g, w_out,
              router_w, router_b, exp_w1, exp_w3, exp_w2, sh_w1, sh_w3, sh_w2, final_g):
    seq = x.shape[1]
    rows = seq // GRID_W
    row_ids = jnp.repeat(jnp.arange(rows, dtype=jnp.int32), GRID_W)
    col_ids = jnp.tile(jnp.arange(GRID_W, dtype=jnp.int32), rows)
    pos = jnp.arange(seq, dtype=jnp.int32)
    c_act = jax.nn.silu(c)
    for l in range(DEPTH):
        mod = jnp.einsum('bd,de->be', c_act, mod_w[l]) + mod_b[l]
        sh1, sc1, g1, sh2, sc2, g2 = [m[:, None, :] for m in jnp.split(mod, 6, axis=-1)]
        u = rms_norm(x, norm1_g[l]) * (1 + sc1) + sh1
        proj = jnp.einsum('bsd,de->bse', u, w_in[l])
        oa = mixer_a(proj[..., :A_IN], row_ids, col_ids, a_qnorm_g[l], a_knorm_g[l])
        ob = mixer_b(proj[..., A_IN:A_IN + B_IN], b_sink[l])
        oc = mixer_c(proj[..., A_IN + B_IN:], pos, c_qnorm_g[l], c_kvnorm_g[l], c_w_uq[l], c_w_uk[l], c_w_uv[l])
        g = out_norm_g[l]
        mixed = jnp.concatenate([rms_norm(oa, g[:A_WIDTH]),
                                 rms_norm(ob, g[A_WIDTH:A_WIDTH + B_WIDTH]),
                                 rms_norm(oc, g[A_WIDTH + B_WIDTH:])], axis=-1)
        x = x + g1 * jnp.einsum('bse,ed->bsd', mixed, w_out[l])
        u = rms_norm(x, norm2_g[l]) * (1 + sc2) + sh2
        x = x + g2 * moe_ffn(u, router_w[l], router_b[l], exp_w1[l], exp_w3[l], exp_w2[l],
                             sh_w1[l], sh_w3[l], sh_w2[l])
    return rms_norm(x, final_g)
```

```cpp
#include <hip/hip_runtime.h>
#include <hip/hip_bf16.h>
#include <cstdio>
#include <cstdint>
#include <cmath>
namespace pg8 {
#define PG8_LAS __attribute__((address_space(3)))
typedef unsigned short bf16_t;
typedef short bf16x8 __attribute__((ext_vector_type(8)));
typedef float f32x4 __attribute__((ext_vector_type(4)));
typedef unsigned u32x4 __attribute__((ext_vector_type(4)));
typedef unsigned u32x2 __attribute__((ext_vector_type(2)));
typedef int i32x4 __attribute__((ext_vector_type(4)));
typedef int i32x8 __attribute__((ext_vector_type(8)));
constexpr int BM = 256, BK = 64, HALF = 128, HTB = HALF * BK * 2  , STAGE_BYTES = 8 * HTB, NXCD = 8, WGM = 8;

__host__ __device__ __forceinline__ int lds_byte(int r, int c) { const int st = (r >> 4) * 2 + (c >> 5), rr = r & 15, cc = c & 31, ob = rr * 64 + cc * 2; return st * 1024 + (ob ^ (((ob >> 9) & 1) << 5)); }
__host__ __device__ __forceinline__ void stage_rc(int b, int& R, int& C) { const int st = b / 1024, sb = b % 1024, swz = sb ^ (((sb >> 9) & 1) << 5); R = (st >> 1) * 16 + swz / 64; C = (st & 1) * 32 + (swz % 64) / 2; }
__host__ __device__ __forceinline__ int perm32(int rho) { const int n = rho >> 4, i = rho & 15; return 8 * (i >> 2) + 4 * n + (i & 3); }

struct Unit { int pm, pn; int e, blk, rows, slot; };
struct Gemm { const bf16_t* A; const bf16_t* Bt; int M, N, K; };

struct StaticOrder {
    static constexpr bool SHARE_A = false;
    int nM, nN, nwg, G, c;
    __host__ __device__ __forceinline__ void init(int M, int N, int G_, int c_) { nM = M / BM; nN = N / BM; nwg = nM * nN; G = G_; c = c_; }
    __host__ __device__ __forceinline__ bool next(int i, Unit& u) const {
        const long L = (long)i * G + c; if (L >= nwg) return false;
        int wgid = (int)L; { const int q = nwg / NXCD, r = nwg % NXCD, xcd = wgid % NXCD, off = wgid / NXCD; wgid = (xcd < r ? xcd * (q + 1) : r * (q + 1) + (xcd - r) * q) + off; }
        const int nig = WGM * nN, gid = wgid / nig, fm = gid * WGM, gsz = (nM - fm) < WGM ? (nM - fm) : WGM;
        u.pm = fm + ((wgid % nig) % gsz); u.pn = (wgid % nig) / gsz; u.e = 0; u.blk = 0; u.rows = BM; u.slot = i; return true;
    }
    __device__ __forceinline__ void a_ready(const Unit&) const {}
    __device__ __forceinline__ void done(const Unit&) const {}
    __device__ __forceinline__ void offsets(const Unit&, unsigned (&)[2][2], int, int, int, int) const {}
};

__device__ __forceinline__ unsigned cvt_pk_bf16(float lo, float hi) { unsigned r; asm volatile("v_cvt_pk_bf16_f32 %0, %1, %2" : "=v"(r) : "v"(lo), "v"(hi)); return r; }

struct EpiBf16 {
    static constexpr bool PERM = true, KSCALE = false;
    bf16_t* O; int ldc;
    __device__ __forceinline__ void operator()(const f32x4 (&acc)[2][2][4][2], const Unit& u, int wr, int wc, int fr, int fq) const {
        const int row0 = u.pm * BM + wr * 64 + fr; const int col0 = u.pn * BM + wc * 32 + 8 * fq;
#pragma unroll
        for (int ai = 0; ai < 2; ++ai)
#pragma unroll
            for (int m = 0; m < 4; ++m) { bf16_t* rowp = O + (size_t)(row0 + ai * HALF + m * 16) * ldc + col0;
#pragma unroll
                for (int bj = 0; bj < 2; ++bj) { const f32x4 v0 = acc[ai][bj][m][0], v1 = acc[ai][bj][m][1];
                    u32x4 w; w.x = cvt_pk_bf16(v0[0], v0[1]); w.y = cvt_pk_bf16(v0[2], v0[3]); w.z = cvt_pk_bf16(v1[0], v1[1]); w.w = cvt_pk_bf16(v1[2], v1[3]);
                    *(u32x4*)(rowp + bj * HALF) = w; } }
    }
};
struct EpiF32 {
    static constexpr bool PERM = false, KSCALE = false;
    float* C; int ldc;
    __device__ __forceinline__ void operator()(const f32x4 (&acc)[2][2][4][2], const Unit& u, int wr, int wc, int fr, int fq) const {
        const int row0 = u.pm * BM + wr * 64 + fr, col0 = u.pn * BM + wc * 32 + 4 * fq;
#pragma unroll
        for (int ai = 0; ai < 2; ++ai)
#pragma unroll
            for (int m = 0; m < 4; ++m) { float* rowp = C + (size_t)(row0 + ai * HALF + m * 16) * ldc + col0;
#pragma unroll
                for (int bj = 0; bj < 2; ++bj)
#pragma unroll
                    for (int n = 0; n < 2; ++n) *(f32x4*)(rowp + bj * HALF + n * 16) = acc[ai][bj][m][n]; }
    }
};

template <class Epi, class Sched, bool ALIGN_EPI = false, bool GATHER = false, bool FP8 = false>
__device__ __forceinline__ void gemm_phase(PG8_LAS unsigned char* lds, const Gemm g, const Sched& S, const Epi& E) {
    int tid_ = threadIdx.x; asm volatile("" : "+v"(tid_));
    const int tid = tid_, wid = __builtin_amdgcn_readfirstlane(tid >> 6), lane = tid & 63, wr = wid >> 2, wc = wid & 3, fr = lane & 15, fq = lane >> 4;
    const int K = g.K; const int rowB = FP8 ? K : 2 * K; const int nt = rowB / (2 * BK);
    const size_t kstep = (size_t)(BK * 2);
    const size_t hstep = (size_t)HALF * rowB;
    const size_t tstep = 2 * hstep;
    unsigned voffA[2], voffB[2]; unsigned vA[2][2], vAn[2][2]; int sR[2], sC[2];
#pragma unroll
    for (int i = 0; i < 2; ++i) { int R, C; stage_rc(tid * 16 + i * 8192, R, C); const int Rb = Epi::PERM ? ((R & ~31) + perm32(R & 31)) : R; sR[i] = R; sC[i] = C;
        voffA[i] = (unsigned)(R * rowB + C * 2); voffB[i] = (unsigned)(Rb * rowB + C * 2);
        vA[0][i] = 0u; vA[1][i] = 0u; vAn[0][i] = 0u; vAn[1][i] = 0u; }
    const size_t ahs = GATHER ? (size_t)0 : hstep;
    const unsigned lds0 = (unsigned)(uintptr_t)lds;
    const unsigned ldsw = (unsigned)wid * 1024u;
    const int aoff = lds_byte(wr * 64 + fr, fq * 8), boff = lds_byte(wc * 32 + fr, fq * 8);
#define PG8_SA(b, h) (((b) * 2 + (h)) * HTB)
#define PG8_SB(b, h) ((4 + (b) * 2 + (h)) * HTB)
#define PG8_GLDS(base_, voff_, ldsdst_) do { unsigned keep_; asm volatile("s_mov_b32 %0, m0\n\ts_mov_b32 m0, %3\n\ts_nop 0\n\tglobal_load_lds_dwordx4 %1, %2\n\ts_mov_b32 m0, %0" \
        : "=&s"(keep_) : "v"(voff_), "s"(base_), "s"(ldsdst_) : "memory"); } while (0)
#define PG8_STAGE(bufoff, gbase, voff) do { const char* gb_ = (const char*)(gbase); _Pragma("unroll") for (int _i = 0; _i < 2; ++_i) \
        PG8_GLDS(gb_, (voff)[_i], (unsigned)__builtin_amdgcn_readfirstlane((int)(lds0 + (unsigned)(bufoff) + ldsw + _i * 8192))); } while (0)
#define PG8_STAGE_A(bufoff, gbase, h, vg) do { if constexpr (GATHER) PG8_STAGE(bufoff, gbase, vg); else PG8_STAGE(bufoff, (gbase) + (h) * ahs, voffA); } while (0)
#define PG8_LDA(dst, b, h) do { _Pragma("unroll") for (int m = 0; m < 4; ++m) _Pragma("unroll") for (int k = 0; k < 2; ++k) dst[m][k] = *(const PG8_LAS bf16x8*)(lds + PG8_SA(b, h) + aoff + m * 2048 + k * 1024); } while (0)
#define PG8_LDB(dst, b, h) do { _Pragma("unroll") for (int n = 0; n < 2; ++n) _Pragma("unroll") for (int k = 0; k < 2; ++k) dst[n][k] = *(const PG8_LAS bf16x8*)(lds + PG8_SB(b, h) + boff + n * 2048 + k * 1024); } while (0)
#define PG8_CAT8(x) __builtin_shufflevector(__builtin_bit_cast(i32x4, (x)[0]), __builtin_bit_cast(i32x4, (x)[1]), 0, 1, 2, 3, 4, 5, 6, 7)
#define PG8_MMA(ai, bj, At, Bt) do { __builtin_amdgcn_s_setprio(1); _Pragma("unroll") for (int m = 0; m < 4; ++m) _Pragma("unroll") for (int n = 0; n < 2; ++n) { \
        if constexpr (FP8) {   \
            asm volatile("v_mfma_scale_f32_16x16x128_f8f6f4 %0, %1, %2, %0, %3, %3 op_sel_hi:[0,0,0]" : "+v"(acc[ai][bj][m][n]) : "v"(PG8_CAT8(Bt[n])), "v"(PG8_CAT8(At[m])), "v"(sc_one)); } \
        else { _Pragma("unroll") for (int k = 0; k < 2; ++k) acc[ai][bj][m][n] = __builtin_amdgcn_mfma_f32_16x16x32_bf16(Bt[n][k], At[m][k], acc[ai][bj][m][n], 0, 0, 0); } } \
        __builtin_amdgcn_s_setprio(0); } while (0)
#define PG8_WAIT_V(n) asm volatile("s_waitcnt vmcnt(" #n ")" ::: "memory")
#define PG8_WAIT_L(n) asm volatile("s_waitcnt lgkmcnt(" #n ")" ::: "memory")
#define PG8_BAR __builtin_amdgcn_s_barrier()
#define PG8_SCHED __builtin_amdgcn_sched_barrier(0)
    Unit cur, nxt; int ui = 0;
    constexpr bool SHARE = Sched::SHARE_A; bool cur_new = true, nxt_new = true;
    if (!S.next(0, cur)) return;
    f32x4 acc[2][2][4][2];
#pragma unroll
    for (int a = 0; a < 2; ++a)
#pragma unroll
        for (int b = 0; b < 2; ++b)
#pragma unroll
            for (int m = 0; m < 4; ++m)
#pragma unroll
                for (int n = 0; n < 2; ++n) acc[a][b][m][n] = (f32x4){0.f, 0.f, 0.f, 0.f};
    bf16x8 At[4][2], B0[2][2], B1[2][2];
    int sc_one = 0x7F7F7F7F; asm volatile("" : "+v"(sc_one));
    const char* cA = GATHER ? (const char*)g.A : (const char*)g.A + (size_t)cur.pm * tstep; const char* cB = (const char*)g.Bt + (size_t)cur.pn * tstep;
    if constexpr (GATHER) S.offsets(cur, vA, sR[0], sC[0], sR[1], sC[1]);
    S.a_ready(cur);
    Unit nn; bool has_next = false, has_nn = false; unsigned rawn[2][2] = {{0u, 0u}, {0u, 0u}};
    if constexpr (GATHER) { has_next = S.next(1, nxt); if (has_next) S.offsets_raw(nxt, rawn, sR[0], sR[1]); }
    PG8_STAGE(PG8_SB(0, 0), cB, voffB); PG8_STAGE(PG8_SB(0, 1), cB + hstep, voffB); PG8_STAGE_A(PG8_SA(0, 0), cA, 0, vA[0]); PG8_STAGE_A(PG8_SA(0, 1), cA, 1, vA[1]);
    if (wr == 1) PG8_BAR;
    PG8_WAIT_V(2); PG8_BAR;
    PG8_STAGE(PG8_SB(1, 0), cB + kstep, voffB); PG8_STAGE_A(PG8_SA(1, 0), cA + kstep, 0, vA[0]); PG8_STAGE(PG8_SB(1, 1), cB + hstep + kstep, voffB);
    PG8_WAIT_V(6); PG8_BAR;
    if constexpr (GATHER) { if (has_next) S.offsets_fin(rawn, vAn, sC[0], sC[1]); else { vAn[0][0] = vA[0][0]; vAn[0][1] = vA[0][1]; vAn[1][0] = vA[1][0]; vAn[1][1] = vA[1][1]; } }
    for (;;) {
        if constexpr (!GATHER) has_next = S.next(ui + 1, nxt);
        if constexpr (SHARE) nxt_new = !(has_next && nxt.pm == cur.pm);
        const char* nA = GATHER ? cA : (has_next ? (const char*)g.A + (size_t)nxt.pm * tstep : cA); const char* nB = has_next ? (const char*)g.Bt + (size_t)nxt.pn * tstep : cB;
        for (int t = 0; t < nt; t += 2) {
            const bool last = (t == nt - 2);
            const char* a1 = cA + (size_t)(t + 1) * kstep;
            const char* a2 = last ? nA : cA + (size_t)(t + 2) * kstep; const char* b2 = last ? nB : cB + (size_t)(t + 2) * kstep;
            const char* a3 = a2 + kstep; const char* b3 = b2 + kstep;
            unsigned w0[2], w1[2];
            if constexpr (GATHER) { w0[0] = last ? vAn[0][0] : vA[0][0]; w0[1] = last ? vAn[0][1] : vA[0][1]; w1[0] = last ? vAn[1][0] : vA[1][0]; w1[1] = last ? vAn[1][1] : vA[1][1]; }
            else { w0[0] = 0u; w0[1] = 0u; w1[0] = 0u; w1[1] = 0u; }
            if (last && has_next) S.a_ready(nxt);
            if constexpr (Epi::KSCALE) { if (t == Epi::KS_TOP) { if constexpr (FP8) asm volatile("s_nop 15\n\ts_nop 15" ::: "memory"); PG8_SCHED; E.kscale(acc, cur, 1, wr); PG8_SCHED; } }
            PG8_LDB(B0, 0, 0); PG8_LDB(B1, 0, 1); PG8_SCHED; PG8_LDA(At, 0, 0); if (!SHARE || cur_new) PG8_STAGE_A(PG8_SA(1, 1), a1, 1, vA[1]);
            if constexpr (SHARE) { if (cur_new) PG8_WAIT_V(8); } else PG8_WAIT_V(8);
            PG8_WAIT_L(0); PG8_BAR; PG8_MMA(0, 0, At, B0); PG8_MMA(0, 1, At, B1); PG8_BAR; PG8_SCHED;
            PG8_LDA(At, 0, 1); PG8_STAGE(PG8_SB(0, 0), b2, voffB); PG8_STAGE(PG8_SB(0, 1), b2 + hstep, voffB); if (!SHARE || nxt_new) PG8_STAGE_A(PG8_SA(0, 0), a2, 0, w0);
            if constexpr (SHARE) { if (cur_new && nxt_new) PG8_WAIT_V(8); else if (cur_new || nxt_new) PG8_WAIT_V(6); else PG8_WAIT_V(4); } else PG8_WAIT_V(8);
            PG8_WAIT_L(0); PG8_BAR; PG8_MMA(1, 0, At, B0); PG8_MMA(1, 1, At, B1); PG8_BAR; PG8_SCHED;
            if constexpr (Epi::KSCALE) { if (t + 1 == Epi::KS_MID) { if constexpr (FP8) asm volatile("s_nop 15\n\ts_nop 15" ::: "memory"); PG8_SCHED; E.kscale(acc, cur, 0, wr); PG8_SCHED; } }
            PG8_LDB(B0, 1, 0); PG8_LDB(B1, 1, 1); PG8_SCHED; PG8_LDA(At, 1, 0); if (!SHARE || nxt_new) PG8_STAGE_A(PG8_SA(0, 1), a2, 1, w1);
            if constexpr (SHARE) { if (cur_new) { if (nxt_new) PG8_WAIT_V(8); else PG8_WAIT_V(4); } } else PG8_WAIT_V(8);
            PG8_WAIT_L(0); PG8_BAR; PG8_MMA(0, 0, At, B0); PG8_MMA(0, 1, At, B1); PG8_BAR; PG8_SCHED;
            PG8_LDA(At, 1, 1); PG8_STAGE(PG8_SB(1, 0), b3, voffB); PG8_STAGE(PG8_SB(1, 1), b3 + hstep, voffB); if (!SHARE || nxt_new) PG8_STAGE_A(PG8_SA(1, 0), a3, 0, w0);
            if constexpr (SHARE) { if (nxt_new) PG8_WAIT_V(8); else PG8_WAIT_V(4); } else PG8_WAIT_V(8);
            PG8_WAIT_L(0); PG8_BAR; PG8_MMA(1, 0, At, B0); PG8_MMA(1, 1, At, B1); PG8_BAR; PG8_SCHED;
        }
        if constexpr (GATHER) { has_nn = has_next && S.next(ui + 2, nn); if (has_nn) S.offsets_raw(nn, rawn, sR[0], sR[1]); }
        if constexpr (ALIGN_EPI) { if (wr == 0) PG8_BAR; }
        if constexpr (FP8) { asm volatile("s_nop 15\n\ts_nop 15" ::: "memory"); PG8_SCHED; }
        E(acc, cur, wr, wc, fr, fq); S.done(cur);
        if (!has_next) break;
#pragma unroll
        for (int a = 0; a < 2; ++a)
#pragma unroll
            for (int b = 0; b < 2; ++b)
#pragma unroll
                for (int m = 0; m < 4; ++m)
#pragma unroll
                    for (int n = 0; n < 2; ++n) acc[a][b][m][n] = (f32x4){0.f, 0.f, 0.f, 0.f};
        cur = nxt; cA = nA; cB = nB; ++ui; if constexpr (SHARE) cur_new = nxt_new;
        if constexpr (GATHER) { vA[0][0] = vAn[0][0]; vA[0][1] = vAn[0][1]; vA[1][0] = vAn[1][0]; vA[1][1] = vAn[1][1]; if (has_nn) S.offsets_fin(rawn, vAn, sC[0], sC[1]); nxt = nn; has_next = has_nn; }
        if constexpr (ALIGN_EPI) { if (wr == 1) PG8_BAR; }
    }
    PG8_WAIT_V(0);
    if constexpr (!ALIGN_EPI) { if (wr == 0) PG8_BAR; }
    PG8_BAR;
#undef PG8_SA
#undef PG8_SB
#undef PG8_STAGE
#undef PG8_GLDS
#undef PG8_STAGE_A
#undef PG8_LDA
#undef PG8_LDB
#undef PG8_MMA
#undef PG8_CAT8
#undef PG8_WAIT_V
#undef PG8_WAIT_L
#undef PG8_BAR
#undef PG8_SCHED
}
}
namespace sat {
using bf16x8 = __attribute__((ext_vector_type(8))) short;
using s16x4 = __attribute__((ext_vector_type(4))) short;
using f32x16 = __attribute__((ext_vector_type(16))) float;
using u32x4 = __attribute__((ext_vector_type(4))) unsigned;
typedef unsigned short bf16_t;
#define SAT_LAS __attribute__((address_space(3)))
constexpr int KSLOT = 12288, VSLOT = 8192;
constexpr int L_K = 0, L_V = 2 * KSLOT, L_WS = L_V + 2 * VSLOT, L_OST = L_WS + 8 * 256, L_BYTES = L_OST + 8 * 4096;
__device__ __forceinline__ int crow(int r, int hi) { return (r & 3) + 8 * (r >> 2) + 4 * hi; }
__device__ __forceinline__ void glds16(const void* gsrc, unsigned lds_dst) { unsigned keep;
    asm volatile("s_mov_b32 %0, m0\n\ts_mov_b32 m0, %2\n\ts_nop 0\n\tglobal_load_lds_dwordx4 %1, off\n\ts_mov_b32 m0, %0" : "=&s"(keep) : "v"(gsrc), "s"(lds_dst) : "memory"); }
typedef float f32x2_t __attribute__((ext_vector_type(2))); typedef __bf16 bf16x2_t __attribute__((ext_vector_type(2)));
__device__ __forceinline__ unsigned cvtpk_s(float lo, float hi) { f32x2_t v = {lo, hi}; bf16x2_t b = __builtin_convertvector(v, bf16x2_t); return __builtin_bit_cast(unsigned, b); }
#define SAT_MX3(a, b, c) __builtin_fmaxf(__builtin_fmaxf((a), (b)), (c))
__device__ __forceinline__ float rowmax(const f32x16& p0, const f32x16& p1) {
    float a = SAT_MX3(p0[0], p0[1], p1[0]), b = SAT_MX3(p0[2], p0[3], p1[1]); a = SAT_MX3(a, p1[2], p1[3]);
#pragma unroll
    for (int r = 4; r < 16; r += 4) { a = SAT_MX3(a, p0[r], p0[r + 1]); b = SAT_MX3(b, p0[r + 2], p0[r + 3]); a = SAT_MX3(a, p1[r], p1[r + 1]); b = SAT_MX3(b, p1[r + 2], p1[r + 3]); }
    float m = __builtin_fmaxf(a, b); auto rr = __builtin_amdgcn_permlane32_swap(__float_as_uint(m), __float_as_uint(m), false, false);
    return __builtin_fmaxf(__uint_as_float(rr[0]), __uint_as_float(rr[1])); }
__device__ __forceinline__ void pv(f32x16* o, int vb, bf16x8 pa0, bf16x8 pa1, bf16x8 pa2, bf16x8 pa3) {
#pragma unroll
    for (int d0 = 0; d0 < 2; ++d0) { s16x4 lo[4], hi[4];
#pragma unroll
        for (int ks = 0; ks < 4; ++ks) {
            asm volatile("ds_read_b64_tr_b16 %0,%1 offset:%c2" : "=&v"(lo[ks]) : "v"(vb), "i"(d0 * 4096 + ks * 1024) : "memory");
            asm volatile("ds_read_b64_tr_b16 %0,%1 offset:%c2" : "=&v"(hi[ks]) : "v"(vb), "i"(d0 * 4096 + ks * 1024 + 512) : "memory"); }
        asm volatile("s_waitcnt lgkmcnt(0)" : "+v"(lo[0]), "+v"(lo[1]), "+v"(lo[2]), "+v"(lo[3]), "+v"(hi[0]), "+v"(hi[1]), "+v"(hi[2]), "+v"(hi[3]) :: "memory"); __builtin_amdgcn_sched_barrier(0);
#define SAT_PK(k) (bf16x8){lo[k][0], lo[k][1], lo[k][2], lo[k][3], hi[k][0], hi[k][1], hi[k][2], hi[k][3]}
        o[d0] = __builtin_amdgcn_mfma_f32_32x32x16_bf16(pa0, SAT_PK(0), o[d0], 0, 0, 0);
        o[d0] = __builtin_amdgcn_mfma_f32_32x32x16_bf16(pa1, SAT_PK(1), o[d0], 0, 0, 0);
        o[d0] = __builtin_amdgcn_mfma_f32_32x32x16_bf16(pa2, SAT_PK(2), o[d0], 0, 0, 0);
        o[d0] = __builtin_amdgcn_mfma_f32_32x32x16_bf16(pa3, SAT_PK(3), o[d0], 0, 0, 0);
#undef SAT_PK
    }
}
#define SAT_WAIT_BAR() asm volatile("s_waitcnt vmcnt(0) lgkmcnt(0)\n\ts_barrier" ::: "memory")

template <int DQK, int MODE>
__device__ __forceinline__ void unit(const bf16_t* Qp, int qpitch, const bf16_t* __restrict__ Kp, int kpitch, const bf16_t* __restrict__ Vp, int vpitch, bf16_t* Op, int opitch,
                                     int q0, int t_lo, int t_hi, float slope2, float sink2, SAT_LAS unsigned char* shm) {
    constexpr int NCH = DQK / 8, ND0 = DQK / 16;
    int tid_ = threadIdx.x; asm volatile("" : "+v"(tid_));
    const int tid = tid_, lane = tid & 63, r32 = lane & 31, hi = lane >> 5; const int wid = __builtin_amdgcn_readfirstlane(tid >> 6);
    const unsigned lds0 = (unsigned)(uintptr_t)shm;
    SAT_LAS float* wsf = (SAT_LAS float*)(shm + L_WS) + wid * 64;
    const bf16_t* ksrc = Kp + (size_t)lane * kpitch + wid * 8;
    const bf16_t* vsrc = Vp + (size_t)(16 * (wid & 3) + (lane >> 2)) * vpitch + (wid >> 2) * 32 + (lane & 3) * 8;
    const unsigned kdst = lds0 + L_K + wid * 1024, vdst = lds0 + L_V + wid * 1024;
#define SAT_DMA(t, bsel) do { glds16(ksrc + (size_t)(t) * 64 * kpitch, (unsigned)__builtin_amdgcn_readfirstlane(kdst + (bsel) * KSLOT)); \
        if (NCH > 8 && wid < NCH - 8) glds16(ksrc + (size_t)(t) * 64 * kpitch + 64, (unsigned)__builtin_amdgcn_readfirstlane(kdst + (bsel) * KSLOT + 8192)); \
        glds16(vsrc + (size_t)(t) * 64 * vpitch, (unsigned)__builtin_amdgcn_readfirstlane(vdst + (bsel) * VSLOT)); } while (0)
    const int vb0 = (int)(lds0 + L_V) + ((lane >> 4) & 1) * 32 + (lane & 3) * 8 + (4 * hi + ((lane & 15) >> 2)) * 64;
    SAT_DMA(t_lo, 0);
    bf16x8 qr[ND0];
    { const bf16_t* Qw = Qp + (size_t)(q0 + wid * 32 + r32) * qpitch + hi * 8;
#pragma unroll
      for (int d0 = 0; d0 < ND0; ++d0) qr[d0] = *reinterpret_cast<const bf16x8*>(Qw + d0 * 16); }
    float mhat = (MODE == 1) ? sink2 : -1e30f, l_reg = (MODE == 1 && hi == 0) ? 1.f : 0.f;
    f32x16 o[2]; o[0] = f32x16{}; o[1] = f32x16{};
    const int qrow = q0 + wid * 32 + r32;
    const int wlo = q0 + wid * 32 - 128, whi = q0 + wid * 32 + 31 + 128;
    SAT_WAIT_BAR();
    int bsel = 0;
    for (int t = t_lo; t < t_hi; ++t) {
        if (t + 1 < t_hi) SAT_DMA(t + 1, bsel ^ 1);
        const bool active = (MODE == 0) || (64 * t + 63 >= wlo && 64 * t <= whi);
        if (active) {
            const SAT_LAS unsigned char* kb = shm + L_K + bsel * KSLOT + hi * 1024 + r32 * 16;
            f32x16 p0 = f32x16{}, p1 = f32x16{};
#pragma unroll
            for (int d0 = 0; d0 < ND0; ++d0) {
                const bf16x8 b0 = *reinterpret_cast<const SAT_LAS bf16x8*>(kb + d0 * 2048);
                const bf16x8 b1 = *reinterpret_cast<const SAT_LAS bf16x8*>(kb + d0 * 2048 + 512);
                p0 = __builtin_amdgcn_mfma_f32_32x32x16_bf16(b0, qr[d0], p0, 0, 0, 0); p1 = __builtin_amdgcn_mfma_f32_32x32x16_bf16(b1, qr[d0], p1, 0, 0, 0); }
            if (MODE == 1) {
                const int kbase = 64 * t + 4 * hi - qrow;
#pragma unroll
                for (int r = 0; r < 16; ++r) { const int rel = kbase + (r & 3) + 8 * (r >> 2); const int d0_ = rel < 0 ? -rel : rel; const int rel1 = rel + 32; const int d1_ = rel1 < 0 ? -rel1 : rel1;
                    p0[r] = d0_ <= 128 ? p0[r] - slope2 * (float)d0_ : -INFINITY; p1[r] = d1_ <= 128 ? p1[r] - slope2 * (float)d1_ : -INFINITY; } }
            const float rm = rowmax(p0, p1);
            const float mnew = __builtin_fmaxf(mhat, rm); const float alpha = __builtin_amdgcn_exp2f(mhat - mnew); mhat = mnew;
            float psum = 0.f;
#pragma unroll
            for (int r = 0; r < 16; ++r) { p0[r] = __builtin_amdgcn_exp2f(p0[r] - mnew); p1[r] = __builtin_amdgcn_exp2f(p1[r] - mnew); psum += p0[r] + p1[r]; }
            l_reg = l_reg * alpha + psum;
            if (hi == 0) wsf[r32] = alpha;
            asm volatile("s_waitcnt lgkmcnt(0)" ::: "memory");
#pragma unroll
            for (int r = 0; r < 16; ++r) { const float f = wsf[crow(r, hi)]; o[0][r] *= f; o[1][r] *= f; }
            u32x4 pw0, pw1, pw2, pw3;
#define SAT_PKW(P, B) cvtpk_s(P[B], P[B + 1])
            pw0 = (u32x4){SAT_PKW(p0, 0), SAT_PKW(p0, 2), SAT_PKW(p0, 4), SAT_PKW(p0, 6)}; pw1 = (u32x4){SAT_PKW(p0, 8), SAT_PKW(p0, 10), SAT_PKW(p0, 12), SAT_PKW(p0, 14)};
            pw2 = (u32x4){SAT_PKW(p1, 0), SAT_PKW(p1, 2), SAT_PKW(p1, 4), SAT_PKW(p1, 6)}; pw3 = (u32x4){SAT_PKW(p1, 8), SAT_PKW(p1, 10), SAT_PKW(p1, 12), SAT_PKW(p1, 14)};
#undef SAT_PKW
            asm volatile("s_waitcnt lgkmcnt(0)" ::: "memory"); __builtin_amdgcn_sched_barrier(0);
            pv(o, vb0 + bsel * VSLOT, __builtin_bit_cast(bf16x8, pw0), __builtin_bit_cast(bf16x8, pw1), __builtin_bit_cast(bf16x8, pw2), __builtin_bit_cast(bf16x8, pw3));
        }
        SAT_WAIT_BAR();
        bsel ^= 1;
    }
    { auto rr = __builtin_amdgcn_permlane32_swap(__float_as_uint(l_reg), __float_as_uint(l_reg), false, false); l_reg = __uint_as_float(rr[0]) + __uint_as_float(rr[1]); }
    if (hi == 0) wsf[32 + r32] = l_reg; asm volatile("s_waitcnt lgkmcnt(0)" ::: "memory");
    float rli[16];
#pragma unroll
    for (int r = 0; r < 16; ++r) rli[r] = __builtin_amdgcn_rcpf(wsf[32 + crow(r, hi)]);
    bf16_t* Ow = Op + (size_t)(q0 + wid * 32) * opitch;
    { SAT_LAS bf16_t* stg = (SAT_LAS bf16_t*)(shm + L_OST) + wid * 2048;
#pragma unroll
      for (int r = 0; r < 16; ++r) { const int orow = crow(r, hi);
#pragma unroll
          for (int d0 = 0; d0 < 2; ++d0) stg[orow * 64 + d0 * 32 + r32] = (bf16_t)(cvtpk_s(o[d0][r] * rli[r], 0.f) & 0xffffu); }
      asm volatile("s_waitcnt lgkmcnt(0)" ::: "memory");
#pragma unroll
      for (int i = 0; i < 4; ++i) { const int row = i * 8 + (lane >> 3), ch = lane & 7; const u32x4 v = *(const SAT_LAS u32x4*)(stg + row * 64 + ch * 8); *(u32x4*)(Ow + (size_t)row * opitch + ch * 8) = v; } }
    asm volatile("s_waitcnt lgkmcnt(0)\n\ts_barrier" ::: "memory");
#undef SAT_DMA
}
}
namespace tat {
using bf16=__hip_bfloat16;
using bf16x8=__attribute__((ext_vector_type(8)))short;
using s16x4=__attribute__((ext_vector_type(4)))short;
using f32x16=__attribute__((ext_vector_type(16)))float;
using u32x4=__attribute__((ext_vector_type(4)))unsigned;
constexpr int SEQ=8192,D=64;
constexpr int NW=8,QBLK=32,QB=QBLK*NW,KVBLK=64,NQB=SEQ/QB;
__device__ __forceinline__ int crow(int r,int hi){return (r&3)+8*(r>>2)+4*hi;}
#define SBAR() __builtin_amdgcn_sched_barrier(0)
__device__ __forceinline__ void cmask(f32x16&p0,f32x16&p1,int jb,int qrel,int hi){
  const float NEG=-INFINITY; int kb=64*jb+4*hi;
  #pragma unroll
  for(int r=0;r<16;++r){int kv=kb+(r&3)+8*(r>>2); if(kv>qrel)p0[r]=NEG; if(kv+32>qrel)p1[r]=NEG;}
}

constexpr int NSLOT=3, SLOTB=8192;
constexpr int LDS_K=0, LDS_V=NSLOT*SLOTB, LDS_WS=2*NSLOT*SLOTB, LDS_OST=LDS_WS+NW*64*4, LDS_BYTES=LDS_OST+NW*4096;
constexpr float C2=0.125f*1.4426950408889634f;
__device__ __forceinline__ void glds16(const void*gsrc,unsigned lds_dst){unsigned keep;
  asm volatile("s_mov_b32 %0, m0\n\ts_mov_b32 m0, %2\n\ts_nop 0\n\tglobal_load_lds_dwordx4 %1, off\n\ts_mov_b32 m0, %0":"=&s"(keep):"v"(gsrc),"s"(lds_dst):"memory");}
__device__ __forceinline__ void glds16s(const void*sbase,unsigned voff,unsigned lds_dst){unsigned keep;
  asm volatile("s_mov_b32 %0, m0\n\ts_mov_b32 m0, %3\n\ts_nop 0\n\tglobal_load_lds_dwordx4 %1, %2\n\ts_mov_b32 m0, %0":"=&s"(keep):"v"(voff),"s"(sbase),"s"(lds_dst):"memory");}
__device__ __forceinline__ float max3f(float a,float b,float c){float r;asm("v_max3_f32 %0, %1, %2, %3":"=v"(r):"v"(a),"v"(b),"v"(c));return r;}
__device__ __forceinline__ float max2f(float a,float b){float r;asm("v_max_f32_e32 %0, %1, %2":"=v"(r):"v"(a),"v"(b));return r;}
__device__ __forceinline__ float fadd_s(float a,float b){float r;asm("v_add_f32_e32 %0, %1, %2":"=v"(r):"v"(a),"v"(b));return r;}
__device__ __forceinline__ float fsub_s(float a,float b){float r;asm("v_sub_f32_e32 %0, %1, %2":"=v"(r):"v"(a),"v"(b));return r;}
typedef float f32x2_t __attribute__((ext_vector_type(2))); typedef __bf16 bf16x2_t __attribute__((ext_vector_type(2)));
__device__ __forceinline__ unsigned cvtpk_s(float lo,float hi){f32x2_t v={lo,hi};bf16x2_t b=__builtin_convertvector(v,bf16x2_t);return __builtin_bit_cast(unsigned,b);}
#define WAIT_BAR(N) asm volatile("s_waitcnt vmcnt(" #N ") lgkmcnt(0)\n\ts_barrier":::"memory")

typedef __attribute__((address_space(3))) const char* lds_cptr;
template<int CTRL> __device__ __forceinline__ float dppf(float v){const int i=__builtin_bit_cast(int,v);return __builtin_bit_cast(float,__builtin_amdgcn_update_dpp(i,i,CTRL,0xF,0xF,false));}
__device__ __forceinline__ void qkt(f32x16&p0,f32x16&p1,lds_cptr Kslot,const bf16x8*qr,const f32x16&negm,int r32,int hi){
  const lds_cptr kb=Kslot+hi*1024+r32*16;
  #pragma unroll
  for(int d0=0;d0<4;++d0){
    const bf16x8 b0=*(const __attribute__((address_space(3))) bf16x8*)(kb+d0*2048);
    const bf16x8 b1=*(const __attribute__((address_space(3))) bf16x8*)(kb+d0*2048+512);
    if(d0==0){p0=__builtin_amdgcn_mfma_f32_32x32x16_bf16(b0,qr[0],negm,0,0,0);p1=__builtin_amdgcn_mfma_f32_32x32x16_bf16(b1,qr[0],negm,0,0,0);}
    else{p0=__builtin_amdgcn_mfma_f32_32x32x16_bf16(b0,qr[d0],p0,0,0,0);p1=__builtin_amdgcn_mfma_f32_32x32x16_bf16(b1,qr[d0],p1,0,0,0);}}
}
typedef short v4i16_t __attribute__((ext_vector_type(4)));
__device__ __forceinline__ void kload8(bf16x8*kf,lds_cptr kp){
  kf[0]=*(const __attribute__((address_space(3))) bf16x8*)(kp);      kf[1]=*(const __attribute__((address_space(3))) bf16x8*)(kp+512);
  kf[2]=*(const __attribute__((address_space(3))) bf16x8*)(kp+2048); kf[3]=*(const __attribute__((address_space(3))) bf16x8*)(kp+2560);
  kf[4]=*(const __attribute__((address_space(3))) bf16x8*)(kp+4096); kf[5]=*(const __attribute__((address_space(3))) bf16x8*)(kp+4608);
  kf[6]=*(const __attribute__((address_space(3))) bf16x8*)(kp+6144); kf[7]=*(const __attribute__((address_space(3))) bf16x8*)(kp+6656);
}
__device__ __forceinline__ void kload2(bf16x8*kf,lds_cptr kp,int j){ kf[2*j]=*(const __attribute__((address_space(3))) bf16x8*)(kp+j*2048); kf[2*j+1]=*(const __attribute__((address_space(3))) bf16x8*)(kp+j*2048+512); }
__device__ __forceinline__ s16x4 vtr(lds_cptr p){ return __builtin_bit_cast(s16x4,__builtin_amdgcn_ds_read_tr16_b64_v4i16((__attribute__((address_space(3))) v4i16_t*)p)); }
__device__ __forceinline__ float rowmax(const f32x16&p0,const f32x16&p1){
  float a=max3f(p0[0],p0[1],p1[0]),b=max3f(p0[2],p0[3],p1[1]);a=max3f(a,p1[2],p1[3]);
  #pragma unroll
  for(int r=4;r<16;r+=4){a=max3f(a,p0[r],p0[r+1]);b=max3f(b,p0[r+2],p0[r+3]);a=max3f(a,p1[r],p1[r+1]);b=max3f(b,p1[r+2],p1[r+3]);}
  const float m=max2f(a,b);
  auto rr=__builtin_amdgcn_permlane32_swap(__float_as_uint(m),__float_as_uint(m),false,false);
  return max2f(__uint_as_float(rr[0]),__uint_as_float(rr[1]));
}
__device__ __forceinline__ void pv(f32x16*o,int vb,bf16x8 pa0,bf16x8 pa1,bf16x8 pa2,bf16x8 pa3){
  #pragma unroll
  for(int d0=0;d0<2;++d0){s16x4 lo[4],hi[4];
    #pragma unroll
    for(int ks=0;ks<4;++ks){
      asm volatile("ds_read_b64_tr_b16 %0,%1 offset:%c2":"=&v"(lo[ks]):"v"(vb),"i"(d0*4096+ks*1024):"memory");
      asm volatile("ds_read_b64_tr_b16 %0,%1 offset:%c2":"=&v"(hi[ks]):"v"(vb),"i"(d0*4096+ks*1024+512):"memory");}
    asm volatile("s_waitcnt lgkmcnt(0)":::"memory");SBAR();
    #define PK(k) (bf16x8){lo[k][0],lo[k][1],lo[k][2],lo[k][3],hi[k][0],hi[k][1],hi[k][2],hi[k][3]}
    o[d0]=__builtin_amdgcn_mfma_f32_32x32x16_bf16(pa0,PK(0),o[d0],0,0,0);
    o[d0]=__builtin_amdgcn_mfma_f32_32x32x16_bf16(pa1,PK(1),o[d0],0,0,0);
    o[d0]=__builtin_amdgcn_mfma_f32_32x32x16_bf16(pa2,PK(2),o[d0],0,0,0);
    o[d0]=__builtin_amdgcn_mfma_f32_32x32x16_bf16(pa3,PK(3),o[d0],0,0,0);
    #undef PK
  }
}

typedef unsigned u32x2_t __attribute__((ext_vector_type(2)));
__device__ __forceinline__ unsigned pk4f8(float a,float b,float c,float d){int w=0;w=__builtin_amdgcn_cvt_pk_fp8_f32(a,b,w,false);w=__builtin_amdgcn_cvt_pk_fp8_f32(c,d,w,true);return (unsigned)w;}
__device__ __forceinline__ float clampf8(float x){return __builtin_fminf(__builtin_fmaxf(x,-448.f),448.f);}
template<int OSC> __device__ __forceinline__ void store8_f8(unsigned char*p,const u32x4&v){ float f[8];
  #pragma unroll
  for(int k=0;k<4;++k){f[2*k]=clampf8(__builtin_bit_cast(float,v[k]<<16)*(float)OSC);f[2*k+1]=clampf8(__builtin_bit_cast(float,v[k]&0xffff0000u)*(float)OSC);}
  *(u32x2_t*)p=(u32x2_t){pk4f8(f[0],f[1],f[2],f[3]),pk4f8(f[4],f[5],f[6],f[7])}; }
#ifndef ATTN_STORE16
#define ATTN_STORE16(p,v) (*(u32x4*)(p)=(v))
#endif
template<int THRL,int QP,int KP,int VP,int OP,int OSC,class Side> __device__ __forceinline__ void unit(const bf16*Qp,const bf16*__restrict__ Kp,const bf16*__restrict__ Vp,unsigned char*Op  ,float*ssq  ,int q0,__attribute__((address_space(3))) char*shm,const Side&side){
  int tid_=threadIdx.x; asm volatile("":"+v"(tid_));
  const int tid=tid_,lane=tid&63,r32=lane&31,hi=lane>>5; const int wid=__builtin_amdgcn_readfirstlane(tid>>6);
  const bf16*Qw=Qp+(long)(q0+wid*QBLK)*QP;
  const bf16*Kh=Kp,*Vh=Vp;
  const unsigned lds0=(unsigned)(uintptr_t)shm;
  __attribute__((address_space(3))) float*wsf=(__attribute__((address_space(3))) float*)(shm+LDS_WS)+wid*64;
  const unsigned koff=(unsigned)(lane*KP+wid*8)*2u;
  const unsigned voff=(unsigned)((16*(wid&3)+(lane>>2))*VP+(wid>>2)*32+(lane&3)*8)*2u;
  const unsigned kdst=lds0+LDS_K+wid*1024, vdst=lds0+LDS_V+wid*1024;
  #define DMA_K(t,slot) glds16s((const char*)Kh+(long)(t)*(KVBLK*KP*2),koff,(unsigned)__builtin_amdgcn_readfirstlane(kdst+(slot)))
  #define DMA_V(t,slot) glds16s((const char*)Vh+(long)(t)*(KVBLK*VP*2),voff,(unsigned)__builtin_amdgcn_readfirstlane(vdst+(slot)))
  const int vb0=(int)(lds0+LDS_V)+((lane>>4)&1)*32+(lane&3)*8+(4*hi+((lane&15)>>2))*64;
  const lds_cptr Kbase=(lds_cptr)shm+LDS_K; bf16x8 kf[8];
  const lds_cptr shm3=(lds_cptr)shm; const lds_cptr kp0=shm3+LDS_K+hi*1024+r32*16; const lds_cptr vp0=shm3+LDS_V+((lane>>4)&1)*32+(lane&3)*8+(4*hi+((lane&15)>>2))*64;
  constexpr int NT=SEQ/KVBLK;
  DMA_K(0,0);DMA_V(0,0);DMA_K(1,SLOTB);
  bf16x8 qr[4];
  #pragma unroll
  for(int d0=0;d0<4;++d0)qr[d0]=*reinterpret_cast<const bf16x8*>(&Qw[(long)r32*QP+d0*16+hi*8]);
  float mhat=0.f,l_reg=0.f;f32x16 o[2];o[0]=f32x16{};o[1]=f32x16{};f32x16 negm=f32x16{};asm volatile("":"+v"(negm));
  #define CMASK(P0,P1,t) do{}while(0)
  bool resc=false;
  #define START(P0,P1) do{ const float rm=rowmax(P0,P1); resc=false; \
    { const float dl=rm; mhat=fadd_s(mhat,dl); \
      _Pragma("unroll") for(int r=0;r<16;++r){P0[r]=fsub_s(P0[r],dl);P1[r]=fsub_s(P1[r],dl);} \
      _Pragma("unroll") for(int r=0;r<16;++r)negm[r]=-mhat; asm volatile("":"+v"(negm)); } \
    _Pragma("unroll") for(int r=0;r<16;++r)P0[r]=__builtin_amdgcn_exp2f(P0[r]); }while(0)
  #define RESC() do{ if(resc){ asm volatile("s_waitcnt lgkmcnt(0)":::"memory"); \
      _Pragma("unroll") for(int d_=0;d_<2;++d_) _Pragma("unroll") for(int r=0;r<16;++r)o[d_][r]*=wsf[crow(r,hi)]; } }while(0)
  f32x16 pA0,pA1,pB0,pB1;
  int sl_prev=0,sl_cur=0,sl_next=SLOTB;
  #define ROT() do{sl_prev=sl_cur;sl_cur=sl_next;sl_next=(sl_next==(NSLOT-1)*SLOTB)?0:sl_next+SLOTB;}while(0)
  DMA_K(2,2*SLOTB);
  side();
  WAIT_BAR(3);
  qkt(pA0,pA1,Kbase,qr,negm,r32,hi);asm volatile("s_nop 15\n\ts_nop 7":"+v"(pA0),"+v"(pA1));CMASK(pA0,pA1,0);
  START(pA0,pA1);
  _Pragma("unroll") for(int r=0;r<16;++r)pA1[r]=__builtin_amdgcn_exp2f(pA1[r]);
  WAIT_BAR(0);
  DMA_K(3,0);DMA_V(1,SLOTB);
  ROT();
  kload8(kf,kp0+sl_cur);
  WAIT_BAR(2);
  s16x4 vlo[8],vhi[8]; u32x4 pw0,pw1,pw2,pw3;
  #define PKW(P,B) cvtpk_s(P[B],P[B+1])
  #define PAF(k) __builtin_bit_cast(bf16x8,pw##k)
  #define VFR(i) (bf16x8){vlo[i][0],vlo[i][1],vlo[i][2],vlo[i][3],vhi[i][0],vhi[i][1],vhi[i][2],vhi[i][3]}
  #define PIN(x) asm volatile("":"+v"(x))
  #define MX3(a,b,c) __builtin_fmaxf(__builtin_fmaxf((a),(b)),(c))
  #define GAPA(MF,A0,A1,A2,A3,W0,W1,PW) do{ MF; sacc+=A0; sacc+=A1; sacc+=A2; sacc+=A3; PIN(sacc); W0; W1; PIN(PW); SBAR(); }while(0)
  #define EX(v) __builtin_amdgcn_exp2f(v)
  #define GAPB(MF,X,B) do{ MF; X[B]=EX(X[B]); X[B+1]=EX(X[B+1]); X[B+2]=EX(X[B+2]); X[B+3]=EX(X[B+3]); PIN(X); SBAR(); }while(0)
  #define VRD(i) do{ vlo[i]=vtr(vp_+(((i)>>2)*4096+((i)&3)*1024)); vhi[i]=vtr(vp_+(((i)>>2)*4096+((i)&3)*1024+512)); }while(0)
  #define KRD(G,j) do{ if(G){ kload2(kf,kp0+sl_next,j); SBAR(); } }while(0)
  #define STEP(C0,C1,P0,P1,t,GK,GV,GL) do{ SBAR(); \
    const lds_cptr vp_=vp0+sl_prev; \
    VRD(0); SBAR(); float sacc=(P0[0]+P0[1]); \
    GAPA(C0=__builtin_amdgcn_mfma_f32_32x32x16_bf16(kf[0],qr[0],negm,0,0,0), P0[2],P0[3],P0[4],P0[5],     pw0[0]=PKW(P0,0), pw0[1]=PKW(P0,2), pw0); \
    VRD(4); SBAR(); GAPA(C1=__builtin_amdgcn_mfma_f32_32x32x16_bf16(kf[1],qr[0],negm,0,0,0), P0[6],P0[7],P0[8],P0[9],     pw0[2]=PKW(P0,4), pw0[3]=PKW(P0,6), pw0); \
    VRD(1); SBAR(); GAPA(C0=__builtin_amdgcn_mfma_f32_32x32x16_bf16(kf[2],qr[1],C0,0,0,0),   P0[10],P0[11],P0[12],P0[13], pw1[0]=PKW(P0,8), pw1[1]=PKW(P0,10), pw1); \
    VRD(5); SBAR(); GAPA(C1=__builtin_amdgcn_mfma_f32_32x32x16_bf16(kf[3],qr[1],C1,0,0,0),   P0[14],P0[15],P1[0],P1[1],   pw1[2]=PKW(P0,12),pw1[3]=PKW(P0,14), pw1); \
    VRD(2); SBAR(); GAPA(C0=__builtin_amdgcn_mfma_f32_32x32x16_bf16(kf[4],qr[2],C0,0,0,0),   P1[2],P1[3],P1[4],P1[5],     pw2[0]=PKW(P1,0), pw2[1]=PKW(P1,2), pw2); \
    VRD(6); SBAR(); GAPA(C1=__builtin_amdgcn_mfma_f32_32x32x16_bf16(kf[5],qr[2],C1,0,0,0),   P1[6],P1[7],P1[8],P1[9],     pw2[2]=PKW(P1,4), pw2[3]=PKW(P1,6), pw2); \
    VRD(3); SBAR(); GAPA(C0=__builtin_amdgcn_mfma_f32_32x32x16_bf16(kf[6],qr[3],C0,0,0,0),   P1[10],P1[11],P1[12],P1[13], pw3[0]=PKW(P1,8), pw3[1]=PKW(P1,10), pw3); \
    VRD(7); SBAR(); GAPA(C1=__builtin_amdgcn_mfma_f32_32x32x16_bf16(kf[7],qr[3],C1,0,0,0),   P1[14],P1[15],0.f,0.f,       pw3[2]=PKW(P1,12),pw3[3]=PKW(P1,14), pw3); \
    l_reg+=sacc; \
    if(GK){DMA_K((t)+3,sl_cur);} if(GV){DMA_V((t)+1,sl_next);} \
    CMASK(C0,C1,t); \
    { float a=MX3(C0[0],C0[1],C1[0]),b=MX3(C0[2],C0[3],C1[1]); a=MX3(a,C1[2],C1[3]); \
      _Pragma("unroll") for(int r=4;r<16;r+=4){a=MX3(a,C0[r],C0[r+1]);b=MX3(b,C0[r+2],C0[r+3]);a=MX3(a,C1[r],C1[r+1]);b=MX3(b,C1[r+2],C1[r+3]);} \
      float rm=__builtin_fmaxf(a,b); { auto rr=__builtin_amdgcn_permlane32_swap(__float_as_uint(rm),__float_as_uint(rm),false,false); rm=__builtin_fmaxf(__uint_as_float(rr[0]),__uint_as_float(rr[1])); } \
      resc=false; \
      if(__builtin_expect(__any(rm>(float)THRL),0)){ const float dl=__builtin_fmaxf(rm,0.f); mhat+=dl; \
        _Pragma("unroll") for(int r=0;r<16;++r){C0[r]-=dl;C1[r]-=dl;} \
        _Pragma("unroll") for(int r=0;r<16;++r)negm[r]=-mhat; asm volatile("":"+v"(negm)); \
        const float f=__builtin_amdgcn_exp2f(-dl); l_reg*=f; if(hi==0)wsf[r32]=f; resc=true; } } \
    SBAR(); \
    GAPB(o[0]=__builtin_amdgcn_mfma_f32_32x32x16_bf16(PAF(0),VFR(0),o[0],0,0,0), C0,0); \
    GAPB(o[1]=__builtin_amdgcn_mfma_f32_32x32x16_bf16(PAF(0),VFR(4),o[1],0,0,0), C0,4); \
    KRD(GL,0); GAPB(o[0]=__builtin_amdgcn_mfma_f32_32x32x16_bf16(PAF(1),VFR(1),o[0],0,0,0), C0,8); \
    KRD(GL,1); GAPB(o[1]=__builtin_amdgcn_mfma_f32_32x32x16_bf16(PAF(1),VFR(5),o[1],0,0,0), C0,12); \
    KRD(GL,2); GAPB(o[0]=__builtin_amdgcn_mfma_f32_32x32x16_bf16(PAF(2),VFR(2),o[0],0,0,0), C1,0); \
    KRD(GL,3); GAPB(o[1]=__builtin_amdgcn_mfma_f32_32x32x16_bf16(PAF(2),VFR(6),o[1],0,0,0), C1,4); \
    GAPB(o[0]=__builtin_amdgcn_mfma_f32_32x32x16_bf16(PAF(3),VFR(3),o[0],0,0,0), C1,8); \
    GAPB(o[1]=__builtin_amdgcn_mfma_f32_32x32x16_bf16(PAF(3),VFR(7),o[1],0,0,0), C1,12); \
    }while(0)
  int t=1;
  #undef CMASK
  #define CMASK(P0,P1,t) do{}while(0)
  for(;t+5<NT;t+=2){
    STEP(pB0,pB1,pA0,pA1,t,true,true,true);     WAIT_BAR(2); RESC(); ROT();
    STEP(pA0,pA1,pB0,pB1,t+1,true,true,true);   WAIT_BAR(2); RESC(); ROT();
  }
  #undef CMASK
  #define CMASK(P0,P1,t) do{}while(0)
  #define ENDW(tt) do{ if((tt)+3<NT){WAIT_BAR(2);} else if((tt)+2<NT){WAIT_BAR(1);} else {WAIT_BAR(0);} }while(0)
  for(;t+1<NT;t+=2){
    STEP(pB0,pB1,pA0,pA1,t,(t+3<NT),(t+1<NT),(t+1<NT));       ENDW(t);   RESC(); ROT();
    STEP(pA0,pA1,pB0,pB1,t+1,(t+4<NT),(t+2<NT),(t+2<NT));     ENDW(t+1); RESC(); ROT();
  }
  STEP(pB0,pB1,pA0,pA1,NT-1,false,false,false); RESC();
  { float sacc=pB0[0]+pB0[1]; _Pragma("unroll") for(int r=2;r<16;++r)sacc+=pB0[r]; _Pragma("unroll") for(int r=0;r<16;++r)sacc+=pB1[r]; l_reg+=sacc;
    pw0=(u32x4){PKW(pB0,0),PKW(pB0,2),PKW(pB0,4),PKW(pB0,6)};pw1=(u32x4){PKW(pB0,8),PKW(pB0,10),PKW(pB0,12),PKW(pB0,14)};pw2=(u32x4){PKW(pB1,0),PKW(pB1,2),PKW(pB1,4),PKW(pB1,6)};pw3=(u32x4){PKW(pB1,8),PKW(pB1,10),PKW(pB1,12),PKW(pB1,14)};
    SBAR(); pv(o,vb0+sl_cur,PAF(0),PAF(1),PAF(2),PAF(3)); }
  #undef PKW
  #undef PAF
  #undef VFR
  #undef PIN
  #undef MX3
  #undef GAPA
  #undef GAPB
  #undef EX
  #undef VRD
  #undef KRD
  #undef STEP
  #undef ENDW
  {auto rr=__builtin_amdgcn_permlane32_swap(__float_as_uint(l_reg),__float_as_uint(l_reg),false,false);l_reg=__uint_as_float(rr[0])+__uint_as_float(rr[1]);}
  if(hi==0)wsf[32+r32]=l_reg;asm volatile("s_waitcnt lgkmcnt(0)":::"memory");
  float rli[16];
  #pragma unroll
  for(int r=0;r<16;++r)rli[r]=__builtin_amdgcn_rcpf(wsf[32+crow(r,hi)]);
  unsigned char*Ow=Op+(long)(q0+wid*QBLK)*OP; float*ssqw=ssq+(long)(q0+wid*QBLK)*16;
  { __attribute__((address_space(3))) unsigned short*stg=(__attribute__((address_space(3))) unsigned short*)(shm+LDS_OST)+wid*2048;
    #pragma unroll
    for(int r=0;r<16;++r){const int orow=crow(r,hi);
      #pragma unroll
      for(int d0=0;d0<2;++d0)stg[orow*64+d0*32+r32]=(unsigned short)(cvtpk_s(o[d0][r]*rli[r],0.f)&0xffffu);}
    asm volatile("s_waitcnt lgkmcnt(0)":::"memory");
    #pragma unroll
    for(int i=0;i<4;++i){const int row=i*8+(lane>>3),ch=lane&7; const u32x4 v=*(const __attribute__((address_space(3))) u32x4*)(stg+row*64+ch*8); store8_f8<OSC>(Ow+(long)row*OP+ch*8,v);
      float q_=0.f;
      #pragma unroll
      for(int k_=0;k_<4;++k_){const float lo_=__builtin_bit_cast(float,v[k_]<<16),hi_=__builtin_bit_cast(float,v[k_]&0xffff0000u); q_+=lo_*lo_+hi_*hi_;}
      q_+=dppf<0xB1>(q_); q_+=dppf<0x4E>(q_); q_+=dppf<0x141>(q_);
      if(ch==0) ssqw[(long)row*16]=q_; } }
  asm volatile("s_waitcnt lgkmcnt(0)\n\ts_barrier":::"memory");
  #undef DMA_K
  #undef DMA_V
  #undef CMASK
  #undef START
  #undef RESC
  #undef ROT
}

template<int THRL,int QP,int KP,int VP,int OP,int OSC> __device__ __forceinline__ void unitB(const bf16*Qp,const bf16*__restrict__ Kp,const bf16*__restrict__ Vp,unsigned char*Op  ,float*ssq  ,int q0,int t_lo,int NT,float slope2,float sink2,__attribute__((address_space(3))) char*shm){
  int tid_=threadIdx.x; asm volatile("":"+v"(tid_));
  const int tid=tid_,lane=tid&63,r32=lane&31,hi=lane>>5; const int wid=__builtin_amdgcn_readfirstlane(tid>>6);
  const bf16*Qw=Qp+(long)(q0+wid*QBLK)*QP;
  const bf16*Kh=Kp,*Vh=Vp;
  const unsigned lds0=(unsigned)(uintptr_t)shm;
  __attribute__((address_space(3))) float*wsf=(__attribute__((address_space(3))) float*)(shm+LDS_WS)+wid*64;
  const unsigned koff=(unsigned)(lane*KP+wid*8)*2u;
  const unsigned voff=(unsigned)((16*(wid&3)+(lane>>2))*VP+(wid>>2)*32+(lane&3)*8)*2u;
  const unsigned kdst=lds0+LDS_K+wid*1024, vdst=lds0+LDS_V+wid*1024;
  #define DMA_K(t,slot) glds16s((const char*)Kh+(long)(t_lo+(t))*(KVBLK*KP*2),koff,(unsigned)__builtin_amdgcn_readfirstlane(kdst+(slot)))
  #define DMA_V(t,slot) glds16s((const char*)Vh+(long)(t_lo+(t))*(KVBLK*VP*2),voff,(unsigned)__builtin_amdgcn_readfirstlane(vdst+(slot)))
  const int vb0=(int)(lds0+LDS_V)+((lane>>4)&1)*32+(lane&3)*8+(4*hi+((lane&15)>>2))*64;
  const lds_cptr Kbase=(lds_cptr)shm+LDS_K; bf16x8 kf[8];
  const lds_cptr shm3=(lds_cptr)shm; const lds_cptr kp0=shm3+LDS_K+hi*1024+r32*16; const lds_cptr vp0=shm3+LDS_V+((lane>>4)&1)*32+(lane&3)*8+(4*hi+((lane&15)>>2))*64;
  const int qrow=q0+wid*QBLK+r32;
  DMA_K(0,0);DMA_V(0,0);DMA_K(1,SLOTB);
  bf16x8 qr[4];
  #pragma unroll
  for(int d0=0;d0<4;++d0)qr[d0]=*reinterpret_cast<const bf16x8*>(&Qw[(long)r32*QP+d0*16+hi*8]);
  float mhat=0.f,l_reg=0.f;f32x16 o[2];o[0]=f32x16{};o[1]=f32x16{};f32x16 negm=f32x16{};asm volatile("":"+v"(negm));
  #define CMASK(P0,P1,t) do{ const float bl_=(float)(64*(t_lo+(t))+4*hi-qrow); _Pragma("unroll") for(int r=0;r<16;++r){ const float e0_=bl_+(float)((r&3)+8*(r>>2)), e1_=e0_+32.f; const float a0_=__builtin_fabsf(e0_), a1_=__builtin_fabsf(e1_); \
      P0[r]=(a0_<=128.f)?(P0[r]-slope2*a0_):-INFINITY; P1[r]=(a1_<=128.f)?(P1[r]-slope2*a1_):-INFINITY; } }while(0)
  bool resc=false;
  #define START(P0,P1) do{ const float rm=rowmax(P0,P1); resc=false; \
    { const float dl=__builtin_fmaxf(rm,-64.f); mhat=fadd_s(mhat,dl); \
      _Pragma("unroll") for(int r=0;r<16;++r){P0[r]=fsub_s(P0[r],dl);P1[r]=fsub_s(P1[r],dl);} \
      _Pragma("unroll") for(int r=0;r<16;++r)negm[r]=-mhat; asm volatile("":"+v"(negm)); } \
    _Pragma("unroll") for(int r=0;r<16;++r)P0[r]=__builtin_amdgcn_exp2f(P0[r]); }while(0)
  #define RESC() do{ if(resc){ asm volatile("s_waitcnt lgkmcnt(0)":::"memory"); \
      _Pragma("unroll") for(int d_=0;d_<2;++d_) _Pragma("unroll") for(int r=0;r<16;++r)o[d_][r]*=wsf[crow(r,hi)]; } }while(0)
  f32x16 pA0,pA1,pB0,pB1;
  int sl_prev=0,sl_cur=0,sl_next=SLOTB;
  #define ROT() do{sl_prev=sl_cur;sl_cur=sl_next;sl_next=(sl_next==(NSLOT-1)*SLOTB)?0:sl_next+SLOTB;}while(0)
  DMA_K(2,2*SLOTB);
  WAIT_BAR(3);
  qkt(pA0,pA1,Kbase,qr,negm,r32,hi);asm volatile("s_nop 15\n\ts_nop 7":"+v"(pA0),"+v"(pA1));CMASK(pA0,pA1,0);
  START(pA0,pA1);
  _Pragma("unroll") for(int r=0;r<16;++r)pA1[r]=__builtin_amdgcn_exp2f(pA1[r]);
  WAIT_BAR(0);
  DMA_K(3,0);DMA_V(1,SLOTB);
  ROT();
  kload8(kf,kp0+sl_cur);
  WAIT_BAR(2);
  s16x4 vlo[8],vhi[8]; u32x4 pw0,pw1,pw2,pw3;
  #define PKW(P,B) cvtpk_s(P[B],P[B+1])
  #define PAF(k) __builtin_bit_cast(bf16x8,pw##k)
  #define VFR(i) (bf16x8){vlo[i][0],vlo[i][1],vlo[i][2],vlo[i][3],vhi[i][0],vhi[i][1],vhi[i][2],vhi[i][3]}
  #define PIN(x) asm volatile("":"+v"(x))
  #define MX3(a,b,c) __builtin_fmaxf(__builtin_fmaxf((a),(b)),(c))
  #define GAPA(MF,A0,A1,A2,A3,W0,W1,PW) do{ MF; sacc+=A0; sacc+=A1; sacc+=A2; sacc+=A3; PIN(sacc); W0; W1; PIN(PW); SBAR(); }while(0)
  #define EX(v) __builtin_amdgcn_exp2f(v)
  #define GAPB(MF,X,B) do{ MF; X[B]=EX(X[B]); X[B+1]=EX(X[B+1]); X[B+2]=EX(X[B+2]); X[B+3]=EX(X[B+3]); PIN(X); SBAR(); }while(0)
  #define VRD(i) do{ vlo[i]=vtr(vp_+(((i)>>2)*4096+((i)&3)*1024)); vhi[i]=vtr(vp_+(((i)>>2)*4096+((i)&3)*1024+512)); }while(0)
  #define KRD(G,j) do{ if(G){ kload2(kf,kp0+sl_next,j); SBAR(); } }while(0)
  #define STEP(C0,C1,P0,P1,t,GK,GV,GL) do{ SBAR(); \
    const lds_cptr vp_=vp0+sl_prev; \
    VRD(0); SBAR(); float sacc=(P0[0]+P0[1]); \
    GAPA(C0=__builtin_amdgcn_mfma_f32_32x32x16_bf16(kf[0],qr[0],negm,0,0,0), P0[2],P0[3],P0[4],P0[5],     pw0[0]=PKW(P0,0), pw0[1]=PKW(P0,2), pw0); \
    VRD(4); SBAR(); GAPA(C1=__builtin_amdgcn_mfma_f32_32x32x16_bf16(kf[1],qr[0],negm,0,0,0), P0[6],P0[7],P0[8],P0[9],     pw0[2]=PKW(P0,4), pw0[3]=PKW(P0,6), pw0); \
    VRD(1); SBAR(); GAPA(C0=__builtin_amdgcn_mfma_f32_32x32x16_bf16(kf[2],qr[1],C0,0,0,0),   P0[10],P0[11],P0[12],P0[13], pw1[0]=PKW(P0,8), pw1[1]=PKW(P0,10), pw1); \
    VRD(5); SBAR(); GAPA(C1=__builtin_amdgcn_mfma_f32_32x32x16_bf16(kf[3],qr[1],C1,0,0,0),   P0[14],P0[15],P1[0],P1[1],   pw1[2]=PKW(P0,12),pw1[3]=PKW(P0,14), pw1); \
    VRD(2); SBAR(); GAPA(C0=__builtin_amdgcn_mfma_f32_32x32x16_bf16(kf[4],qr[2],C0,0,0,0),   P1[2],P1[3],P1[4],P1[5],     pw2[0]=PKW(P1,0), pw2[1]=PKW(P1,2), pw2); \
    VRD(6); SBAR(); GAPA(C1=__builtin_amdgcn_mfma_f32_32x32x16_bf16(kf[5],qr[2],C1,0,0,0),   P1[6],P1[7],P1[8],P1[9],     pw2[2]=PKW(P1,4), pw2[3]=PKW(P1,6), pw2); \
    VRD(3); SBAR(); GAPA(C0=__builtin_amdgcn_mfma_f32_32x32x16_bf16(kf[6],qr[3],C0,0,0,0),   P1[10],P1[11],P1[12],P1[13], pw3[0]=PKW(P1,8), pw3[1]=PKW(P1,10), pw3); \
    VRD(7); SBAR(); GAPA(C1=__builtin_amdgcn_mfma_f32_32x32x16_bf16(kf[7],qr[3],C1,0,0,0),   P1[14],P1[15],0.f,0.f,       pw3[2]=PKW(P1,12),pw3[3]=PKW(P1,14), pw3); \
    l_reg+=sacc; \
    if(GK){DMA_K((t)+3,sl_cur);} if(GV){DMA_V((t)+1,sl_next);} \
    CMASK(C0,C1,t); \
    { float a=MX3(C0[0],C0[1],C1[0]),b=MX3(C0[2],C0[3],C1[1]); a=MX3(a,C1[2],C1[3]); \
      _Pragma("unroll") for(int r=4;r<16;r+=4){a=MX3(a,C0[r],C0[r+1]);b=MX3(b,C0[r+2],C0[r+3]);a=MX3(a,C1[r],C1[r+1]);b=MX3(b,C1[r+2],C1[r+3]);} \
      float rm=__builtin_fmaxf(a,b); { auto rr=__builtin_amdgcn_permlane32_swap(__float_as_uint(rm),__float_as_uint(rm),false,false); rm=__builtin_fmaxf(__uint_as_float(rr[0]),__uint_as_float(rr[1])); } \
      resc=false; \
      if(__builtin_expect(__any(rm>(float)THRL),0)){ const float dl=__builtin_fmaxf(rm,0.f); mhat+=dl; \
        _Pragma("unroll") for(int r=0;r<16;++r){C0[r]-=dl;C1[r]-=dl;} \
        _Pragma("unroll") for(int r=0;r<16;++r)negm[r]=-mhat; asm volatile("":"+v"(negm)); \
        const float f=__builtin_amdgcn_exp2f(-dl); l_reg*=f; if(hi==0)wsf[r32]=f; resc=true; } } \
    SBAR(); \
    GAPB(o[0]=__builtin_amdgcn_mfma_f32_32x32x16_bf16(PAF(0),VFR(0),o[0],0,0,0), C0,0); \
    GAPB(o[1]=__builtin_amdgcn_mfma_f32_32x32x16_bf16(PAF(0),VFR(4),o[1],0,0,0), C0,4); \
    KRD(GL,0); GAPB(o[0]=__builtin_amdgcn_mfma_f32_32x32x16_bf16(PAF(1),VFR(1),o[0],0,0,0), C0,8); \
    KRD(GL,1); GAPB(o[1]=__builtin_amdgcn_mfma_f32_32x32x16_bf16(PAF(1),VFR(5),o[1],0,0,0), C0,12); \
    KRD(GL,2); GAPB(o[0]=__builtin_amdgcn_mfma_f32_32x32x16_bf16(PAF(2),VFR(2),o[0],0,0,0), C1,0); \
    KRD(GL,3); GAPB(o[1]=__builtin_amdgcn_mfma_f32_32x32x16_bf16(PAF(2),VFR(6),o[1],0,0,0), C1,4); \
    GAPB(o[0]=__builtin_amdgcn_mfma_f32_32x32x16_bf16(PAF(3),VFR(3),o[0],0,0,0), C1,8); \
    GAPB(o[1]=__builtin_amdgcn_mfma_f32_32x32x16_bf16(PAF(3),VFR(7),o[1],0,0,0), C1,12); \
    }while(0)
  int t=1;
  #undef CMASK
  #define CMASK(P0,P1,t) do{ const float bl_=(float)(64*(t_lo+(t))+4*hi-qrow); _Pragma("unroll") for(int r=0;r<16;++r){ const float e0_=bl_+(float)((r&3)+8*(r>>2)), e1_=e0_+32.f; const float a0_=__builtin_fabsf(e0_), a1_=__builtin_fabsf(e1_); \
      P0[r]=(a0_<=128.f)?(P0[r]-slope2*a0_):-INFINITY; P1[r]=(a1_<=128.f)?(P1[r]-slope2*a1_):-INFINITY; } }while(0)
  for(;t+5<NT;t+=2){
    STEP(pB0,pB1,pA0,pA1,t,true,true,true);     WAIT_BAR(2); RESC(); ROT();
    STEP(pA0,pA1,pB0,pB1,t+1,true,true,true);   WAIT_BAR(2); RESC(); ROT();
  }
  #undef CMASK
  #define CMASK(P0,P1,t) do{ const float bl_=(float)(64*(t_lo+(t))+4*hi-qrow); _Pragma("unroll") for(int r=0;r<16;++r){ const float e0_=bl_+(float)((r&3)+8*(r>>2)), e1_=e0_+32.f; const float a0_=__builtin_fabsf(e0_), a1_=__builtin_fabsf(e1_); \
      P0[r]=(a0_<=128.f)?(P0[r]-slope2*a0_):-INFINITY; P1[r]=(a1_<=128.f)?(P1[r]-slope2*a1_):-INFINITY; } }while(0)
  #define ENDW(tt) do{ if((tt)+3<NT){WAIT_BAR(2);} else if((tt)+2<NT){WAIT_BAR(1);} else {WAIT_BAR(0);} }while(0)
  for(;t+1<NT;t+=2){
    STEP(pB0,pB1,pA0,pA1,t,(t+3<NT),(t+1<NT),(t+1<NT));       ENDW(t);   RESC(); ROT();
    STEP(pA0,pA1,pB0,pB1,t+1,(t+4<NT),(t+2<NT),(t+2<NT));     ENDW(t+1); RESC(); ROT();
  }
  STEP(pB0,pB1,pA0,pA1,NT-1,false,false,false); RESC();
  { float sacc=pB0[0]+pB0[1]; _Pragma("unroll") for(int r=2;r<16;++r)sacc+=pB0[r]; _Pragma("unroll") for(int r=0;r<16;++r)sacc+=pB1[r]; l_reg+=sacc;
    pw0=(u32x4){PKW(pB0,0),PKW(pB0,2),PKW(pB0,4),PKW(pB0,6)};pw1=(u32x4){PKW(pB0,8),PKW(pB0,10),PKW(pB0,12),PKW(pB0,14)};pw2=(u32x4){PKW(pB1,0),PKW(pB1,2),PKW(pB1,4),PKW(pB1,6)};pw3=(u32x4){PKW(pB1,8),PKW(pB1,10),PKW(pB1,12),PKW(pB1,14)};
    SBAR(); pv(o,vb0+sl_cur,PAF(0),PAF(1),PAF(2),PAF(3)); }
  #undef PKW
  #undef PAF
  #undef VFR
  #undef PIN
  #undef MX3
  #undef GAPA
  #undef GAPB
  #undef EX
  #undef VRD
  #undef KRD
  #undef STEP
  #undef ENDW
  {auto rr=__builtin_amdgcn_permlane32_swap(__float_as_uint(l_reg),__float_as_uint(l_reg),false,false);l_reg=__uint_as_float(rr[0])+__uint_as_float(rr[1]);}
  l_reg+=__builtin_amdgcn_exp2f(sink2-mhat);
  if(hi==0)wsf[32+r32]=l_reg;asm volatile("s_waitcnt lgkmcnt(0)":::"memory");
  float rli[16];
  #pragma unroll
  for(int r=0;r<16;++r)rli[r]=__builtin_amdgcn_rcpf(wsf[32+crow(r,hi)]);
  unsigned char*Ow=Op+(long)(q0+wid*QBLK)*OP; float*ssqw=ssq+(long)(q0+wid*QBLK)*16;
  { __attribute__((address_space(3))) unsigned short*stg=(__attribute__((address_space(3))) unsigned short*)(shm+LDS_OST)+wid*2048;
    #pragma unroll
    for(int r=0;r<16;++r){const int orow=crow(r,hi);
      #pragma unroll
      for(int d0=0;d0<2;++d0)stg[orow*64+d0*32+r32]=(unsigned short)(cvtpk_s(o[d0][r]*rli[r],0.f)&0xffffu);}
    asm volatile("s_waitcnt lgkmcnt(0)":::"memory");
    #pragma unroll
    for(int i=0;i<4;++i){const int row=i*8+(lane>>3),ch=lane&7; const u32x4 v=*(const __attribute__((address_space(3))) u32x4*)(stg+row*64+ch*8); store8_f8<OSC>(Ow+(long)row*OP+ch*8,v);
      float q_=0.f;
      #pragma unroll
      for(int k_=0;k_<4;++k_){const float lo_=__builtin_bit_cast(float,v[k_]<<16),hi_=__builtin_bit_cast(float,v[k_]&0xffff0000u); q_+=lo_*lo_+hi_*hi_;}
      q_+=dppf<0xB1>(q_); q_+=dppf<0x4E>(q_); q_+=dppf<0x141>(q_);
      if(ch==0) ssqw[(long)row*16]=q_; } }
  asm volatile("s_waitcnt lgkmcnt(0)\n\ts_barrier":::"memory");
  #undef DMA_K
  #undef DMA_V
  #undef CMASK
  #undef START
  #undef RESC
  #undef ROT
}


__device__ __forceinline__ void qkt96(f32x16&p0,f32x16&p1,lds_cptr Kslot,const bf16x8*qr,const f32x16&negm,int r32,int hi){
  const lds_cptr kb=Kslot+hi*1024+r32*16;
  #pragma unroll
  for(int d0=0;d0<6;++d0){
    const bf16x8 b0=*(const __attribute__((address_space(3))) bf16x8*)(kb+d0*2048);
    const bf16x8 b1=*(const __attribute__((address_space(3))) bf16x8*)(kb+d0*2048+512);
    if(d0==0){p0=__builtin_amdgcn_mfma_f32_32x32x16_bf16(b0,qr[0],negm,0,0,0);p1=__builtin_amdgcn_mfma_f32_32x32x16_bf16(b1,qr[0],negm,0,0,0);}
    else{p0=__builtin_amdgcn_mfma_f32_32x32x16_bf16(b0,qr[d0],p0,0,0,0);p1=__builtin_amdgcn_mfma_f32_32x32x16_bf16(b1,qr[d0],p1,0,0,0);}}
}
__device__ __forceinline__ void kload12(bf16x8*kf,lds_cptr kp){
  #pragma unroll
  for(int j=0;j<6;++j){ kf[2*j]=*(const __attribute__((address_space(3))) bf16x8*)(kp+j*2048); kf[2*j+1]=*(const __attribute__((address_space(3))) bf16x8*)(kp+j*2048+512); }
}
template<int THRL,int QP,int KP,int VP,int OP,int OSC,class Side> __device__ __forceinline__ void unit96(const bf16*Qp,const bf16*__restrict__ Kp,const bf16*__restrict__ Vp,unsigned char*Op  ,float*ssq  ,int q0,__attribute__((address_space(3))) char*shm,const Side&side){
  int tid_=threadIdx.x; asm volatile("":"+v"(tid_));
  const int tid=tid_,lane=tid&63,r32=lane&31,hi=lane>>5; const int wid=__builtin_amdgcn_readfirstlane(tid>>6);
  const bf16*Qw=Qp+(long)(q0+wid*QBLK)*QP;
  const bf16*Kh=Kp,*Vh=Vp;
  constexpr int KSL=12288, L_K=0, L_V=3*KSL, L_WS=L_V+3*SLOTB, L_OST=L_WS+NW*64*4;
  const bool kx=wid<4;
  const unsigned lds0=(unsigned)(uintptr_t)shm;
  __attribute__((address_space(3))) float*wsf=(__attribute__((address_space(3))) float*)(shm+L_WS)+wid*64;
  const unsigned koff=(unsigned)(lane*KP+wid*8)*2u;
  const unsigned voff=(unsigned)((16*(wid&3)+(lane>>2))*VP+(wid>>2)*32+(lane&3)*8)*2u;
  const unsigned kdst=lds0+L_K+wid*1024, vdst=lds0+L_V+wid*1024;
  #define DMA_K(t,slot) do{ glds16s((const char*)Kh+(long)(t)*(KVBLK*KP*2),koff,(unsigned)__builtin_amdgcn_readfirstlane(kdst+(slot))); if(kx)glds16s((const char*)Kh+(long)(t)*(KVBLK*KP*2)+128,koff,(unsigned)__builtin_amdgcn_readfirstlane(kdst+(slot)+8192)); }while(0)
  #define DMA_V(t,slot) glds16s((const char*)Vh+(long)(t)*(KVBLK*VP*2),voff,(unsigned)__builtin_amdgcn_readfirstlane(vdst+(slot)))
  const int vb0=(int)(lds0+L_V)+((lane>>4)&1)*32+(lane&3)*8+(4*hi+((lane&15)>>2))*64;
  const lds_cptr Kbase=(lds_cptr)shm+L_K; bf16x8 kf[12];
  const lds_cptr shm3=(lds_cptr)shm; const lds_cptr kp0=shm3+L_K+hi*1024+r32*16; const lds_cptr vp0=shm3+L_V+((lane>>4)&1)*32+(lane&3)*8+(4*hi+((lane&15)>>2))*64;
  constexpr int NT=SEQ/KVBLK;
  DMA_K(0,0);DMA_V(0,0);DMA_K(1,KSL);
  bf16x8 qr[6];
  #pragma unroll
  for(int d0=0;d0<6;++d0)qr[d0]=*reinterpret_cast<const bf16x8*>(&Qw[(long)r32*QP+d0*16+hi*8]);
  float mhat=0.f,l_reg=0.f;f32x16 o[2];o[0]=f32x16{};o[1]=f32x16{};f32x16 negm=f32x16{};asm volatile("":"+v"(negm));
  #define CMASK(P0,P1,t) do{}while(0)
  bool resc=false;
  #define START(P0,P1) do{ const float rm=rowmax(P0,P1); resc=false; \
    { const float dl=rm; mhat=fadd_s(mhat,dl); \
      _Pragma("unroll") for(int r=0;r<16;++r){P0[r]=fsub_s(P0[r],dl);P1[r]=fsub_s(P1[r],dl);} \
      _Pragma("unroll") for(int r=0;r<16;++r)negm[r]=-mhat; asm volatile("":"+v"(negm)); } \
    _Pragma("unroll") for(int r=0;r<16;++r)P0[r]=__builtin_amdgcn_exp2f(P0[r]); }while(0)
  #define RESC() do{ if(resc){ asm volatile("s_waitcnt lgkmcnt(0)":::"memory"); \
      _Pragma("unroll") for(int d_=0;d_<2;++d_) _Pragma("unroll") for(int r=0;r<16;++r)o[d_][r]*=wsf[crow(r,hi)]; } }while(0)
  f32x16 pA0,pA1,pB0,pB1;
  int sl_prev=0,sl_cur=0,sl_next=SLOTB;
  int ks_cur=0,ks_next=KSL;
  #define ROT() do{sl_prev=sl_cur;sl_cur=sl_next;sl_next=(sl_next==(NSLOT-1)*SLOTB)?0:sl_next+SLOTB; ks_cur=ks_next;ks_next=(ks_next==(NSLOT-1)*KSL)?0:ks_next+KSL;}while(0)
  #define WB_KV() do{ if(kx){WAIT_BAR(3);}else{WAIT_BAR(2);} }while(0)
  DMA_K(2,2*KSL);
  side();
  WAIT_BAR(3);
  qkt96(pA0,pA1,Kbase,qr,negm,r32,hi);asm volatile("s_nop 15\n\ts_nop 7":"+v"(pA0),"+v"(pA1));CMASK(pA0,pA1,0);
  START(pA0,pA1);
  _Pragma("unroll") for(int r=0;r<16;++r)pA1[r]=__builtin_amdgcn_exp2f(pA1[r]);
  WAIT_BAR(0);
  DMA_K(3,0);DMA_V(1,SLOTB);
  ROT();
  kload12(kf,kp0+ks_cur);
  WB_KV();
  s16x4 vlo[8],vhi[8]; u32x4 pw0,pw1,pw2,pw3;
  #define PKW(P,B) cvtpk_s(P[B],P[B+1])
  #define PAF(k) __builtin_bit_cast(bf16x8,pw##k)
  #define VFR(i) (bf16x8){vlo[i][0],vlo[i][1],vlo[i][2],vlo[i][3],vhi[i][0],vhi[i][1],vhi[i][2],vhi[i][3]}
  #define PIN(x) asm volatile("":"+v"(x))
  #define MX3(a,b,c) __builtin_fmaxf(__builtin_fmaxf((a),(b)),(c))
  #define GAPA(MF,A0,A1,A2,A3,W0,W1,PW) do{ MF; sacc+=A0; sacc+=A1; sacc+=A2; sacc+=A3; PIN(sacc); W0; W1; PIN(PW); SBAR(); }while(0)
  #define EX(v) __builtin_amdgcn_exp2f(v)
  #define GAPB(MF,X,B) do{ MF; X[B]=EX(X[B]); X[B+1]=EX(X[B+1]); X[B+2]=EX(X[B+2]); X[B+3]=EX(X[B+3]); PIN(X); SBAR(); }while(0)
  #define VRD(i) do{ vlo[i]=vtr(vp_+(((i)>>2)*4096+((i)&3)*1024)); vhi[i]=vtr(vp_+(((i)>>2)*4096+((i)&3)*1024+512)); }while(0)
  #define KRD(G,j) do{ if(G){ kload2(kf,kp0+ks_next,j); SBAR(); } }while(0)
  #define STEP(C0,C1,P0,P1,t,GK,GV,GL) do{ SBAR(); \
    const lds_cptr vp_=vp0+sl_prev; \
    VRD(0); SBAR(); float sacc=(P0[0]+P0[1]); \
    GAPA(C0=__builtin_amdgcn_mfma_f32_32x32x16_bf16(kf[0],qr[0],negm,0,0,0), P0[2],P0[3],P0[4],P0[5],     pw0[0]=PKW(P0,0), pw0[1]=PKW(P0,2), pw0); \
    VRD(1); SBAR(); GAPA(C1=__builtin_amdgcn_mfma_f32_32x32x16_bf16(kf[1],qr[0],negm,0,0,0), P0[6],P0[7],P0[8],P0[9],     pw0[2]=PKW(P0,4), pw0[3]=PKW(P0,6), pw0); \
    VRD(2); SBAR(); GAPA(C0=__builtin_amdgcn_mfma_f32_32x32x16_bf16(kf[2],qr[1],C0,0,0,0),   P0[10],P0[11],P0[12],P0[13], pw1[0]=PKW(P0,8), pw1[1]=PKW(P0,10), pw1); \
    VRD(3); SBAR(); GAPA(C1=__builtin_amdgcn_mfma_f32_32x32x16_bf16(kf[3],qr[1],C1,0,0,0),   P0[14],P0[15],P1[0],P1[1],   pw1[2]=PKW(P0,12),pw1[3]=PKW(P0,14), pw1); \
    GAPA(C0=__builtin_amdgcn_mfma_f32_32x32x16_bf16(kf[4],qr[2],C0,0,0,0),   P1[2],P1[3],P1[4],P1[5],     pw2[0]=PKW(P1,0), pw2[1]=PKW(P1,2), pw2); \
    GAPA(C1=__builtin_amdgcn_mfma_f32_32x32x16_bf16(kf[5],qr[2],C1,0,0,0),   P1[6],P1[7],P1[8],P1[9],     pw2[2]=PKW(P1,4), pw2[3]=PKW(P1,6), pw2); \
    GAPA(C0=__builtin_amdgcn_mfma_f32_32x32x16_bf16(kf[6],qr[3],C0,0,0,0),   P1[10],P1[11],P1[12],P1[13], pw3[0]=PKW(P1,8), pw3[1]=PKW(P1,10), pw3); \
    GAPA(C1=__builtin_amdgcn_mfma_f32_32x32x16_bf16(kf[7],qr[3],C1,0,0,0),   P1[14],P1[15],0.f,0.f,       pw3[2]=PKW(P1,12),pw3[3]=PKW(P1,14), pw3); \
    VRD(4); SBAR(); C0=__builtin_amdgcn_mfma_f32_32x32x16_bf16(kf[8],qr[4],C0,0,0,0);  SBAR(); \
    VRD(5); SBAR(); C1=__builtin_amdgcn_mfma_f32_32x32x16_bf16(kf[9],qr[4],C1,0,0,0);  SBAR(); \
    VRD(6); SBAR(); C0=__builtin_amdgcn_mfma_f32_32x32x16_bf16(kf[10],qr[5],C0,0,0,0); SBAR(); \
    VRD(7); SBAR(); C1=__builtin_amdgcn_mfma_f32_32x32x16_bf16(kf[11],qr[5],C1,0,0,0); SBAR(); \
    l_reg+=sacc; \
    if(GK){DMA_K((t)+3,ks_cur);} if(GV){DMA_V((t)+1,sl_next);} \
    CMASK(C0,C1,t); \
    { float a=MX3(C0[0],C0[1],C1[0]),b=MX3(C0[2],C0[3],C1[1]); a=MX3(a,C1[2],C1[3]); \
      _Pragma("unroll") for(int r=4;r<16;r+=4){a=MX3(a,C0[r],C0[r+1]);b=MX3(b,C0[r+2],C0[r+3]);a=MX3(a,C1[r],C1[r+1]);b=MX3(b,C1[r+2],C1[r+3]);} \
      float rm=__builtin_fmaxf(a,b); { auto rr=__builtin_amdgcn_permlane32_swap(__float_as_uint(rm),__float_as_uint(rm),false,false); rm=__builtin_fmaxf(__uint_as_float(rr[0]),__uint_as_float(rr[1])); } \
      resc=false; \
      if(__builtin_expect(__any(rm>(float)THRL),0)){ const float dl=__builtin_fmaxf(rm,0.f); mhat+=dl; \
        _Pragma("unroll") for(int r=0;r<16;++r){C0[r]-=dl;C1[r]-=dl;} \
        _Pragma("unroll") for(int r=0;r<16;++r)negm[r]=-mhat; asm volatile("":"+v"(negm)); \
        const float f=__builtin_amdgcn_exp2f(-dl); l_reg*=f; if(hi==0)wsf[r32]=f; resc=true; } } \
    SBAR(); \
    GAPB(o[0]=__builtin_amdgcn_mfma_f32_32x32x16_bf16(PAF(0),VFR(0),o[0],0,0,0), C0,0); \
    GAPB(o[1]=__builtin_amdgcn_mfma_f32_32x32x16_bf16(PAF(0),VFR(4),o[1],0,0,0), C0,4); \
    KRD(GL,0); GAPB(o[0]=__builtin_amdgcn_mfma_f32_32x32x16_bf16(PAF(1),VFR(1),o[0],0,0,0), C0,8); \
    KRD(GL,1); GAPB(o[1]=__builtin_amdgcn_mfma_f32_32x32x16_bf16(PAF(1),VFR(5),o[1],0,0,0), C0,12); \
    KRD(GL,2); GAPB(o[0]=__builtin_amdgcn_mfma_f32_32x32x16_bf16(PAF(2),VFR(2),o[0],0,0,0), C1,0); \
    KRD(GL,3); GAPB(o[1]=__builtin_amdgcn_mfma_f32_32x32x16_bf16(PAF(2),VFR(6),o[1],0,0,0), C1,4); \
    KRD(GL,4); GAPB(o[0]=__builtin_amdgcn_mfma_f32_32x32x16_bf16(PAF(3),VFR(3),o[0],0,0,0), C1,8); \
    KRD(GL,5); GAPB(o[1]=__builtin_amdgcn_mfma_f32_32x32x16_bf16(PAF(3),VFR(7),o[1],0,0,0), C1,12); \
    }while(0)
  int t=1;
  #undef CMASK
  #define CMASK(P0,P1,t) do{}while(0)
  for(;t+5<NT;t+=2){
    STEP(pB0,pB1,pA0,pA1,t,true,true,true);     WB_KV(); RESC(); ROT();
    STEP(pA0,pA1,pB0,pB1,t+1,true,true,true);   WB_KV(); RESC(); ROT();
  }
  #undef CMASK
  #define CMASK(P0,P1,t) do{}while(0)
  #define ENDW(tt) do{ if((tt)+3<NT){WB_KV();} else if((tt)+2<NT){WAIT_BAR(1);} else {WAIT_BAR(0);} }while(0)
  for(;t+1<NT;t+=2){
    STEP(pB0,pB1,pA0,pA1,t,(t+3<NT),(t+1<NT),(t+1<NT));       ENDW(t);   RESC(); ROT();
    STEP(pA0,pA1,pB0,pB1,t+1,(t+4<NT),(t+2<NT),(t+2<NT));     ENDW(t+1); RESC(); ROT();
  }
  STEP(pB0,pB1,pA0,pA1,NT-1,false,false,false); RESC();
  { float sacc=pB0[0]+pB0[1]; _Pragma("unroll") for(int r=2;r<16;++r)sacc+=pB0[r]; _Pragma("unroll") for(int r=0;r<16;++r)sacc+=pB1[r]; l_reg+=sacc;
    pw0=(u32x4){PKW(pB0,0),PKW(pB0,2),PKW(pB0,4),PKW(pB0,6)};pw1=(u32x4){PKW(pB0,8),PKW(pB0,10),PKW(pB0,12),PKW(pB0,14)};pw2=(u32x4){PKW(pB1,0),PKW(pB1,2),PKW(pB1,4),PKW(pB1,6)};pw3=(u32x4){PKW(pB1,8),PKW(pB1,10),PKW(pB1,12),PKW(pB1,14)};
    SBAR(); pv(o,vb0+sl_cur,PAF(0),PAF(1),PAF(2),PAF(3)); }
  #undef PKW
  #undef PAF
  #undef VFR
  #undef PIN
  #undef MX3
  #undef GAPA
  #undef GAPB
  #undef EX
  #undef VRD
  #undef KRD
  #undef STEP
  #undef ENDW
  {auto rr=__builtin_amdgcn_permlane32_swap(__float_as_uint(l_reg),__float_as_uint(l_reg),false,false);l_reg=__uint_as_float(rr[0])+__uint_as_float(rr[1]);}
  if(hi==0)wsf[32+r32]=l_reg;asm volatile("s_waitcnt lgkmcnt(0)":::"memory");
  float rli[16];
  #pragma unroll
  for(int r=0;r<16;++r)rli[r]=__builtin_amdgcn_rcpf(wsf[32+crow(r,hi)]);
  unsigned char*Ow=Op+(long)(q0+wid*QBLK)*OP; float*ssqw=ssq+(long)(q0+wid*QBLK)*16;
  { __attribute__((address_space(3))) unsigned short*stg=(__attribute__((address_space(3))) unsigned short*)(shm+L_OST)+wid*2048;
    #pragma unroll
    for(int r=0;r<16;++r){const int orow=crow(r,hi);
      #pragma unroll
      for(int d0=0;d0<2;++d0)stg[orow*64+d0*32+r32]=(unsigned short)(cvtpk_s(o[d0][r]*rli[r],0.f)&0xffffu);}
    asm volatile("s_waitcnt lgkmcnt(0)":::"memory");
    #pragma unroll
    for(int i=0;i<4;++i){const int row=i*8+(lane>>3),ch=lane&7; const u32x4 v=*(const __attribute__((address_space(3))) u32x4*)(stg+row*64+ch*8); store8_f8<OSC>(Ow+(long)row*OP+ch*8,v);
      float q_=0.f;
      #pragma unroll
      for(int k_=0;k_<4;++k_){const float lo_=__builtin_bit_cast(float,v[k_]<<16),hi_=__builtin_bit_cast(float,v[k_]&0xffff0000u); q_+=lo_*lo_+hi_*hi_;}
      q_+=dppf<0xB1>(q_); q_+=dppf<0x4E>(q_); q_+=dppf<0x141>(q_);
      if(ch==0) ssqw[(long)row*16]=q_; } }
  asm volatile("s_waitcnt lgkmcnt(0)\n\ts_barrier":::"memory");
  #undef DMA_K
  #undef DMA_V
  #undef CMASK
  #undef START
  #undef RESC
  #undef ROT
  #undef WB_KV
}

#undef SBAR
#undef WAIT_BAR
}
constexpr int D = 1024, NBATCH = 8, SEQ = 8192, M = NBATCH * SEQ, DEPTH = 2;
constexpr int IN_W = 1696, IN_WP = 1792;
constexpr int NE = 256, NEX = 257, TOPK = 8;
constexpr int LCAP = 65536;
constexpr float EPS = 1e-6f;
constexpr float LOG2E = 1.4426950408889634f;
constexpr float C2A = 0.125f * LOG2E;
constexpr float C2C = 0.10206207261596575f * LOG2E;
constexpr int NWAVES = 8, NTHREADS = 512;

constexpr size_t MiB = 1u << 20;
constexpr size_t WS_CTL = 0, CTL_ZERO_BYTES = 1 * MiB;
constexpr size_t WS_MODV = 1 * MiB;
constexpr size_t WS_TABC = 2 * MiB, WS_TABS = 2 * MiB + 512 * 1024;
constexpr size_t WS_WC = 3 * MiB;
constexpr size_t WS_WR = 5 * MiB;
constexpr size_t WS_WIN = 6 * MiB;
constexpr size_t WS_WOUT = 13 * MiB;
constexpr size_t WS_TOPW = 18 * MiB;
constexpr size_t WS_W13 = 20 * MiB;
constexpr size_t WS_W2 = 277 * MiB;
constexpr size_t WS_LIST = 406 * MiB;
constexpr size_t WS_XN = 470 * MiB;
constexpr size_t WS_ACT = 598 * MiB;
constexpr size_t WS_PROJ = WS_ACT;
constexpr size_t WS_QA = WS_ACT + 224 * MiB;
constexpr size_t WS_KA = WS_QA + 48 * MiB;
constexpr size_t WS_VA = WS_KA + 16 * MiB;
constexpr size_t WS_QB = WS_VA + 16 * MiB;
constexpr size_t WS_KB = WS_QB + 48 * MiB;
constexpr size_t WS_VB = WS_KB + 16 * MiB;
constexpr size_t WS_CQK = WS_VB + 16 * MiB;
constexpr size_t WS_QC = WS_CQK + 48 * MiB;
constexpr size_t WS_KC = WS_QC + 48 * MiB;
constexpr size_t WS_VC = WS_KC + 48 * MiB;
constexpr size_t WS_MIX = WS_VC + 32 * MiB;
constexpr size_t WS_ATT_END = WS_MIX + 128 * MiB;
constexpr size_t WS_H = WS_ACT;
constexpr size_t WS_SSQ = 1728 * MiB;
constexpr size_t WS_XB = 1600 * MiB;
constexpr size_t WS_U2F = 1536 * MiB;
constexpr size_t WS_LOGITS = WS_ACT + 320 * MiB;
constexpr size_t WS_Y = WS_ACT + 384 * MiB;
constexpr size_t WS_END = WS_Y + 512 * MiB;
static_assert(WS_ATT_END <= WS_U2F && WS_END <= WS_U2F && WS_U2F + 64 * MiB <= WS_XB && WS_XB + 128 * MiB <= 2048 * MiB, "d_ws map");
constexpr int CW_BAR = 4096;
constexpr int CW_GCNT = 16384;

constexpr int RING_BYTES = 131072;
constexpr int LDSCTL_OFF = RING_BYTES, MISC_OFF = LDSCTL_OFF + 320;
constexpr int TAB_OFF = LDSCTL_OFF + 1024;
constexpr int LDS_BYTES = 147456;

#define GAS __attribute__((address_space(1)))
#define LAS __attribute__((address_space(3)))
typedef unsigned short bf16;
typedef unsigned v4u __attribute__((ext_vector_type(4)));
typedef unsigned v2u __attribute__((ext_vector_type(2)));
typedef float f32x4 __attribute__((ext_vector_type(4)));
typedef GAS unsigned gu32;
#define RLX_AGENT __ATOMIC_RELAXED, __HIP_MEMORY_SCOPE_AGENT
#define LDS_WAIT() asm volatile("s_waitcnt lgkmcnt(0)" ::: "memory")
#define VM_WAIT() asm volatile("s_waitcnt vmcnt(0)" ::: "memory")
__device__ __forceinline__ unsigned f2bf(float f) { unsigned u = __builtin_bit_cast(unsigned, f); return (u + 0x7fffu + ((u >> 16) & 1u)) >> 16; }
__device__ __forceinline__ unsigned pk2(float lo, float hi) { return f2bf(lo) | (f2bf(hi) << 16); }
__device__ __forceinline__ float bflo(unsigned w) { return __builtin_bit_cast(float, w << 16); }
__device__ __forceinline__ float bfhi(unsigned w) { return __builtin_bit_cast(float, w & 0xffff0000u); }
template <int K> __device__ __forceinline__ float sx(float v) { return __builtin_bit_cast(float, __builtin_amdgcn_ds_swizzle(__builtin_bit_cast(int, v), 0x1F | (K << 10))); }
template <int K> __device__ __forceinline__ int sxi(int v) { return __builtin_amdgcn_ds_swizzle(v, 0x1F | (K << 10)); }
template <int CTRL> __device__ __forceinline__ float dx(float v) { const int i = __builtin_bit_cast(int, v); return __builtin_bit_cast(float, __builtin_amdgcn_update_dpp(i, i, CTRL, 0xF, 0xF, false)); }
template <int CTRL> __device__ __forceinline__ int dxi(int v) { return __builtin_amdgcn_update_dpp(v, v, CTRL, 0xF, 0xF, false); }
__device__ __forceinline__ float red8(float v) { v += dx<0xB1>(v); v += dx<0x4E>(v); v += dx<0x141>(v); return v; }
__device__ __forceinline__ float red16(float v) { v = red8(v); v += dx<0x140>(v); return v; }
__device__ __forceinline__ float red32(float v) { v = red16(v); v += sx<16>(v); return v; }
__device__ __forceinline__ float wave_sum(float v) {
    v = red32(v);
    auto rr = __builtin_amdgcn_permlane32_swap(__float_as_uint(v), __float_as_uint(v), false, false);
    return __uint_as_float(rr[0]) + __uint_as_float(rr[1]);
}
__device__ __forceinline__ float fast_sigmoid(float x) { return __builtin_amdgcn_rcpf(1.f + __builtin_amdgcn_exp2f(-x * LOG2E)); }

#define XB_TMO      128
#define XB_XCNT(j)  (256  + 64 * (j))
#define XB_XSUB(j)  (1280 + 64 * (j))
#define XB_XGEN(j)  (2304 + 64 * (j))
#define XB_TOP      3328
#define XB_TOPGEN   3392
#define XCD_BAR_WORDS 3456
#define XB_SPIN_CAP (1u << 18)
__device__ __forceinline__ unsigned xb_ld(unsigned* p)              { return __hip_atomic_load(p, __ATOMIC_RELAXED, __HIP_MEMORY_SCOPE_AGENT); }
__device__ __forceinline__ unsigned xb_add(unsigned* p, unsigned v) { return __hip_atomic_fetch_add(p, v, __ATOMIC_RELAXED, __HIP_MEMORY_SCOPE_AGENT); }
__device__ __forceinline__ unsigned xb_xcc_id() { return (unsigned)__builtin_amdgcn_s_getreg((3 << 11) | 20) & 0xFu; }
#define XB_SPIN(cond, bar) do { unsigned _sp = 0; while (cond) { __builtin_amdgcn_s_sleep(1); \
    if ((++_sp & 255u) == 0u) { if (xb_ld(&(bar)[XB_TMO])) break; if (_sp > XB_SPIN_CAP) { atomicAdd(&(bar)[XB_TMO], 1u); break; } } } } while (0)
struct XcdBarrier { unsigned* bar; unsigned x; volatile LAS unsigned* st; };
__device__ __forceinline__ XcdBarrier xcd_barrier_post(unsigned* bar, volatile LAS unsigned* st) {
    XcdBarrier b; b.bar = bar; b.x = xb_xcc_id(); b.st = st;
    if (threadIdx.x == 0) (void)xb_add(&bar[XB_XCNT(b.x)], 1u);
    return b;
}
__device__ __forceinline__ void xcd_barrier_complete(unsigned* bar, unsigned x, unsigned& nloc, unsigned& nx) {
    const unsigned G = gridDim.x * gridDim.y * gridDim.z;
    unsigned sum, cnt, mine, sp = 0u;
    for (;;) {
        sum = 0u; cnt = 0u; mine = 0u;
#pragma unroll
        for (unsigned j = 0; j < 16; ++j) { const unsigned c = xb_ld(&bar[XB_XCNT(j)]); sum += c; cnt += (c > 0u) ? 1u : 0u; mine = (j == x) ? c : mine; }
        if (sum == G) break;
        __builtin_amdgcn_s_sleep(1);
        if ((++sp & 255u) == 0u) { if (xb_ld(&bar[XB_TMO])) break; if (sp > XB_SPIN_CAP) { atomicAdd(&bar[XB_TMO], 1u); break; } }
    }
    nloc = mine > 0u ? mine : 1u; nx = cnt > 0u ? cnt : 1u;
}
__device__ __forceinline__ void xcd_barrier(const XcdBarrier& b) {
    asm volatile("s_waitcnt vmcnt(0)" ::: "memory");
    __syncthreads();
    if (threadIdx.x == 0) {
        unsigned* bar = b.bar;
        __builtin_amdgcn_s_waitcnt(0);
        unsigned nloc = b.st[0], nx = b.st[1];
        if (nloc == 0u) { xcd_barrier_complete(bar, b.x, nloc, nx); b.st[0] = nloc; b.st[1] = nx; }
        const unsigned old = xb_add(&bar[XB_XSUB(b.x)], 1u);
        const unsigned gen = old / nloc;
        if (old + 1u == (gen + 1u) * nloc) {
            __builtin_amdgcn_fence(__ATOMIC_RELEASE, "agent");
            asm volatile("s_waitcnt vmcnt(0)" ::: "memory");
            const unsigned og = xb_add(&bar[XB_TOP], 1u);
            const unsigned tg = og / nx;
            if (og + 1u == (tg + 1u) * nx) xb_add(&bar[XB_TOPGEN], 1u);
            else XB_SPIN(xb_ld(&bar[XB_TOPGEN]) == tg, bar);
            __builtin_amdgcn_fence(__ATOMIC_ACQUIRE, "agent");
            xb_add(&bar[XB_XGEN(b.x)], 1u);
            asm volatile("s_waitcnt vmcnt(0)" ::: "memory");
        } else {
            XB_SPIN(xb_ld(&bar[XB_XGEN(b.x)]) == gen, bar);
            __builtin_amdgcn_fence(__ATOMIC_ACQUIRE, "agent");
            asm volatile("s_waitcnt vmcnt(0)" ::: "memory");
        }
    }
    __syncthreads();
}
constexpr size_t WS_DRY0 = 1792ull << 20, WS_DRY1 = 1920ull << 20;
#define DRY(p) (NREP(p) == 2 && rep_ == 0)
#ifndef REP_MASK
#define REP_MASK 0
#endif
#define NREP(p) ((((REP_MASK) >> (p)) & 1) ? 2 : 1)
enum InIdx { I_X = 0, I_C, I_MODW, I_MODB, I_N1G, I_N2G, I_WIN, I_AQG, I_AKG, I_BSINK, I_CQG, I_CKVG, I_WUQ, I_WUK, I_WUV, I_ONG, I_WOUT, I_RW, I_RB, I_EW1, I_EW3, I_EW2, I_SW1, I_SW3, I_SW2, I_FG, N_IN };
struct Args { const float* in[N_IN]; float* out; unsigned char* ws; int ph_lo, ph_hi; };
constexpr int PH_PER_LAYER = 13, N_PHASES = 1 + PH_PER_LAYER * DEPTH;

typedef __attribute__((address_space(4))) const Args* KArgs;
__device__ __forceinline__ KArgs kargs() { KArgs p = (KArgs)__builtin_amdgcn_kernarg_segment_ptr(); asm volatile("" : "+s"(p)); return p; }
struct Ctx {
    LAS unsigned char* lds; unsigned char* ws;
    int tid, lane, wave, G, vcu, gw, NGW;
};

__device__ __forceinline__ void tr_item(const float* W, int N, bf16* WT, int ldk, int koff, int drow0, LAS float* scr, int k0, int n0, int lane, const float* ks = nullptr  ) {
    float tv[32];
#pragma unroll
    for (int i = 0; i < 32; ++i) { const int kk = 2 * i + (lane >> 5); tv[i] = __builtin_nontemporal_load(W + (size_t)(k0 + kk) * N + n0 + (lane & 31)); }
#pragma unroll
    for (int i = 0; i < 32; ++i) { const int kk = 2 * i + (lane >> 5); scr[kk * 33 + (lane & 31)] = tv[i] * (ks ? ks[k0 + kk] : 1.f); }
    LDS_WAIT(); asm volatile("" ::: "memory");
    const int c = lane & 7;
#pragma unroll
    for (int j = 0; j < 4; ++j) { const int n = (lane >> 3) + 8 * j; const LAS float* s = scr + (8 * c) * 33 + n;
        v4u o; o.x = pk2(s[0 * 33], s[1 * 33]); o.y = pk2(s[2 * 33], s[3 * 33]); o.z = pk2(s[4 * 33], s[5 * 33]); o.w = pk2(s[6 * 33], s[7 * 33]);
        *(GAS v4u*)(WT + (size_t)(drow0 + n) * ldk + koff + k0 + 8 * c) = o; }
    LDS_WAIT(); asm volatile("" ::: "memory");
}
__device__ __forceinline__ unsigned pk4_fp8(float a, float b, float c, float d) { int w = 0; w = __builtin_amdgcn_cvt_pk_fp8_f32(a, b, w, false); w = __builtin_amdgcn_cvt_pk_fp8_f32(c, d, w, true); return (unsigned)w; }
__device__ __forceinline__ void tr_load(const float* W, int N, int k0, int n0, int lane, float (&tv)[32]) {
#pragma unroll
    for (int i = 0; i < 32; ++i) { const int kk = 2 * i + (lane >> 5); tv[i] = __builtin_nontemporal_load(W + (size_t)(k0 + kk) * N + n0 + (lane & 31)); }
}
__device__ __forceinline__ void tr_store_f8(const float (&tv)[32], unsigned char* WT, int ldk, int drow0, float sc, LAS float* scr, int k0, int lane, const float* ks = nullptr  ) {
#pragma unroll
    for (int i = 0; i < 32; ++i) { const int kk = 2 * i + (lane >> 5); scr[kk * 33 + (lane & 31)] = tv[i] * (ks ? ks[k0 + kk] : 1.f); }
    LDS_WAIT(); asm volatile("" ::: "memory");
    const int c = lane & 7;
#pragma unroll
    for (int j = 0; j < 4; ++j) { const int n = (lane >> 3) + 8 * j; const LAS float* s = scr + (8 * c) * 33 + n;
        v2u o; o.x = pk4_fp8(s[0 * 33] * sc, s[1 * 33] * sc, s[2 * 33] * sc, s[3 * 33] * sc); o.y = pk4_fp8(s[4 * 33] * sc, s[5 * 33] * sc, s[6 * 33] * sc, s[7 * 33] * sc);
        *(GAS v2u*)(WT + (size_t)(drow0 + n) * ldk + k0 + 8 * c) = o; }
    LDS_WAIT(); asm volatile("" ::: "memory");
}
__device__ __forceinline__ void tr_item_f8(const float* W, int N, unsigned char* WT, int ldk, int drow0, float sc, LAS float* scr, int k0, int n0, int lane, const float* ks = nullptr) {
    float tv[32]; tr_load(W, N, k0, n0, lane, tv); tr_store_f8(tv, WT, ldk, drow0, sc, scr, k0, lane, ks);
}
constexpr float SC_W13 = 64.f, SC_W2 = 32.f, SC_H = 8.f;
constexpr int SC_MIXA = 256, SC_MIXB = 32, SC_MIXC = 256; constexpr float SC_WO = 64.f;
struct ExpItem { const float* src; unsigned char* dst; int N, ldk, drow0, k0, n0; float sc; };
__device__ __forceinline__ ExpItem expert_item(const KArgs ap, unsigned char* ws, int l, int it) {
    ExpItem x; const int e = it / 384, r = it % 384, which = r >> 7, q = r & 127;
    if (which < 2) {
        const float* ew = which == 0 ? ap->in[I_EW1] : ap->in[I_EW3]; const float* sw = which == 0 ? ap->in[I_SW1] : ap->in[I_SW3];
        x.src = (e < NE) ? ew + (size_t)(l * NE + e) * 262144 : sw + (size_t)l * 262144;
        const int kb = q >> 3, nb = q & 7;
        x.dst = ws + WS_W13 + (size_t)e * 524288; x.N = 256; x.ldk = 1024; x.drow0 = (nb >> 2) * 256 + (nb & 3) * 32 + which * 128; x.k0 = kb * 64; x.n0 = nb * 32; x.sc = SC_W13;
    } else {
        x.src = (e < NE) ? ap->in[I_EW2] + (size_t)(l * NE + e) * 262144 : ap->in[I_SW2] + (size_t)l * 262144;
        const int kb = q >> 5, nb = q & 31;
        x.dst = ws + WS_W2 + (size_t)e * 262144; x.N = 1024; x.ldk = 256; x.drow0 = nb * 32; x.k0 = kb * 64; x.n0 = nb * 32; x.sc = SC_W2;
    }
    return x;
}
__device__ __forceinline__ void convert_experts(const Ctx& c, int l) {
    LAS float* scr = (LAS float*)(c.lds + c.wave * 16384);
    const KArgs ap = kargs();
    constexpr int NIT = NEX * 384;
    for (int it = c.gw; it < NIT; it += 2 * c.NGW) {
        const ExpItem a0 = expert_item(ap, c.ws, l, it); const bool two = it + c.NGW < NIT; const ExpItem a1 = expert_item(ap, c.ws, l, two ? it + c.NGW : it);
        float t0[32], t1[32];
        tr_load(a0.src, a0.N, a0.k0, a0.n0, c.lane, t0); tr_load(a1.src, a1.N, a1.k0, a1.n0, c.lane, t1);
        tr_store_f8(t0, a0.dst, a0.ldk, a0.drow0, a0.sc, scr, a0.k0, c.lane);
        if (two) tr_store_f8(t1, a1.dst, a1.ldk, a1.drow0, a1.sc, scr, a1.k0, c.lane);
    }
}
__device__ __forceinline__ void tr_store_f8_half(const float (&tv)[32], int half, unsigned char* WT, int ldk, int drow0, float sc, LAS float* scr, int k0, int lane) {
#pragma unroll
    for (int i = 0; i < 16; ++i) { const int kk = 2 * i + (lane >> 5); scr[kk * 33 + (lane & 31)] = tv[16 * half + i]; }
    LDS_WAIT(); asm volatile("" ::: "memory");
    const int c = lane & 3;
#pragma unroll
    for (int j = 0; j < 2; ++j) { const int n = (lane >> 2) + 16 * j; const LAS float* s = scr + (8 * c) * 33 + n;
        v2u o; o.x = pk4_fp8(s[0 * 33] * sc, s[1 * 33] * sc, s[2 * 33] * sc, s[3 * 33] * sc); o.y = pk4_fp8(s[4 * 33] * sc, s[5 * 33] * sc, s[6 * 33] * sc, s[7 * 33] * sc);
        *(GAS v2u*)(WT + (size_t)(drow0 + n) * ldk + k0 + 32 * half + 8 * c) = o; }
    LDS_WAIT(); asm volatile("" ::: "memory");
}
struct ExpItem2 { const float* src; unsigned char* dst; int N, ldk; float sc; };
__device__ __forceinline__ ExpItem2 expert_item2(const KArgs ap, unsigned char* ws, int l, int it) {
    ExpItem2 x; const int e = it / 192, r = it % 192, which = r >> 6, q = r & 63;
    if (which < 2) {
        const float* ew = which == 0 ? ap->in[I_EW1] : ap->in[I_EW3]; const float* sw = which == 0 ? ap->in[I_SW1] : ap->in[I_SW3];
        const float* base = (e < NE) ? ew + (size_t)(l * NE + e) * 262144 : sw + (size_t)l * 262144;
        const int k0 = (q >> 3) * 128, n0 = (q & 7) * 32;
        x.N = 256; x.ldk = 1024; x.sc = SC_W13; x.src = base + (size_t)k0 * 256 + n0;
        x.dst = ws + WS_W13 + (size_t)e * 524288 + (size_t)((n0 >> 7) * 256 + which * 128 + (n0 & 127)) * 1024 + k0;
    } else {
        const float* base = (e < NE) ? ap->in[I_EW2] + (size_t)(l * NE + e) * 262144 : ap->in[I_SW2] + (size_t)l * 262144;
        const int k0 = (q >> 5) * 128, n0 = (q & 31) * 32;
        x.N = 1024; x.ldk = 256; x.sc = SC_W2; x.src = base + (size_t)k0 * 1024 + n0;
        x.dst = ws + WS_W2 + (size_t)e * 262144 + (size_t)n0 * 256 + k0;
    }
    return x;
}
__device__ __forceinline__ void cvt_item_load(const ExpItem2& a, int lane, f32x4 (&v)[4][4]) {
    const float* p = a.src + (size_t)(16 * (lane >> 3)) * a.N + 4 * (lane & 7);
#pragma unroll
    for (int s_ = 0; s_ < 4; ++s_)
#pragma unroll
        for (int i = 0; i < 4; ++i) v[s_][i] = __builtin_nontemporal_load((const GAS f32x4*)(p + (size_t)(4 * s_ + i) * a.N));
}
__device__ __forceinline__ void cvt_item_store(const ExpItem2& a, int lane, const f32x4 (&v)[4][4]) {
    unsigned char* d = a.dst + (size_t)(4 * (lane & 7)) * a.ldk + 16 * (lane >> 3); const float sc = a.sc;
#pragma unroll
    for (int j = 0; j < 4; ++j) { v4u o;
        o.x = pk4_fp8(v[0][0][j] * sc, v[0][1][j] * sc, v[0][2][j] * sc, v[0][3][j] * sc); o.y = pk4_fp8(v[1][0][j] * sc, v[1][1][j] * sc, v[1][2][j] * sc, v[1][3][j] * sc);
        o.z = pk4_fp8(v[2][0][j] * sc, v[2][1][j] * sc, v[2][2][j] * sc, v[2][3][j] * sc); o.w = pk4_fp8(v[3][0][j] * sc, v[3][1][j] * sc, v[3][2][j] * sc, v[3][3][j] * sc);
        *(GAS v4u*)(d + (size_t)j * a.ldk) = o; }
}
__device__ __forceinline__ void convert_experts_part(const Ctx& c, int l, int part, int nparts) {
    const KArgs ap = kargs();
    constexpr int NIT = NEX * 192;
    const int K = (NIT - c.gw + 2 * c.NGW - 1) / (2 * c.NGW); const int k_lo = (int)((long)part * K / nparts), k_hi = (int)((long)(part + 1) * K / nparts);
    for (int k = k_lo; k < k_hi; ++k) { const int it = c.gw + k * 2 * c.NGW;
        const bool two = it + c.NGW < NIT;
        const ExpItem2 a0 = expert_item2(ap, c.ws, l, it), a1 = expert_item2(ap, c.ws, l, two ? it + c.NGW : it);
        f32x4 v0[4][4], v1[4][4];
        cvt_item_load(a0, c.lane, v0); cvt_item_load(a1, c.lane, v1);
        cvt_item_store(a0, c.lane, v0); if (two) cvt_item_store(a1, c.lane, v1);
    }
    VM_WAIT();
}
__device__ __forceinline__ void zero_rect(const Ctx& c, bf16* base, int ld, int r0, int nr, int c0, int nc) {
    const int cpr = nc / 8, total = nr * cpr;
    for (int i = c.gw * 64 + c.lane; i < total; i += c.NGW * 64) { const int r = i / cpr, cc = i % cpr; *(GAS v4u*)(base + (size_t)(r0 + r) * ld + c0 + cc * 8) = (v4u){0u, 0u, 0u, 0u}; }
}
__device__ __forceinline__ void prologue(const Ctx& c) {
    const KArgs ap = kargs(); const auto& a = *ap;
    for (int item = blockIdx.x; item < DEPTH * 128; item += c.G) {
        const int l = item / 128, grp = item % 128;
        LAS float* cact = (LAS float*)c.lds; LAS float* part = cact + 8192;
        for (int i = c.tid; i < 8192; i += NTHREADS) { const float v = a.in[I_C][i]; cact[i] = v * fast_sigmoid(v); }
        __syncthreads();
        const int col = grp * 48 + (c.lane < 48 ? c.lane : 47); const float* W = a.in[I_MODW] + (size_t)l * 1024 * 6144 + col;
        float acc[8];
#pragma unroll
        for (int b = 0; b < 8; ++b) acc[b] = 0.f;
#pragma unroll 16
        for (int d = c.wave * 128; d < c.wave * 128 + 128; ++d) { const float w = __builtin_nontemporal_load(W + (size_t)d * 6144);
#pragma unroll
            for (int b = 0; b < 8; ++b) acc[b] += cact[b * 1024 + d] * w; }
#pragma unroll
        for (int b = 0; b < 8; ++b) part[(c.wave * 8 + b) * 64 + c.lane] = acc[b];
        __syncthreads();
        { const int b = c.wave; float s = a.in[I_MODB][l * 6144 + col];
#pragma unroll
          for (int w = 0; w < 8; ++w) s += part[(w * 8 + b) * 64 + c.lane];
          if (c.lane < 48) ((float*)(c.ws + WS_MODV))[(size_t)(l * 8 + b) * 6144 + col] = s; }
        __syncthreads();
    }
    { float* TC = (float*)(c.ws + WS_TABC); float* TS = (float*)(c.ws + WS_TABS);
      for (int idx = c.gw * 64 + c.lane; idx < 8192 * 16; idx += c.NGW * 64) { const int p = idx >> 4, j = idx & 15;
          const double inv = exp2(-(double)j * (13.287712379549449 / 16.0)); double rev = (double)p * inv * 0.15915494309189535; rev -= rint(rev);
          TC[idx] = __builtin_amdgcn_cosf((float)rev); TS[idx] = __builtin_amdgcn_sinf((float)rev); } }
    __syncthreads();
    { LAS float* scr = (LAS float*)(c.lds + c.wave * 16384);
      constexpr int I0 = 16 * 53, I1 = I0 + 16 * 32, I2 = I1 + 16 * 8, I3 = I2 + 4 * 12, I4 = I3 + 2 * 8, I5 = I4 + 2 * 8;
      for (int it = c.gw; it < DEPTH * I5; it += c.NGW) {
          const int l = it / I5; int r = it % I5;
          if (r < I0) { tr_item(a.in[I_WIN] + (size_t)l * 1024 * IN_W, IN_W, (bf16*)(c.ws + WS_WIN) + (size_t)l * IN_WP * 1024, 1024, 0, (r % 53) * 32, scr, (r / 53) * 64, (r % 53) * 32, c.lane); continue; } r -= I0;
          if (r < 16 * 32) { tr_item_f8(a.in[I_WOUT] + (size_t)l * 1024 * 1024, 1024, c.ws + WS_WOUT + (size_t)l * 1024 * 1024, 1024, (r & 31) * 32, SC_WO, scr, (r >> 5) * 64, (r & 31) * 32, c.lane, a.in[I_ONG] + l * 1024); continue; } r -= 16 * 32;
          if (r < 16 * 8) { tr_item(a.in[I_RW] + (size_t)l * 1024 * 256, 256, (bf16*)(c.ws + WS_WR) + (size_t)l * 256 * 1024, 1024, 0, (r & 7) * 32, scr, (r >> 3) * 64, (r & 7) * 32, c.lane); continue; } r -= 16 * 8;
          bf16* WC = (bf16*)(c.ws + WS_WC) + (size_t)l * 1024 * 384;
          if (r < 48) { tr_item(a.in[I_WUQ] + (size_t)l * 256 * 384, 384, WC, 384, 0, (r % 12) * 32, scr, (r / 12) * 64, (r % 12) * 32, c.lane); continue; } r -= 48;
          if (r < 16) { tr_item(a.in[I_WUK] + (size_t)l * 128 * 256, 256, WC, 384, 256, 384 + (r & 7) * 32, scr, (r >> 3) * 64, (r & 7) * 32, c.lane); continue; } r -= 16;
          tr_item(a.in[I_WUV] + (size_t)l * 128 * 256, 256, WC, 384, 256, 640 + (r & 7) * 32, scr, (r >> 3) * 64, (r & 7) * 32, c.lane);
      }
      for (int l = 0; l < DEPTH; ++l) {
          zero_rect(c, (bf16*)(c.ws + WS_WIN) + (size_t)l * IN_WP * 1024, 1024, IN_W, IN_WP - IN_W, 0, 1024);
          bf16* WC = (bf16*)(c.ws + WS_WC) + (size_t)l * 1024 * 384;
          zero_rect(c, WC, 384, 0, 384, 256, 128); zero_rect(c, WC, 384, 384, 512, 0, 256); zero_rect(c, WC, 384, 896, 128, 0, 384);
      } }
}

template <bool SRC_F32>
__device__ __forceinline__ void norm_mod_rows(const Ctx& c, const void* X, bf16* Y, unsigned char* Y8  , const float* g, const float* modv  , int i_shift, int i_scale) {
    constexpr int NRF = 4;
    for (int m0 = c.gw; m0 < M; m0 += NRF * c.NGW) {
        f32x4 v[NRF][4]; float s[NRF];
#pragma unroll
        for (int u = 0; u < NRF; ++u) { const int m = m0 + u * c.NGW; const size_t ro = (size_t)(m < M ? m : m0) * D;
            if constexpr (SRC_F32) { const GAS f32x4* xr = (const GAS f32x4*)((const float*)X + ro) + c.lane;
#pragma unroll
                for (int j = 0; j < 4; ++j) v[u][j] = __builtin_nontemporal_load(xr + 64 * j); }
            else { const GAS v2u* xr = (const GAS v2u*)((const bf16*)X + ro) + c.lane;
#pragma unroll
                for (int j = 0; j < 4; ++j) { const v2u w = xr[64 * j]; v[u][j] = (f32x4){bflo(w.x), bfhi(w.x), bflo(w.y), bfhi(w.y)}; } } }
#pragma unroll
        for (int u = 0; u < NRF; ++u) { float q = 0.f;
#pragma unroll
            for (int j = 0; j < 4; ++j) q += (v[u][j].x * v[u][j].x + v[u][j].y * v[u][j].y) + (v[u][j].z * v[u][j].z + v[u][j].w * v[u][j].w);
            s[u] = q; }
#pragma unroll
        for (int u = 0; u < NRF; ++u) { const int m = m0 + u * c.NGW; if (m >= M) break;
            const int b = m >> 13; const float rstd = 1.f / sqrtf(wave_sum(s[u]) * (1.f / D) + EPS);
            const f32x4* gp = (const f32x4*)g + c.lane; const f32x4* scp = (const f32x4*)(modv + (size_t)(b * 6 + i_scale) * 1024) + c.lane; const f32x4* shp = (const f32x4*)(modv + (size_t)(b * 6 + i_shift) * 1024) + c.lane;
            GAS v2u* o8 = (GAS v2u*)(Y + (size_t)m * D) + c.lane;
#pragma unroll
            for (int j = 0; j < 4; ++j) { const f32x4 gg = gp[64 * j], sc = scp[64 * j], sh = shp[64 * j]; const f32x4 y = v[u][j] * rstd * gg * (sc + 1.f) + sh;
                o8[64 * j] = (v2u){pk2(y.x, y.y), pk2(y.z, y.w)};
                if (Y8) *((GAS unsigned*)(Y8 + (size_t)m * D) + c.lane + 64 * j) = pk4_fp8(y.x, y.y, y.z, y.w); } }
    }
}
__device__ __forceinline__ void unpack8(const v4u w, float (&v)[8]) { v[0] = bflo(w.x); v[1] = bfhi(w.x); v[2] = bflo(w.y); v[3] = bfhi(w.y); v[4] = bflo(w.z); v[5] = bfhi(w.z); v[6] = bflo(w.w); v[7] = bfhi(w.w); }
__device__ __forceinline__ v4u pack8(const float (&v)[8]) { return (v4u){pk2(v[0], v[1]), pk2(v[2], v[3]), pk2(v[4], v[5]), pk2(v[6], v[7])}; }
__device__ __forceinline__ float sumsq8(const float (&v)[8]) { float s = 0.f;
#pragma unroll
    for (int i = 0; i < 8; ++i) s += v[i] * v[i]; return s; }
__device__ __forceinline__ void norm2_rows(const Ctx& c, const bf16* X, bf16* Y, unsigned char* Y8, const float* g, const float* modv, int i_shift, int i_scale) {
    const int lane = c.lane;
    for (int m0 = c.gw; m0 < M; m0 += 4 * c.NGW) {
        v4u w0[4], w1[4];
#pragma unroll
        for (int u = 0; u < 4; ++u) { const int m = (m0 + u * c.NGW) < M ? (m0 + u * c.NGW) : m0; const bf16* row = X + (size_t)m * D; w0[u] = *(const GAS v4u*)(row + 8 * lane); w1[u] = *(const GAS v4u*)(row + 512 + 8 * lane); }
#pragma unroll
        for (int u = 0; u < 4; ++u) { const int m = m0 + u * c.NGW; if (m >= M) break;
            const int b = m >> 13; float v0[8], v1[8]; unpack8(w0[u], v0); unpack8(w1[u], v1);
            const float rstd = 1.f / sqrtf(wave_sum(sumsq8(v0) + sumsq8(v1)) * (1.f / D) + EPS);
            const float* scp = modv + (size_t)(b * 6 + i_scale) * 1024; const float* shp = modv + (size_t)(b * 6 + i_shift) * 1024;
#pragma unroll
            for (int h = 0; h < 2; ++h) { const int e0 = h * 512 + 8 * lane; float (&v)[8] = h == 0 ? v0 : v1;
                const f32x4 ga = *(const f32x4*)(g + e0), gb = *(const f32x4*)(g + e0 + 4), sa = *(const f32x4*)(scp + e0), sb = *(const f32x4*)(scp + e0 + 4), ha = *(const f32x4*)(shp + e0), hb = *(const f32x4*)(shp + e0 + 4);
                float y[8];
                y[0] = v[0] * rstd * ga.x * (1.f + sa.x) + ha.x; y[1] = v[1] * rstd * ga.y * (1.f + sa.y) + ha.y; y[2] = v[2] * rstd * ga.z * (1.f + sa.z) + ha.z; y[3] = v[3] * rstd * ga.w * (1.f + sa.w) + ha.w;
                y[4] = v[4] * rstd * gb.x * (1.f + sb.x) + hb.x; y[5] = v[5] * rstd * gb.y * (1.f + sb.y) + hb.y; y[6] = v[6] * rstd * gb.z * (1.f + sb.z) + hb.z; y[7] = v[7] * rstd * gb.w * (1.f + sb.w) + hb.w;
                *(GAS v4u*)(Y + (size_t)m * D + e0) = pack8(y);
                *(GAS v2u*)(Y8 + (size_t)m * D + e0) = (v2u){pk4_fp8(y[0], y[1], y[2], y[3]), pk4_fp8(y[4], y[5], y[6], y[7])}; } }
    }
}
__device__ __forceinline__ void rope8(float (&y)[8], int r8, int pos, const float* TC, const float* TS) {
    float py[8];
#pragma unroll
    for (int i = 0; i < 8; ++i) py[i] = dx<0x4E>(y[i]);
    const int j0 = (r8 & 1) * 8; const f32x4* cp = (const f32x4*)(TC + pos * 16 + j0); const f32x4* sp = (const f32x4*)(TS + pos * 16 + j0);
    const f32x4 c0 = cp[0], c1 = cp[1], s0 = sp[0], s1 = sp[1];
    const float cs[8] = {c0.x, c0.y, c0.z, c0.w, c1.x, c1.y, c1.z, c1.w}, sn[8] = {s0.x, s0.y, s0.z, s0.w, s1.x, s1.y, s1.z, s1.w};
    const bool first = r8 < 2;
#pragma unroll
    for (int i = 0; i < 8; ++i) y[i] = first ? (y[i] * cs[i] - py[i] * sn[i]) : (py[i] * sn[i] + y[i] * cs[i]);
}
struct QkvDst { bf16 *QA, *KA, *VA, *QB, *KB, *VB, *CQK, *KC; const float *TC, *TS, *aqg, *akg, *cqg, *ckvg; };
__device__ __forceinline__ void qkv_row(const QkvDst& d, int t, int lane, const v4u w0, const v4u w2, const v4u w3) {
    const int pos = t & (SEQ - 1), prow = pos >> 6, pcol = pos & 63;
    { float v[8]; unpack8(w0, v);
      const float ss = red8(sumsq8(v));
      const float rstd = 1.f / sqrtf(ss * (1.f / 64.f) + EPS);
      const int head = lane >> 3, d0 = (lane & 7) * 8; const float* gg = (head < 6 ? d.aqg : d.akg) + d0;
#pragma unroll
      for (int i = 0; i < 8; ++i) v[i] = v[i] * rstd * gg[i];
      rope8(v, (lane & 3), (d0 < 32) ? prow : pcol, d.TC, d.TS);
      if (head < 6) {
#pragma unroll
          for (int i = 0; i < 8; ++i) v[i] *= C2A;
          *(GAS v4u*)(d.QA + (size_t)t * 384 + head * 64 + d0) = pack8(v);
      } else *(GAS v4u*)(d.KA + (size_t)t * 128 + (head - 6) * 64 + d0) = pack8(v); }
    { const int e0 = 1024 + 8 * lane; float v[8]; unpack8(w2, v);
      const float ss = red32(sumsq8(v));
      if (e0 >= 1280) { const float rstd = 1.f / sqrtf(ss * (1.f / 256.f) + EPS); const float* gg = d.cqg + (e0 - 1280);
#pragma unroll
          for (int i = 0; i < 8; ++i) v[i] = v[i] * rstd * gg[i];
          *(GAS v4u*)(d.CQK + (size_t)t * 384 + (e0 - 1280)) = pack8(v); } }
    { const int e0 = 1536 + 8 * lane; float v[8]; unpack8(w3, v);
      const float ss = red16(sumsq8(v));
      float y[8];
#pragma unroll
      for (int i = 0; i < 8; ++i) y[i] = v[i];
      rope8(y, (lane & 3), pos, d.TC, d.TS);
      if (lane < 16) { const float rstd = 1.f / sqrtf(ss * (1.f / 128.f) + EPS); const float* gg = d.ckvg + (e0 - 1536);
#pragma unroll
          for (int i = 0; i < 8; ++i) v[i] = v[i] * rstd * gg[i];
          *(GAS v4u*)(d.CQK + (size_t)t * 384 + 256 + (e0 - 1536)) = pack8(v); }
      else if (lane < 20) { const v4u o = pack8(y); const int r = (lane - 16) * 8;
#pragma unroll
          for (int h = 0; h < 4; ++h) *(GAS v4u*)(d.KC + (size_t)t * 384 + h * 96 + 64 + r) = o; } }
}
__device__ __forceinline__ void qkv_prep_rows(const Ctx& c, int l) {
    const KArgs ap = kargs(); unsigned char* ws = c.ws;
    const bf16* PROJ = (const bf16*)(ws + WS_PROJ);
    QkvDst d{(bf16*)(ws + WS_QA), (bf16*)(ws + WS_KA), (bf16*)(ws + WS_VA), (bf16*)(ws + WS_QB), (bf16*)(ws + WS_KB), (bf16*)(ws + WS_VB), (bf16*)(ws + WS_CQK), (bf16*)(ws + WS_KC),
             (const float*)(ws + WS_TABC), (const float*)(ws + WS_TABS), ap->in[I_AQG] + l * 64, ap->in[I_AKG] + l * 64, ap->in[I_CQG] + l * 256, ap->in[I_CKVG] + l * 128};
    const int lane = c.lane;
    for (int t0 = c.gw; t0 < M; t0 += 8 * c.NGW) {
        v4u w[8][3];
#pragma unroll
        for (int u = 0; u < 8; ++u) { const int t = (t0 + u * c.NGW) < M ? (t0 + u * c.NGW) : t0; const bf16* pr = PROJ + (size_t)t * IN_WP;
            w[u][0] = __builtin_nontemporal_load((const GAS v4u*)(pr + 8 * lane));
            w[u][1] = (v4u){0u, 0u, 0u, 0u}; if (lane >= 32) w[u][1] = __builtin_nontemporal_load((const GAS v4u*)(pr + 1024 + 8 * lane));
            w[u][2] = (v4u){0u, 0u, 0u, 0u}; if (lane < 20) w[u][2] = __builtin_nontemporal_load((const GAS v4u*)(pr + 1536 + 8 * lane)); }
#pragma unroll
        for (int u = 0; u < 8; ++u) if (t0 + u * c.NGW < M) qkv_row(d, t0 + u * c.NGW, lane, w[u][0], w[u][1], w[u][2]);
    }
}
__device__ __forceinline__ void mixnorm_rows(const Ctx& c, int l, bool dry = false) {
    bf16* MIX = (bf16*)(c.ws + WS_MIX); bf16* MIXO = dry ? (bf16*)(c.ws + WS_DRY0) : MIX; const float* g = kargs()->in[I_ONG] + l * 1024; const int lane = c.lane;
    const float* g0 = g + 8 * lane; const float* g1 = g + 512 + 8 * lane;
    float gg0[8], gg1[8];
#pragma unroll
    for (int i = 0; i < 8; ++i) { gg0[i] = g0[i]; gg1[i] = g1[i]; }
    for (int t0 = c.gw; t0 < M; t0 += 4 * c.NGW) {
        v4u w0[4], w1[4];
#pragma unroll
        for (int u = 0; u < 4; ++u) { const int t = (t0 + u * c.NGW) < M ? (t0 + u * c.NGW) : t0; const bf16* row = MIX + (size_t)t * 1024; w0[u] = __builtin_nontemporal_load((const GAS v4u*)(row + 8 * lane)); w1[u] = __builtin_nontemporal_load((const GAS v4u*)(row + 512 + 8 * lane)); }
#pragma unroll
        for (int u = 0; u < 4; ++u) { const int t = t0 + u * c.NGW; if (t >= M) break;
            bf16* row = MIXO + (size_t)t * 1024;
            float v0[8], v1[8]; unpack8(w0[u], v0); unpack8(w1[u], v1);
            const float q0 = sumsq8(v0), q1 = sumsq8(v1);
            const float sA = wave_sum(lane < 48 ? q0 : 0.f), sB = wave_sum((lane >= 48 ? q0 : 0.f) + (lane < 32 ? q1 : 0.f)), sC = wave_sum(lane >= 32 ? q1 : 0.f);
            const float rA = 1.f / sqrtf(sA * (1.f / 384.f) + EPS), rB = 1.f / sqrtf(sB * (1.f / 384.f) + EPS), rC = 1.f / sqrtf(sC * (1.f / 256.f) + EPS);
            const float r0 = lane < 48 ? rA : rB, r1 = lane < 32 ? rB : rC;
#pragma unroll
            for (int i = 0; i < 8; ++i) { v0[i] = v0[i] * r0 * gg0[i]; v1[i] = v1[i] * r1 * gg1[i]; }
            *(GAS v4u*)(row + 8 * lane) = pack8(v0); *(GAS v4u*)(row + 512 + 8 * lane) = pack8(v1); }
    }
}
__device__ __forceinline__ void combine_rows(const Ctx& c, int l, bool dry = false) {
    const unsigned char* Y8 = (const unsigned char*)(c.ws + WS_Y); const unsigned char* YS8 = (const unsigned char*)(c.ws + WS_U2F);     float* OUT = kargs()->out; bf16* XB = (bf16*)(c.ws + WS_XB);
    const float* modv = (const float*)(c.ws + WS_MODV) + (size_t)l * 8 * 6144; const int lane = c.lane;
    const bool lastl = (l + 1 == DEPTH);
    const float* gn = lastl ? kargs()->in[I_FG] : kargs()->in[I_N1G] + (l + 1) * 1024;
    const float* modn = (const float*)(c.ws + WS_MODV) + (size_t)(lastl ? l : l + 1) * 8 * 6144;
    const int cA = (lane >> 4) * 256 + ((lane >> 2) & 3) * 32 + (lane & 3) * 8;
    for (int t = c.gw; t < M; t += c.NGW) {
        const int b = t >> 13;
        float acc[16];
#pragma unroll
        for (int i = 0; i < 16; ++i) acc[i] = 0.f;
#pragma unroll
        for (int k = 0; k < 9; ++k) { const v4u w = __builtin_nontemporal_load((const GAS v4u*)((k < 8 ? Y8 + ((size_t)t * 8 + k) * 1024 : YS8 + (size_t)t * 1024) + 16 * lane));
            const unsigned ww[4] = {w.x, w.y, w.z, w.w};
#pragma unroll
            for (int q = 0; q < 4; ++q) { const auto lo = __builtin_amdgcn_cvt_pk_f32_fp8((int)ww[q], false), hi = __builtin_amdgcn_cvt_pk_f32_fp8((int)ww[q], true);
                acc[4 * q + 0] += lo[0]; acc[4 * q + 1] += lo[1]; acc[4 * q + 2] += hi[0]; acc[4 * q + 3] += hi[1]; } }
        const float* g2 = modv + (size_t)(b * 6 + 5) * 1024;
        bf16* xb = XB + (size_t)t * 1024 + cA; bf16* xbo = dry ? (bf16*)(c.ws + WS_DRY0) + (size_t)t * 1024 + cA : xb; float* xr = OUT + (size_t)t * 1024; float ss = 0.f;
        float xv[16];
        { float a0[8], a1[8]; unpack8(__builtin_nontemporal_load((const GAS v4u*)xb), a0); unpack8(__builtin_nontemporal_load((const GAS v4u*)(xb + 128)), a1);
#pragma unroll
          for (int i = 0; i < 8; ++i) { xv[i] = a0[i]; xv[8 + i] = a1[i]; } }
#define COL(q) (cA + ((q) >> 1) * 128 + ((q) & 1) * 4)
#pragma unroll
        for (int q = 0; q < 4; ++q) { const f32x4 ga = *(const f32x4*)(g2 + COL(q));
            acc[4 * q + 0] = xv[4 * q + 0] + ga.x * (acc[4 * q + 0] * 0.0625f); acc[4 * q + 1] = xv[4 * q + 1] + ga.y * (acc[4 * q + 1] * 0.0625f);
            acc[4 * q + 2] = xv[4 * q + 2] + ga.z * (acc[4 * q + 2] * 0.0625f); acc[4 * q + 3] = xv[4 * q + 3] + ga.w * (acc[4 * q + 3] * 0.0625f);
            ss += (acc[4 * q] * acc[4 * q] + acc[4 * q + 1] * acc[4 * q + 1]) + (acc[4 * q + 2] * acc[4 * q + 2] + acc[4 * q + 3] * acc[4 * q + 3]); }
        const float rstd = 1.f / sqrtf(wave_sum(ss) * (1.f / D) + EPS);
        if (lastl) {
#pragma unroll
            for (int q = 0; q < 4; ++q) { const f32x4 na = *(const f32x4*)(gn + COL(q));
                *(GAS f32x4*)(xr + COL(q)) = (f32x4){acc[4 * q] * rstd * na.x, acc[4 * q + 1] * rstd * na.y, acc[4 * q + 2] * rstd * na.z, acc[4 * q + 3] * rstd * na.w}; }
        } else {
            const float* scp = modn + (size_t)(b * 6 + 1) * 1024; const float* shp = modn + (size_t)(b * 6 + 0) * 1024;
            float y[16];
#pragma unroll
            for (int q = 0; q < 4; ++q) { const f32x4 na = *(const f32x4*)(gn + COL(q)), sa = *(const f32x4*)(scp + COL(q)), ha = *(const f32x4*)(shp + COL(q));
                y[4 * q] = acc[4 * q] * rstd * na.x * (1.f + sa.x) + ha.x; y[4 * q + 1] = acc[4 * q + 1] * rstd * na.y * (1.f + sa.y) + ha.y;
                y[4 * q + 2] = acc[4 * q + 2] * rstd * na.z * (1.f + sa.z) + ha.z; y[4 * q + 3] = acc[4 * q + 3] * rstd * na.w * (1.f + sa.w) + ha.w; }
            *(GAS v4u*)xbo = (v4u){pk2(acc[0], acc[1]), pk2(acc[2], acc[3]), pk2(acc[4], acc[5]), pk2(acc[6], acc[7])};
            *(GAS v4u*)(xbo + 128) = (v4u){pk2(acc[8], acc[9]), pk2(acc[10], acc[11]), pk2(acc[12], acc[13]), pk2(acc[14], acc[15])};
            bf16* yo = (dry ? (bf16*)(c.ws + WS_DRY1) : (bf16*)(c.ws + WS_XN)) + (size_t)t * 1024 + cA;
            *(GAS v4u*)yo = (v4u){pk2(y[0], y[1]), pk2(y[2], y[3]), pk2(y[4], y[5]), pk2(y[6], y[7])};
            *(GAS v4u*)(yo + 128) = (v4u){pk2(y[8], y[9]), pk2(y[10], y[11]), pk2(y[12], y[13]), pk2(y[14], y[15])};
        }
#undef COL
    }
}

__device__ __forceinline__ void select_phase(const Ctx& c, int l, bool dry = false) {
    LAS int* lcnt = (LAS int*)c.lds; LAS int* lbase = lcnt + 256; LAS int* sel_e = lbase + 256; LAS int* sel_p = sel_e + 2048; LAS int* sel_w = sel_p + 2048;
    const float* LOG = (const float*)(c.ws + WS_LOGITS); const float* rb = kargs()->in[I_RB] + l * NE; int* LIST = (int*)(c.ws + (dry ? WS_Y : WS_LIST));
    unsigned* gcnt = (unsigned*)(c.ws + WS_CTL) + CW_GCNT + l * 512 + (dry ? 1024 : 0);
    const int lane = c.lane;
    for (int chunk = blockIdx.x; chunk < M / 256; chunk += c.G) {
        if (c.tid < 256) lcnt[c.tid] = 0;
        __syncthreads();
        const f32x4 rbv = *(const f32x4*)(rb + 4 * lane);
        f32x4 lgn[2];
#pragma unroll
        for (int u = 0; u < 2; ++u) lgn[u] = __builtin_nontemporal_load((const GAS f32x4*)(LOG + (size_t)(chunk * 256 + c.wave * 32 + u) * 256 + 4 * lane));
        for (int tt = 0; tt < 32; tt += 2) {
            float s[2][4], cv[2][4], myw[2], ssum[2]; int mye[2];
            f32x4 lgc[2] = {lgn[0], lgn[1]};
            if (tt + 2 < 32) {
#pragma unroll
                for (int u = 0; u < 2; ++u) lgn[u] = __builtin_nontemporal_load((const GAS f32x4*)(LOG + (size_t)(chunk * 256 + c.wave * 32 + tt + 2 + u) * 256 + 4 * lane)); }
#pragma unroll
            for (int u = 0; u < 2; ++u) {
                const f32x4 lg = lgc[u];
                s[u][0] = fast_sigmoid(lg.x); s[u][1] = fast_sigmoid(lg.y); s[u][2] = fast_sigmoid(lg.z); s[u][3] = fast_sigmoid(lg.w);
                cv[u][0] = s[u][0] + rbv.x; cv[u][1] = s[u][1] + rbv.y; cv[u][2] = s[u][2] + rbv.z; cv[u][3] = s[u][3] + rbv.w; myw[u] = 0.f; ssum[u] = 0.f; mye[u] = 0; }
            float m1[2], m2[2];
#pragma unroll
            for (int u = 0; u < 2; ++u) { const float a = fmaxf(cv[u][0], cv[u][1]), b = fminf(cv[u][0], cv[u][1]), cc = fmaxf(cv[u][2], cv[u][3]), d = fminf(cv[u][2], cv[u][3]); m1[u] = fmaxf(a, cc); m2[u] = fmaxf(fminf(a, cc), fmaxf(b, d)); }
#define TOP2_STEP(K) { _Pragma("unroll") for (int u = 0; u < 2; ++u) { const float o1 = dx<K>(m1[u]), o2 = dx<K>(m2[u]); const float n1 = fmaxf(m1[u], o1), n2 = fmaxf(fminf(m1[u], o1), fmaxf(m2[u], o2)); m1[u] = n1; m2[u] = n2; } }
            TOP2_STEP(0xB1) TOP2_STEP(0x4E) TOP2_STEP(0x141)
#undef TOP2_STEP
            unsigned key[2][4];
#pragma unroll
            for (int u = 0; u < 2; ++u) { const float gs = m1[u] + m2[u]; const int grp = lane >> 3; int rank = 0;
#pragma unroll
                for (int gp = 0; gp < 8; ++gp) { const float sg = __builtin_bit_cast(float, __builtin_amdgcn_readlane(__builtin_bit_cast(int, gs), gp * 8)); rank += (int)((sg > gs) | ((sg == gs) & (gp < grp))); }
                const bool drop = rank >= 4;
#pragma unroll
                for (int jj = 0; jj < 4; ++jj) { const unsigned b = __builtin_bit_cast(unsigned, cv[u][jj]); const unsigned ok = (b & 0x80000000u) ? ~b : (b | 0x80000000u);
                    key[u][jj] = drop ? 0u : ((ok & 0xFFFFFF00u) | (unsigned)(255 - (4 * lane + jj))); } }
#pragma unroll
            for (int k = 0; k < 8; ++k) {
                unsigned bk[2];
#pragma unroll
                for (int u = 0; u < 2; ++u) { const unsigned a = key[u][0] > key[u][1] ? key[u][0] : key[u][1], b = key[u][2] > key[u][3] ? key[u][2] : key[u][3]; bk[u] = a > b ? a : b; }
#define KMAX_STEP(K) { _Pragma("unroll") for (int u = 0; u < 2; ++u) { const unsigned o = (unsigned)dxi<K>((int)bk[u]); bk[u] = o > bk[u] ? o : bk[u]; } }
                KMAX_STEP(0xB1) KMAX_STEP(0x4E) KMAX_STEP(0x141) KMAX_STEP(0x140)
#undef KMAX_STEP
#pragma unroll
                for (int u = 0; u < 2; ++u) { const unsigned o = (unsigned)sxi<16>((int)bk[u]); bk[u] = o > bk[u] ? o : bk[u]; }
#pragma unroll
                for (int u = 0; u < 2; ++u) {
                    { auto rk = __builtin_amdgcn_permlane32_swap(bk[u], bk[u], false, false); bk[u] = rk[0] > rk[1] ? rk[0] : rk[1]; }
                    const unsigned best = (unsigned)__builtin_amdgcn_readfirstlane((int)bk[u]);
                    const int g = 255 - (int)(best & 0xFFu);
                    const int owner = g >> 2, slot = g & 3; float sc;
                    { const bool own = lane == owner; const float ssel = slot == 0 ? s[u][0] : slot == 1 ? s[u][1] : slot == 2 ? s[u][2] : s[u][3]; sc = own ? ssel : 0.f;
#pragma unroll
                      for (int jj = 0; jj < 4; ++jj) key[u][jj] = (key[u][jj] == best) ? 0u : key[u][jj]; }
                    sc = __builtin_bit_cast(float, __builtin_amdgcn_readlane(__builtin_bit_cast(int, sc), owner)); ssum[u] += sc;
                    { const bool me = lane == k; mye[u] = me ? g : mye[u]; myw[u] = me ? sc : myw[u]; } }
            }
#pragma unroll
            for (int u = 0; u < 2; ++u) { const int tl = c.wave * 32 + tt + u;
                if (lane < 8) { sel_w[tl * 8 + lane] = (int)(myw[u] / ssum[u] * 8191.f + 0.5f); const int p = __hip_atomic_fetch_add(&lcnt[mye[u]], 1, __ATOMIC_RELAXED, __HIP_MEMORY_SCOPE_WORKGROUP); sel_e[tl * 8 + lane] = mye[u]; sel_p[tl * 8 + lane] = p; } }
        }
        __syncthreads();
        if (c.tid < 256) lbase[c.tid] = (int)__hip_atomic_fetch_add(gcnt + c.tid, (unsigned)lcnt[c.tid], RLX_AGENT);
        __syncthreads();
        for (int i = c.tid; i < 2048; i += NTHREADS) { const int e = sel_e[i]; LIST[(size_t)e * LCAP + lbase[e] + sel_p[i]] = ((chunk * 2048 + i) << 13) | sel_w[i]; }
        __syncthreads();
    }
}

__device__ __forceinline__ void build_moe_tables(const Ctx& c, int l) {
    LAS int* cum = (LAS int*)(c.lds + TAB_OFF); LAS int* cnt = cum + 260;
    unsigned* gcnt = (unsigned*)(c.ws + WS_CTL) + CW_GCNT + l * 512;
    if (c.wave == 0) {
        int n[4], nb = 0;
#pragma unroll
        for (int i = 0; i < 4; ++i) { n[i] = (int)__hip_atomic_load(gcnt + 4 * c.lane + i, RLX_AGENT); cnt[4 * c.lane + i] = n[i]; nb += (n[i] + 255) >> 8; }
        int inc = nb;
#pragma unroll
        for (int off = 1; off < 64; off <<= 1) { const int o = __builtin_amdgcn_ds_bpermute((c.lane - off) << 2, inc); if (c.lane >= off) inc += o; }
        int run = inc - nb;
#pragma unroll
        for (int i = 0; i < 4; ++i) { cum[4 * c.lane + i] = run; run += (n[i] + 255) >> 8; }
        if (c.lane == 63) { cum[256] = run; cum[257] = run + M / 256; cnt[256] = M; }
    }
    __syncthreads();
}
constexpr int ULIST_OFF = LDSCTL_OFF + 4096, ULIST_MAX = 128;
constexpr int ETAB_OFF = LDSCTL_OFF + 8192;
template <bool SHARE> struct MoeOrderT {
    static constexpr bool SHARE_A = SHARE;
    const LAS int* cum; const LAS int* cnt; const LAS int* ulist; const int* LIST; int G, c, NT, total, nblk, nlist; unsigned etab; bool use_tab;
    __device__ __forceinline__ bool locate(int i, int& blkidx, int& pnl) const {
        if constexpr (SHARE) { blkidx = (i >> 2) * G + c; pnl = i & 3; return blkidx < nblk; }
        else { const long L = (long)i * G + c; if (L >= total) return false; blkidx = (int)(L / NT); pnl = (int)(L % NT); return true; }
    }
    __device__ __forceinline__ void search(int blkidx, int pnl, pg8::Unit& u) const {
        int lo = 0, hi = 257;
#pragma unroll 1
        while (hi - lo > 1) { const int mid = (lo + hi) >> 1; const int cm = cum[mid]; if (cm <= blkidx) lo = mid; else hi = mid; }
        u.e = lo; u.blk = blkidx - cum[lo]; u.pm = blkidx; u.pn = lo * NT + pnl; const int left = cnt[lo] - u.blk * 256; u.rows = left < 256 ? left : 256;
    }
    __device__ __forceinline__ void init(const Ctx& cx, int NT_, bool use_tab_) {
        cum = (const LAS int*)(cx.lds + TAB_OFF); cnt = cum + 260; LIST = (const int*)(cx.ws + WS_LIST); G = cx.G; c = cx.vcu; NT = NT_; nblk = __builtin_amdgcn_readfirstlane(cum[257]); total = nblk * NT_;
        ulist = (const LAS int*)(cx.lds + ULIST_OFF); etab = (unsigned)(uintptr_t)(cx.lds + ETAB_OFF); use_tab = use_tab_;
        int mine;
        if constexpr (SHARE) mine = nblk > c ? ((nblk - c + G - 1) / G) * 4 : 0; else mine = total > c ? (total - c + G - 1) / G : 0;
        nlist = mine < ULIST_MAX ? mine : ULIST_MAX;
        if (cx.tid < nlist) { pg8::Unit u; int bi, pl; locate(cx.tid, bi, pl); search(bi, pl, u); LAS int* w = (LAS int*)(cx.lds + ULIST_OFF) + cx.tid * 8; w[0] = u.e; w[1] = u.blk; w[2] = u.pm; w[3] = u.pn; w[4] = u.rows; }
        __syncthreads();
    }
    __device__ __forceinline__ bool next(int i, pg8::Unit& u) const {
        int bi, pl; if (!locate(i, bi, pl)) return false;
        if (i < nlist) { const LAS int* w = ulist + i * 8; u.e = __builtin_amdgcn_readfirstlane(w[0]); u.blk = __builtin_amdgcn_readfirstlane(w[1]); u.pm = __builtin_amdgcn_readfirstlane(w[2]); u.pn = __builtin_amdgcn_readfirstlane(w[3]); u.rows = __builtin_amdgcn_readfirstlane(w[4]); }
        else { search(bi, pl, u); u.e = __builtin_amdgcn_readfirstlane(u.e); u.blk = __builtin_amdgcn_readfirstlane(u.blk); u.pm = __builtin_amdgcn_readfirstlane(u.pm); u.pn = __builtin_amdgcn_readfirstlane(u.pn); u.rows = __builtin_amdgcn_readfirstlane(u.rows); }
        if constexpr (SHARE) u.slot = ((i >> 2) % 3) | ((i & 3) ? 0 : 256); else u.slot = i % 3;
        return true;
    }
    __device__ __forceinline__ void a_ready(const pg8::Unit& u) const {
        if (use_tab && u.e != NE && (!SHARE || (u.slot & 256))) { int t_ = threadIdx.x; asm volatile("" : "+v"(t_));
            if (__builtin_amdgcn_readfirstlane(t_ >> 6) == 0) sat::glds16(LIST + (size_t)u.e * LCAP + u.blk * 256 + (t_ & 63) * 4, (unsigned)__builtin_amdgcn_readfirstlane((int)(etab + (u.slot & 255) * 1024))); }
    }
    __device__ __forceinline__ void done(const pg8::Unit&) const {}
    __device__ __forceinline__ void offsets_raw(const pg8::Unit& u, unsigned (&raw)[2][2], int R0, int R1) const {
#pragma unroll
        for (int h = 0; h < 2; ++h) { const int r0 = h * 128 + R0, r1 = h * 128 + R1;
            if (u.e == NE) { raw[h][0] = (unsigned)(u.blk * 256 + r0) << 16; raw[h][1] = (unsigned)(u.blk * 256 + r1) << 16; }
            else { const int* lp = LIST + (size_t)u.e * LCAP + u.blk * 256; raw[h][0] = r0 < u.rows ? (unsigned)lp[r0] : 0u; raw[h][1] = r1 < u.rows ? (unsigned)lp[r1] : 0u; } }
    }
    __device__ __forceinline__ void offsets_fin(const unsigned (&raw)[2][2], unsigned (&v)[2][2], int C0, int C1) const {
#pragma unroll
        for (int h = 0; h < 2; ++h) { v[h][0] = (raw[h][0] >> 16) * 1024u + (unsigned)(C0 * 2); v[h][1] = (raw[h][1] >> 16) * 1024u + (unsigned)(C1 * 2); }
    }
    __device__ __forceinline__ void offsets(const pg8::Unit& u, unsigned (&v)[2][2], int R0, int C0, int R1, int C1) const {
#pragma unroll
        for (int h = 0; h < 2; ++h) {
            const int r0 = h * 128 + R0, r1 = h * 128 + R1;
            int t0, t1;
            if (u.e == NE) { t0 = u.blk * 256 + r0; t1 = u.blk * 256 + r1; }
            else { const int* lp = LIST + (size_t)u.e * LCAP + u.blk * 256; t0 = r0 < u.rows ? (int)((unsigned)lp[r0] >> 16) : 0; t1 = r1 < u.rows ? (int)((unsigned)lp[r1] >> 16) : 0; }
            v[h][0] = (unsigned)(t0 * 1024 + C0 * 2); v[h][1] = (unsigned)(t1 * 1024 + C1 * 2);
        }
    }
};
using MoeOrder = MoeOrderT<false>;
struct EpiE1 {
    static constexpr bool PERM = true, KSCALE = false;
    unsigned char* H;
    __device__ __forceinline__ void operator()(const pg8::f32x4 (&acc)[2][2][4][2], const pg8::Unit& u, int wr, int wc, int fr_, int fq_) const {
        int t_ = threadIdx.x; asm volatile("" : "+v"(t_)); const int fr = t_ & 15, fq = (t_ >> 4) & 3; (void)fr_; (void)fq_;
        const int pnl = u.pn & 1; const int col0 = pnl * 128 + wc * 32 + 8 * fq;
        constexpr float KX = -LOG2E / SC_W13, CI = SC_W13 * SC_W13 / SC_H;
#pragma unroll
        for (int ai = 0; ai < 2; ++ai)
#pragma unroll
            for (int m = 0; m < 4; ++m) { const int r = ai * 128 + wr * 64 + m * 16 + fr;
                const pg8::f32x4 a0 = acc[ai][0][m][0], a1 = acc[ai][0][m][1], b0 = acc[ai][1][m][0], b1 = acc[ai][1][m][1];
                const pg8::f32x4 x0 = a0 * KX, x1 = a1 * KX, t0 = a0 * b0, t1 = a1 * b1;
                pg8::f32x4 e0, e1;
#pragma unroll
                for (int i = 0; i < 4; ++i) { e0[i] = __builtin_amdgcn_exp2f(x0[i]); e1[i] = __builtin_amdgcn_exp2f(x1[i]); }
                const pg8::f32x4 d0 = e0 * CI + CI, d1 = e1 * CI + CI;
                pg8::f32x4 r0, r1;
#pragma unroll
                for (int i = 0; i < 4; ++i) { r0[i] = __builtin_amdgcn_rcpf(d0[i]); r1[i] = __builtin_amdgcn_rcpf(d1[i]); }
                const pg8::f32x4 h0 = t0 * r0, h1 = t1 * r1;
                *(GAS v2u*)(H + ((size_t)u.pm * 256 + r) * 256 + col0) = (v2u){pk4_fp8(h0[0], h0[1], h0[2], h0[3]), pk4_fp8(h1[0], h1[1], h1[2], h1[3])}; }
    }
};
struct EpiE2 {
    static constexpr bool PERM = true, KSCALE = false;
    unsigned char* Y8; unsigned char* YS8; const LAS int* etab;
    __device__ __forceinline__ void operator()(const pg8::f32x4 (&acc)[2][2][4][2], const pg8::Unit& u, int wr, int wc, int fr_, int fq_) const {
        int t_ = threadIdx.x; asm volatile("" : "+v"(t_)); const int fr = t_ & 15, fq = (t_ >> 4) & 3; (void)fr_; (void)fq_;
        const int pnl = u.pn & 3; const bool shared = u.e == NE;
#pragma unroll
        for (int ai = 0; ai < 2; ++ai)
#pragma unroll
            for (int m = 0; m < 4; ++m) { const int r = ai * 128 + wr * 64 + m * 16 + fr;
                if (r < u.rows) {
                    unsigned char* dst; float w;
                    if (shared) { dst = YS8 + ((size_t)u.blk * 256 + r) * 1024; w = 16.f / (SC_W2 * SC_H); }
                    else { const unsigned ent = (unsigned)etab[(u.slot & 255) * 256 + r]; dst = Y8 + (size_t)(ent >> 13) * 1024; w = (float)(ent & 8191u) * (16.f * 2.5f / 8191.f / (SC_W2 * SC_H)); }
                    unsigned q[4];
#pragma unroll
                    for (int bj = 0; bj < 2; ++bj) { const pg8::f32x4 v0 = acc[ai][bj][m][0] * w, v1 = acc[ai][bj][m][1] * w;
                        int w0 = 0, w1 = 0; w0 = __builtin_amdgcn_cvt_pk_fp8_f32(v0[0], v0[1], w0, false); w0 = __builtin_amdgcn_cvt_pk_fp8_f32(v0[2], v0[3], w0, true);
                        w1 = __builtin_amdgcn_cvt_pk_fp8_f32(v1[0], v1[1], w1, false); w1 = __builtin_amdgcn_cvt_pk_fp8_f32(v1[2], v1[3], w1, true);
                        q[2 * bj] = (unsigned)w0; q[2 * bj + 1] = (unsigned)w1; }
                    __builtin_nontemporal_store((v4u){q[0], q[1], q[2], q[3]}, (GAS v4u*)(dst + pnl * 256 + wc * 64 + fq * 16));
                } }
    }
};
struct EpiInProj {
    static constexpr bool PERM = true, KSCALE = false;
    bf16 *PROJ, *VA, *QB, *KB, *VB;
    __device__ __forceinline__ void operator()(const pg8::f32x4 (&acc)[2][2][4][2], const pg8::Unit& u, int wr, int wc, int fr_, int fq_) const {
        int t_ = threadIdx.x; asm volatile("" : "+v"(t_)); const int fr = t_ & 15, fq = (t_ >> 4) & 3; (void)fr_; (void)fq_;
        const int row0 = u.pm * 256 + wr * 64 + fr;
#pragma unroll
        for (int bj = 0; bj < 2; ++bj) {
            const int cg = u.pn * 256 + bj * 128 + wc * 32;
            bf16* base; int pitch, cc; float sc = 1.f;
            if (cg < 512 || cg >= 1280) { base = PROJ; pitch = IN_WP; cc = cg; }
            else if (cg < 640) { base = VA; pitch = 128; cc = cg - 512; }
            else if (cg < 1024) { base = QB; pitch = 384; cc = cg - 640; sc = C2A; }
            else if (cg < 1152) { base = KB; pitch = 128; cc = cg - 1024; }
            else { base = VB; pitch = 128; cc = cg - 1152; }
#pragma unroll
            for (int ai = 0; ai < 2; ++ai)
#pragma unroll
                for (int m = 0; m < 4; ++m) { const pg8::f32x4 v0 = acc[ai][bj][m][0] * sc, v1 = acc[ai][bj][m][1] * sc;
                    *(GAS v4u*)(base + (size_t)(row0 + ai * 128 + m * 16) * pitch + cc + 8 * fq) = (v4u){pg8::cvt_pk_bf16(v0[0], v0[1]), pg8::cvt_pk_bf16(v0[2], v0[3]), pg8::cvt_pk_bf16(v1[0], v1[1]), pg8::cvt_pk_bf16(v1[2], v1[3])}; }
        }
    }
};
struct EpiCup {
    static constexpr bool PERM = false, KSCALE = false;
    bf16* QC; bf16* KC; bf16* VC; const float* TC; const float* TS;
    __device__ __forceinline__ void operator()(const pg8::f32x4 (&acc)[2][2][4][2], const pg8::Unit& u, int wr, int wc, int fr_, int fq_) const {
        int t_ = threadIdx.x; asm volatile("" : "+v"(t_)); const int fr = t_ & 15, fq = (t_ >> 4) & 3; (void)fr_; (void)fq_;
#pragma unroll
        for (int bj = 0; bj < 2; ++bj) {
            const int cg = u.pn * 256 + bj * 128 + wc * 32;
            if (cg >= 896) continue;
            const bool rope = cg < 384 && (cg % 96) == 64;
#pragma unroll
            for (int ai = 0; ai < 2; ++ai) {
                pg8::f32x4 cs[4], sn[4];
                if (rope) {
#pragma unroll
                    for (int m = 0; m < 4; ++m) { const int pos = (u.pm * 256 + ai * 128 + wr * 64 + m * 16 + fr) & (SEQ - 1); cs[m] = *(const pg8::f32x4*)(TC + pos * 16 + 4 * fq); sn[m] = *(const pg8::f32x4*)(TS + pos * 16 + 4 * fq); } }
#pragma unroll
                for (int m = 0; m < 4; ++m) { const int row = u.pm * 256 + ai * 128 + wr * 64 + m * 16 + fr;
                    pg8::f32x4 v0 = acc[ai][bj][m][0], v1 = acc[ai][bj][m][1];
                    bf16* dst;
                    if (cg < 384) {
                        if (rope) { const pg8::f32x4 x1 = v0, x2 = v1; v0 = x1 * cs[m] - x2 * sn[m]; v1 = x1 * sn[m] + x2 * cs[m]; }
                        v0 = v0 * C2C; v1 = v1 * C2C; dst = QC + (size_t)row * 384 + cg;
                    } else if (cg < 640) { const int j = cg - 384; dst = KC + (size_t)row * 384 + (j >> 6) * 96 + (j & 63); }
                    else dst = VC + (size_t)row * 256 + (cg - 640);
                    *(GAS v2u*)(dst + 4 * fq) = (v2u){pg8::cvt_pk_bf16(v0[0], v0[1]), pg8::cvt_pk_bf16(v0[2], v0[3])};
                    *(GAS v2u*)(dst + 16 + 4 * fq) = (v2u){pg8::cvt_pk_bf16(v1[0], v1[1]), pg8::cvt_pk_bf16(v1[2], v1[3])}; }
            }
        }
    }
};
constexpr int RS_OFF = LDSCTL_OFF + 4096;
template <bool SRC_F32> struct EpiOutT {
    static constexpr bool PERM = true, KSCALE = true; static constexpr int KS_MID = 3, KS_TOP = 6;
    const void* Xs; bf16* Xd; const float* modv; const LAS float* rs;
    __device__ __forceinline__ void kscale(pg8::f32x4 (&acc)[2][2][4][2], const pg8::Unit& u, int which, int wr) const {
        int t_ = threadIdx.x; asm volatile("" : "+v"(t_)); const int fr = t_ & 15;
#pragma unroll
        for (int ai = 0; ai < 2; ++ai)
#pragma unroll
            for (int m = 0; m < 4; ++m) { const float f = rs[(u.slot * 256 + ai * 128 + wr * 64 + m * 16 + fr) * 3 + which];
#pragma unroll
                for (int bj = 0; bj < 2; ++bj)
#pragma unroll
                    for (int n = 0; n < 2; ++n) acc[ai][bj][m][n] = acc[ai][bj][m][n] * f; }
    }
    __device__ __forceinline__ void operator()(const pg8::f32x4 (&acc)[2][2][4][2], const pg8::Unit& u, int wr, int wc, int fr_, int fq_) const {
        int t_ = threadIdx.x; asm volatile("" : "+v"(t_)); const int fr = t_ & 15, fq = (t_ >> 4) & 3; (void)fr_; (void)fq_;
        const int row0 = u.pm * 256 + wr * 64 + fr, col0 = u.pn * 256 + wc * 32 + 8 * fq; const int b = (u.pm * 256) >> 13;
        const float* g1 = modv + (size_t)(b * 6 + 2) * 1024 + col0;
        pg8::f32x4 gv[2][2];
#pragma unroll
        for (int bj = 0; bj < 2; ++bj)
#pragma unroll
            for (int n = 0; n < 2; ++n) gv[bj][n] = *(const pg8::f32x4*)(g1 + bj * 128 + n * 4);
#pragma unroll
        for (int am = 0; am < 4; ++am) {
            const int ai = am >> 1, mb = (am & 1) * 2;
            pg8::f32x4 x0[2][2], x1[2][2];
#pragma unroll
            for (int mm = 0; mm < 2; ++mm) { const int m = mb + mm; const size_t off = (size_t)(row0 + ai * 128 + m * 16) * 1024 + col0;
#pragma unroll
                for (int bj = 0; bj < 2; ++bj) {
                    if constexpr (SRC_F32) { const float* xp = (const float*)Xs + off + bj * 128; x0[mm][bj] = __builtin_nontemporal_load((const GAS pg8::f32x4*)xp); x1[mm][bj] = __builtin_nontemporal_load((const GAS pg8::f32x4*)(xp + 4)); }
                    else { const v4u w = *(const GAS v4u*)((const bf16*)Xs + off + bj * 128); x0[mm][bj] = (pg8::f32x4){bflo(w.x), bfhi(w.x), bflo(w.y), bfhi(w.y)}; x1[mm][bj] = (pg8::f32x4){bflo(w.z), bfhi(w.z), bflo(w.w), bfhi(w.w)}; } } }
#pragma unroll
            for (int mm = 0; mm < 2; ++mm) { const int m = mb + mm; const size_t off = (size_t)(row0 + ai * 128 + m * 16) * 1024 + col0;
                const float f3 = rs[(u.slot * 256 + ai * 128 + wr * 64 + m * 16 + fr) * 3 + 2];
#pragma unroll
                for (int bj = 0; bj < 2; ++bj) {
                    const pg8::f32x4 y0 = x0[mm][bj] + gv[bj][0] * (acc[ai][bj][m][0] * f3), y1 = x1[mm][bj] + gv[bj][1] * (acc[ai][bj][m][1] * f3);
                    *(GAS v4u*)(Xd + off + bj * 128) = (v4u){pg8::cvt_pk_bf16(y0[0], y0[1]), pg8::cvt_pk_bf16(y0[2], y0[3]), pg8::cvt_pk_bf16(y1[0], y1[1]), pg8::cvt_pk_bf16(y1[2], y1[3])}; } }
        }
    }
};

__device__ __forceinline__ void attention_phase(const Ctx& c, int l) {
    unsigned char* ws = c.ws;
    const bf16 *QA = (const bf16*)(ws + WS_QA), *KA = (const bf16*)(ws + WS_KA), *VA = (const bf16*)(ws + WS_VA), *QB = (const bf16*)(ws + WS_QB), *KB = (const bf16*)(ws + WS_KB), *VB = (const bf16*)(ws + WS_VB);
    const bf16 *QC = (const bf16*)(ws + WS_QC), *KC = (const bf16*)(ws + WS_KC), *VC = (const bf16*)(ws + WS_VC); unsigned char* MIX8 = ws + WS_MIX;
    const float* sink = kargs()->in[I_BSINK] + l * 6; float* SSQ = (float*)(c.ws + WS_SSQ);
    for (int rep_ = 0; rep_ < NREP(16); ++rep_)
    for (int L = c.vcu; L < NBATCH * 6 * 32; L += c.G) {
        const int qb = L & 31, ph = L >> 5, idx = (ph & 7) * 6 + (ph >> 3), b = idx / 6, hq = idx % 6, kvh = hq / 3; const size_t rb = (size_t)b * SEQ;
        tat::unit<8, 384, 128, 128, 1024, SC_MIXA>((const tat::bf16*)(QA + rb * 384 + hq * 64), (const tat::bf16*)(KA + rb * 128 + kvh * 64), (const tat::bf16*)(VA + rb * 128 + kvh * 64), MIX8 + rb * 1024 + hq * 64, SSQ + rb * 16 + hq, qb * 256, (LAS char*)c.lds,
            [&]() { if (rep_ == 0) { const int nA = (NBATCH * 6 * 32 - c.vcu + c.G - 1) / c.G, nC = (NBATCH * 4 * 32 - c.vcu + c.G - 1) / c.G; convert_experts_part(c, l, (L - c.vcu) / c.G, nA + nC); } });
    }
    for (int rep_ = 0; rep_ < NREP(17); ++rep_)
    for (int L = c.vcu; L < NBATCH * 4 * 32; L += c.G) {
        const int qb = L & 31, ph = L >> 5, idx = (ph & 7) * 4 + (ph >> 3), b = idx >> 2, h = idx & 3; const size_t rb = (size_t)b * SEQ;
        tat::unit96<8, 384, 384, 256, 1024, SC_MIXC>((const tat::bf16*)(QC + rb * 384 + h * 96), (const tat::bf16*)(KC + rb * 384 + h * 96), (const tat::bf16*)(VC + rb * 256 + h * 64), MIX8 + rb * 1024 + 768 + h * 64, SSQ + rb * 16 + 12 + h, qb * 256, (LAS char*)c.lds,
            [&]() { if (rep_ == 0) { const int nA = (NBATCH * 6 * 32 - c.vcu + c.G - 1) / c.G, nC = (NBATCH * 4 * 32 - c.vcu + c.G - 1) / c.G; convert_experts_part(c, l, nA + (L - c.vcu) / c.G, nA + nC); } });
    }
    for (int rep_ = 0; rep_ < NREP(18); ++rep_)
    for (int L = c.vcu; L < NBATCH * 6 * 32; L += c.G) {
        const int qb = L & 31, ph = L >> 5, idx = (ph & 7) * 6 + (ph >> 3), b = idx / 6, hq = idx % 6, kvh = hq / 3; const size_t rb = (size_t)b * SEQ;
        const int t_lo = (4 * qb - 2) < 0 ? 0 : 4 * qb - 2, t_hi = (4 * qb + 6) > SEQ / 64 ? SEQ / 64 : 4 * qb + 6;
        const float slope2 = exp2f(-8.f * (float)(hq + 1) / 6.f) * LOG2E, sink2 = sink[hq] * LOG2E;
        tat::unitB<8, 384, 128, 128, 1024, SC_MIXB>((const tat::bf16*)(QB + rb * 384 + hq * 64), (const tat::bf16*)(KB + rb * 128 + kvh * 64), (const tat::bf16*)(VB + rb * 128 + kvh * 64), MIX8 + rb * 1024 + 384 + hq * 64, SSQ + rb * 16 + 6 + hq, qb * 256, t_lo, t_hi - t_lo, slope2, sink2, (LAS char*)c.lds);
    }
}

__global__ void __launch_bounds__(NTHREADS, 2) mega_fwd(Args args) {
    extern __shared__ __attribute__((aligned(16))) unsigned char lds_raw[];
    Ctx c;
#define NEWCTX() do { int t_ = threadIdx.x; asm volatile("" : "+v"(t_)); c.lds = (LAS unsigned char*)lds_raw; c.ws = kargs()->ws; c.tid = t_; c.lane = t_ & 63; c.wave = __builtin_amdgcn_readfirstlane(t_ >> 6); \
        c.G = gridDim.x; { const int bx = blockIdx.x; c.vcu = (c.G % 8 == 0) ? (bx % 8) * (c.G / 8) + bx / 8 : bx; } c.gw = c.vcu * NWAVES + c.wave; c.NGW = c.G * NWAVES; } while (0)
    NEWCTX();
    unsigned char* ws = c.ws;
    for (int u = c.tid; u < (LDS_BYTES - LDSCTL_OFF) / 4; u += NTHREADS) ((LAS unsigned*)(c.lds + LDSCTL_OFF))[u] = 0u;
    __syncthreads();
    const int lo = kargs()->ph_lo, hi = kargs()->ph_hi;
    const bool multi = (hi - lo) > 1;
    XcdBarrier bar; bar.bar = (unsigned*)(ws + WS_CTL) + CW_BAR; bar.x = 0; bar.st = nullptr;
    if (multi) bar = xcd_barrier_post((unsigned*)(ws + WS_CTL) + CW_BAR, (volatile LAS unsigned*)(c.lds + MISC_OFF) + 8);
#ifndef PH_MASK
#define PH_MASK 0x7fff
#endif
#define HAS(p) (((PH_MASK) >> (p)) & 1)

#define IN(k) (lo <= (k) && (k) < hi)
#define SEAM(k) do { if (IN(k) && IN((k) + 1)) { XcdBarrier b2_ = bar; asm volatile("" : "+s"(b2_.bar)); xcd_barrier(b2_); } } while (0)

    if (HAS(13) && IN(0)) for (int rep_ = 0; rep_ < NREP(13); ++rep_) { NEWCTX(); prologue(c); __syncthreads(); } SEAM(0);

    for (int l = 0; l < DEPTH; ++l) {
        const int P = 1 + PH_PER_LAYER * l;
#define MODV_L ((const float*)(c.ws + WS_MODV) + (size_t)l * 8 * 6144)
        if (l == 0) {
        if (HAS(0) && IN(P + 0)) for (int rep_ = 0; rep_ < NREP(0); ++rep_) { NEWCTX(); norm_mod_rows<true>(c, kargs()->in[I_X], (bf16*)(c.ws + WS_XN), nullptr, kargs()->in[I_N1G], MODV_L, 0, 1); }
        SEAM(P + 0); }
        if (HAS(1) && IN(P + 1)) for (int rep_ = 0; rep_ < NREP(1); ++rep_) { NEWCTX(); pg8::Gemm g{(const bf16*)(c.ws + WS_XN), (const bf16*)(c.ws + WS_WIN) + (size_t)l * IN_WP * 1024, M, IN_WP, 1024}; pg8::StaticOrder S; S.init(M, IN_WP, c.G, (int)blockIdx.x);
            EpiInProj E{(bf16*)(c.ws + WS_PROJ), (bf16*)(c.ws + WS_VA), (bf16*)(c.ws + WS_QB), (bf16*)(c.ws + WS_KB), (bf16*)(c.ws + WS_VB)}; pg8::gemm_phase<EpiInProj, pg8::StaticOrder, true, false>(c.lds, g, S, E); }
        SEAM(P + 1);
        if (HAS(2) && IN(P + 2)) for (int rep_ = 0; rep_ < NREP(2); ++rep_) { NEWCTX(); qkv_prep_rows(c, l); }
        SEAM(P + 2);
        if (HAS(3) && IN(P + 3)) for (int rep_ = 0; rep_ < NREP(3); ++rep_) { NEWCTX(); pg8::Gemm g{(const bf16*)(c.ws + WS_CQK), (const bf16*)(c.ws + WS_WC) + (size_t)l * 1024 * 384, M, 1024, 384}; pg8::StaticOrder S; S.init(M, 1024, c.G, (int)blockIdx.x);
            EpiCup E{(bf16*)(c.ws + WS_QC), (bf16*)(c.ws + WS_KC), (bf16*)(c.ws + WS_VC), (const float*)(c.ws + WS_TABC), (const float*)(c.ws + WS_TABS)}; pg8::gemm_phase<EpiCup, pg8::StaticOrder, true, false>(c.lds, g, S, E); }
        SEAM(P + 3);
        if (HAS(4) && IN(P + 4)) for (int rep_ = 0; rep_ < NREP(4); ++rep_) { NEWCTX(); attention_phase(c, l); }
        SEAM(P + 4);
        if (HAS(6) && IN(P + 6)) { NEWCTX(); pg8::Gemm g{(const bf16*)(c.ws + WS_MIX), (const bf16*)(c.ws + WS_WOUT + (size_t)l * 1024 * 1024), M, 1024, 1024};     pg8::StaticOrder S; S.init(M, 1024, c.G, (int)blockIdx.x);
            { LAS float* rs = (LAS float*)(c.lds + RS_OFF); const float* SSQ = (const float*)(c.ws + WS_SSQ); pg8::Unit u;
              for (int i = 0; i < 4 && S.next(i, u); ++i) if (c.tid < 256) { const f32x4* sp = (const f32x4*)(SSQ + (size_t)(u.pm * 256 + c.tid) * 16); const f32x4 a0 = sp[0], a1 = sp[1], a2 = sp[2], a3 = sp[3];
                  const float sA = (a0.x + a0.y) + (a0.z + a0.w) + (a1.x + a1.y), sB = (a1.z + a1.w) + (a2.x + a2.y) + (a2.z + a2.w), sC = (a3.x + a3.y) + (a3.z + a3.w);
                  const float rA = 1.f / sqrtf(sA * (1.f / 384.f) + EPS), rB = 1.f / sqrtf(sB * (1.f / 384.f) + EPS), rC = 1.f / sqrtf(sC * (1.f / 256.f) + EPS);
                  LAS float* w = rs + (i * 256 + c.tid) * 3; w[0] = rA / rB * ((float)SC_MIXB / (float)SC_MIXA); w[1] = rB / rC * ((float)SC_MIXC / (float)SC_MIXB); w[2] = rC * (1.f / (SC_WO * (float)SC_MIXC)); }
              __syncthreads(); }
            if (l == 0) { EpiOutT<true> E{kargs()->in[I_X], (bf16*)(c.ws + WS_XB), MODV_L, (const LAS float*)(c.lds + RS_OFF)}; pg8::gemm_phase<EpiOutT<true>, pg8::StaticOrder, true, false, true>(c.lds, g, S, E); }
            else { EpiOutT<false> E{c.ws + WS_XB, (bf16*)(c.ws + WS_XB), MODV_L, (const LAS float*)(c.lds + RS_OFF)}; pg8::gemm_phase<EpiOutT<false>, pg8::StaticOrder, true, false, true>(c.lds, g, S, E); } }
        SEAM(P + 6);
        if (HAS(7) && IN(P + 7)) for (int rep_ = 0; rep_ < NREP(7); ++rep_) { NEWCTX(); norm2_rows(c, (const bf16*)(c.ws + WS_XB), (bf16*)(c.ws + WS_XN), c.ws + WS_U2F, kargs()->in[I_N2G] + l * 1024, MODV_L, 3, 4); }
        SEAM(P + 7);
        if (HAS(8) && IN(P + 8)) for (int rep_ = 0; rep_ < NREP(8); ++rep_) { NEWCTX(); pg8::Gemm g{(const bf16*)(c.ws + WS_XN), (const bf16*)(c.ws + WS_WR) + (size_t)l * 256 * 1024, M, 256, 1024}; pg8::StaticOrder S; S.init(M, 256, c.G, (int)blockIdx.x);
            pg8::EpiF32 E{(float*)(c.ws + WS_LOGITS), 256}; pg8::gemm_phase<pg8::EpiF32, pg8::StaticOrder, true, false>(c.lds, g, S, E); }
        SEAM(P + 8);
        if (HAS(9) && IN(P + 9)) for (int rep_ = 0; rep_ < NREP(9); ++rep_) { NEWCTX(); select_phase(c, l, DRY(9)); }
        SEAM(P + 9);
        if (HAS(10) && IN(P + 10)) for (int rep_ = 0; rep_ < NREP(10); ++rep_) { NEWCTX(); build_moe_tables(c, l); pg8::Gemm g{(const bf16*)(c.ws + WS_U2F), (const bf16*)(c.ws + WS_W13), M, NEX * 512, 1024}; MoeOrder S; S.init(c, 2, false);
            EpiE1 E{c.ws + WS_H}; pg8::gemm_phase<EpiE1, MoeOrder, true, true, true>(c.lds, g, S, E); }
        SEAM(P + 10);
        if (HAS(11) && IN(P + 11)) for (int rep_ = 0; rep_ < NREP(11); ++rep_) { NEWCTX(); build_moe_tables(c, l); pg8::Gemm g{(const bf16*)(c.ws + WS_H), (const bf16*)(c.ws + WS_W2), M, NEX * 1024, 256}; MoeOrderT<true> S; S.init(c, 4, true);
            EpiE2 E{(unsigned char*)(c.ws + WS_Y), (unsigned char*)(c.ws + WS_U2F), (const LAS int*)(c.lds + ETAB_OFF)}; pg8::gemm_phase<EpiE2, MoeOrderT<true>, true, false, true>(c.lds, g, S, E); }
        SEAM(P + 11);
        if (HAS(12) && IN(P + 12)) for (int rep_ = 0; rep_ < NREP(12); ++rep_) { NEWCTX(); combine_rows(c, l, DRY(12)); }
        SEAM(P + 12);
    }
#undef MODV_L
#undef IN
#undef SEAM
}

#ifndef MK_ONE_LAUNCH
#define MK_ONE_LAUNCH 1
#endif
extern "C" void kernel_launch(void* const* d_in, const int* in_sizes, int n_in, void* d_out, int out_size, void* d_ws, size_t ws_size, hipStream_t stream) {
    static int grid = 0;
    if (grid == 0) {
        if (n_in != N_IN || out_size != M * D || ws_size < WS_SSQ + 4 * MiB) { fprintf(stderr, "kernel_launch: unexpected shapes (n_in %d, out %d, ws %zu)\n", n_in, out_size, ws_size); grid = -1; return; }
        int dev = 0, cus = 0, per_cu = 0;
        if (hipGetDevice(&dev) != hipSuccess || hipDeviceGetAttribute(&cus, hipDeviceAttributeMultiprocessorCount, dev) != hipSuccess) { grid = -1; return; }
        if (hipFuncSetAttribute((const void*)mega_fwd, hipFuncAttributeMaxDynamicSharedMemorySize, LDS_BYTES) != hipSuccess) { fprintf(stderr, "kernel_launch: hipFuncSetAttribute failed\n"); grid = -1; return; }
        if (hipOccupancyMaxActiveBlocksPerMultiprocessor(&per_cu, (const void*)mega_fwd, NTHREADS, LDS_BYTES) != hipSuccess || per_cu < 1) fprintf(stderr, "kernel_launch: occupancy query says %d\n", per_cu);
        (void)hipGetLastError();
        grid = cus;
    }
    if (grid < 0) return;
    if (hipMemsetAsync((char*)d_ws + WS_CTL, 0, CTL_ZERO_BYTES, stream) != hipSuccess) return;
    Args a{};
    for (int i = 0; i < N_IN; ++i) a.in[i] = (const float*)d_in[i];
    a.out = (float*)d_out; a.ws = (unsigned char*)d_ws;
#if MK_ONE_LAUNCH
    a.ph_lo = 0; a.ph_hi = N_PHASES;
    hipLaunchKernelGGL(mega_fwd, dim3(grid), dim3(NTHREADS), LDS_BYTES, stream, a);
#else
    for (int p = 0; p < N_PHASES; ++p) { a.ph_lo = p; a.ph_hi = p + 1; hipLaunchKernelGGL(mega_fwd, dim3(grid), dim3(NTHREADS), LDS_BYTES, stream, a); }
#endif
}
```

```cpp
#include <hip/hip_runtime.h>
#include <hip/hip_bf16.h>
#include <cstdio>
#include <cstdint>
#include <cmath>
namespace pg8 {
#define PG8_LAS __attribute__((address_space(3)))
typedef unsigned short bf16_t;
typedef short bf16x8 __attribute__((ext_vector_type(8)));
typedef float f32x4 __attribute__((ext_vector_type(4)));
typedef unsigned u32x4 __attribute__((ext_vector_type(4)));
typedef unsigned u32x2 __attribute__((ext_vector_type(2)));
typedef int i32x4 __attribute__((ext_vector_type(4)));
typedef int i32x8 __attribute__((ext_vector_type(8)));
constexpr int BM = 256, BK = 64, HALF = 128, HTB = HALF * BK * 2  , STAGE_BYTES = 8 * HTB, NXCD = 8, WGM = 8;

__host__ __device__ __forceinline__ int lds_byte(int r, int c) { const int st = (r >> 4) * 2 + (c >> 5), rr = r & 15, cc = c & 31, ob = rr * 64 + cc * 2; return st * 1024 + (ob ^ (((ob >> 9) & 1) << 5)); }
__host__ __device__ __forceinline__ void stage_rc(int b, int& R, int& C) { const int st = b / 1024, sb = b % 1024, swz = sb ^ (((sb >> 9) & 1) << 5); R = (st >> 1) * 16 + swz / 64; C = (st & 1) * 32 + (swz % 64) / 2; }
__host__ __device__ __forceinline__ int perm32(int rho) { const int n = rho >> 4, i = rho & 15; return 8 * (i >> 2) + 4 * n + (i & 3); }

struct Unit { int pm, pn; int e, blk, rows, slot; };
struct Gemm { const bf16_t* A; const bf16_t* Bt; int M, N, K; };

struct StaticOrder {
    static constexpr bool SHARE_A = false;
    int nM, nN, nwg, G, c;
    __host__ __device__ __forceinline__ void init(int M, int N, int G_, int c_) { nM = M / BM; nN = N / BM; nwg = nM * nN; G = G_; c = c_; }
    __host__ __device__ __forceinline__ bool next(int i, Unit& u) const {
        const long L = (long)i * G + c; if (L >= nwg) return false;
        int wgid = (int)L; { const int q = nwg / NXCD, r = nwg % NXCD, xcd = wgid % NXCD, off = wgid / NXCD; wgid = (xcd < r ? xcd * (q + 1) : r * (q + 1) + (xcd - r) * q) + off; }
        const int nig = WGM * nN, gid = wgid / nig, fm = gid * WGM, gsz = (nM - fm) < WGM ? (nM - fm) : WGM;
        u.pm = fm + ((wgid % nig) % gsz); u.pn = (wgid % nig) / gsz; u.e = 0; u.blk = 0; u.rows = BM; u.slot = i; return true;
    }
    __device__ __forceinline__ void a_ready(const Unit&) const {}
    __device__ __forceinline__ void done(const Unit&) const {}
    __device__ __forceinline__ void offsets(const Unit&, unsigned (&)[2][2], int, int, int, int) const {}
};

__device__ __forceinline__ unsigned cvt_pk_bf16(float lo, float hi) { unsigned r; asm volatile("v_cvt_pk_bf16_f32 %0, %1, %2" : "=v"(r) : "v"(lo), "v"(hi)); return r; }

struct EpiBf16 {
    static constexpr bool PERM = true, KSCALE = false;
    bf16_t* O; int ldc;
    __device__ __forceinline__ void operator()(const f32x4 (&acc)[2][2][4][2], const Unit& u, int wr, int wc, int fr, int fq) const {
        const int row0 = u.pm * BM + wr * 64 + fr; const int col0 = u.pn * BM + wc * 32 + 8 * fq;
#pragma unroll
        for (int ai = 0; ai < 2; ++ai)
#pragma unroll
            for (int m = 0; m < 4; ++m) { bf16_t* rowp = O + (size_t)(row0 + ai * HALF + m * 16) * ldc + col0;
#pragma unroll
                for (int bj = 0; bj < 2; ++bj) { const f32x4 v0 = acc[ai][bj][m][0], v1 = acc[ai][bj][m][1];
                    u32x4 w; w.x = cvt_pk_bf16(v0[0], v0[1]); w.y = cvt_pk_bf16(v0[2], v0[3]); w.z = cvt_pk_bf16(v1[0], v1[1]); w.w = cvt_pk_bf16(v1[2], v1[3]);
                    *(u32x4*)(rowp + bj * HALF) = w; } }
    }
};
struct EpiF32 {
    static constexpr bool PERM = false, KSCALE = false;
    float* C; int ldc;
    __device__ __forceinline__ void operator()(const f32x4 (&acc)[2][2][4][2], const Unit& u, int wr, int wc, int fr, int fq) const {
        const int row0 = u.pm * BM + wr * 64 + fr, col0 = u.pn * BM + wc * 32 + 4 * fq;
#pragma unroll
        for (int ai = 0; ai < 2; ++ai)
#pragma unroll
            for (int m = 0; m < 4; ++m) { float* rowp = C + (size_t)(row0 + ai * HALF + m * 16) * ldc + col0;
#pragma unroll
                for (int bj = 0; bj < 2; ++bj)
#pragma unroll
                    for (int n = 0; n < 2; ++n) *(f32x4*)(rowp + bj * HALF + n * 16) = acc[ai][bj][m][n]; }
    }
};

template <class Epi, class Sched, bool ALIGN_EPI = false, bool GATHER = false, bool FP8 = false>
__device__ __forceinline__ void gemm_phase(PG8_LAS unsigned char* lds, const Gemm g, const Sched& S, const Epi& E) {
    int tid_ = threadIdx.x; asm volatile("" : "+v"(tid_));
    const int tid = tid_, wid = __builtin_amdgcn_readfirstlane(tid >> 6), lane = tid & 63, wr = wid >> 2, wc = wid & 3, fr = lane & 15, fq = lane >> 4;
    const int K = g.K; const int rowB = FP8 ? K : 2 * K; const int nt = rowB / (2 * BK);
    const size_t kstep = (size_t)(BK * 2);
    const size_t hstep = (size_t)HALF * rowB;
    const size_t tstep = 2 * hstep;
    unsigned voffA[2], voffB[2]; unsigned vA[2][2], vAn[2][2]; int sR[2], sC[2];
#pragma unroll
    for (int i = 0; i < 2; ++i) { int R, C; stage_rc(tid * 16 + i * 8192, R, C); const int Rb = Epi::PERM ? ((R & ~31) + perm32(R & 31)) : R; sR[i] = R; sC[i] = C;
        voffA[i] = (unsigned)(R * rowB + C * 2); voffB[i] = (unsigned)(Rb * rowB + C * 2);
        vA[0][i] = 0u; vA[1][i] = 0u; vAn[0][i] = 0u; vAn[1][i] = 0u; }
    const size_t ahs = GATHER ? (size_t)0 : hstep;
    const unsigned lds0 = (unsigned)(uintptr_t)lds;
    const unsigned ldsw = (unsigned)wid * 1024u;
    const int aoff = lds_byte(wr * 64 + fr, fq * 8), boff = lds_byte(wc * 32 + fr, fq * 8);
#define PG8_SA(b, h) (((b) * 2 + (h)) * HTB)
#define PG8_SB(b, h) ((4 + (b) * 2 + (h)) * HTB)
#define PG8_GLDS(base_, voff_, ldsdst_) do { unsigned keep_; asm volatile("s_mov_b32 %0, m0\n\ts_mov_b32 m0, %3\n\ts_nop 0\n\tglobal_load_lds_dwordx4 %1, %2\n\ts_mov_b32 m0, %0" \
        : "=&s"(keep_) : "v"(voff_), "s"(base_), "s"(ldsdst_) : "memory"); } while (0)
#define PG8_STAGE(bufoff, gbase, voff) do { const char* gb_ = (const char*)(gbase); _Pragma("unroll") for (int _i = 0; _i < 2; ++_i) \
        PG8_GLDS(gb_, (voff)[_i], (unsigned)__builtin_amdgcn_readfirstlane((int)(lds0 + (unsigned)(bufoff) + ldsw + _i * 8192))); } while (0)
#define PG8_STAGE_A(bufoff, gbase, h, vg) do { if constexpr (GATHER) PG8_STAGE(bufoff, gbase, vg); else PG8_STAGE(bufoff, (gbase) + (h) * ahs, voffA); } while (0)
#define PG8_LDA(dst, b, h) do { _Pragma("unroll") for (int m = 0; m < 4; ++m) _Pragma("unroll") for (int k = 0; k < 2; ++k) dst[m][k] = *(const PG8_LAS bf16x8*)(lds + PG8_SA(b, h) + aoff + m * 2048 + k * 1024); } while (0)
#define PG8_LDB(dst, b, h) do { _Pragma("unroll") for (int n = 0; n < 2; ++n) _Pragma("unroll") for (int k = 0; k < 2; ++k) dst[n][k] = *(const PG8_LAS bf16x8*)(lds + PG8_SB(b, h) + boff + n * 2048 + k * 1024); } while (0)
#define PG8_CAT8(x) __builtin_shufflevector(__builtin_bit_cast(i32x4, (x)[0]), __builtin_bit_cast(i32x4, (x)[1]), 0, 1, 2, 3, 4, 5, 6, 7)
#define PG8_MMA(ai, bj, At, Bt) do { __builtin_amdgcn_s_setprio(1); _Pragma("unroll") for (int m = 0; m < 4; ++m) _Pragma("unroll") for (int n = 0; n < 2; ++n) { \
        if constexpr (FP8) {   \
            asm volatile("v_mfma_scale_f32_16x16x128_f8f6f4 %0, %1, %2, %0, %3, %3 op_sel_hi:[0,0,0]" : "+v"(acc[ai][bj][m][n]) : "v"(PG8_CAT8(Bt[n])), "v"(PG8_CAT8(At[m])), "v"(sc_one)); } \
        else { _Pragma("unroll") for (int k = 0; k < 2; ++k) acc[ai][bj][m][n] = __builtin_amdgcn_mfma_f32_16x16x32_bf16(Bt[n][k], At[m][k], acc[ai][bj][m][n], 0, 0, 0); } } \
        __builtin_amdgcn_s_setprio(0); } while (0)
#define PG8_WAIT_V(n) asm volatile("s_waitcnt vmcnt(" #n ")" ::: "memory")
#define PG8_WAIT_L(n) asm volatile("s_waitcnt lgkmcnt(" #n ")" ::: "memory")
#define PG8_BAR __builtin_amdgcn_s_barrier()
#define PG8_SCHED __builtin_amdgcn_sched_barrier(0)
    Unit cur, nxt; int ui = 0;
    constexpr bool SHARE = Sched::SHARE_A; bool cur_new = true, nxt_new = true;
    if (!S.next(0, cur)) return;
    f32x4 acc[2][2][4][2];
#pragma unroll
    for (int a = 0; a < 2; ++a)
#pragma unroll
        for (int b = 0; b < 2; ++b)
#pragma unroll
            for (int m = 0; m < 4; ++m)
#pragma unroll
                for (int n = 0; n < 2; ++n) acc[a][b][m][n] = (f32x4){0.f, 0.f, 0.f, 0.f};
    bf16x8 At[4][2], B0[2][2], B1[2][2];
    int sc_one = 0x7F7F7F7F; asm volatile("" : "+v"(sc_one));
    const char* cA = GATHER ? (const char*)g.A : (const char*)g.A + (size_t)cur.pm * tstep; const char* cB = (const char*)g.Bt + (size_t)cur.pn * tstep;
    if constexpr (GATHER) S.offsets(cur, vA, sR[0], sC[0], sR[1], sC[1]);
    S.a_ready(cur);
    Unit nn; bool has_next = false, has_nn = false; unsigned rawn[2][2] = {{0u, 0u}, {0u, 0u}};
    if constexpr (GATHER) { has_next = S.next(1, nxt); if (has_next) S.offsets_raw(nxt, rawn, sR[0], sR[1]); }
    PG8_STAGE(PG8_SB(0, 0), cB, voffB); PG8_STAGE(PG8_SB(0, 1), cB + hstep, voffB); PG8_STAGE_A(PG8_SA(0, 0), cA, 0, vA[0]); PG8_STAGE_A(PG8_SA(0, 1), cA, 1, vA[1]);
    if (wr == 1) PG8_BAR;
    PG8_WAIT_V(2); PG8_BAR;
    PG8_STAGE(PG8_SB(1, 0), cB + kstep, voffB); PG8_STAGE_A(PG8_SA(1, 0), cA + kstep, 0, vA[0]); PG8_STAGE(PG8_SB(1, 1), cB + hstep + kstep, voffB);
    PG8_WAIT_V(6); PG8_BAR;
    if constexpr (GATHER) { if (has_next) S.offsets_fin(rawn, vAn, sC[0], sC[1]); else { vAn[0][0] = vA[0][0]; vAn[0][1] = vA[0][1]; vAn[1][0] = vA[1][0]; vAn[1][1] = vA[1][1]; } }
    for (;;) {
        if constexpr (!GATHER) has_next = S.next(ui + 1, nxt);
        if constexpr (SHARE) nxt_new = !(has_next && nxt.pm == cur.pm);
        const char* nA = GATHER ? cA : (has_next ? (const char*)g.A + (size_t)nxt.pm * tstep : cA); const char* nB = has_next ? (const char*)g.Bt + (size_t)nxt.pn * tstep : cB;
        for (int t = 0; t < nt; t += 2) {
            const bool last = (t == nt - 2);
            const char* a1 = cA + (size_t)(t + 1) * kstep;
            const char* a2 = last ? nA : cA + (size_t)(t + 2) * kstep; const char* b2 = last ? nB : cB + (size_t)(t + 2) * kstep;
            const char* a3 = a2 + kstep; const char* b3 = b2 + kstep;
            unsigned w0[2], w1[2];
            if constexpr (GATHER) { w0[0] = last ? vAn[0][0] : vA[0][0]; w0[1] = last ? vAn[0][1] : vA[0][1]; w1[0] = last ? vAn[1][0] : vA[1][0]; w1[1] = last ? vAn[1][1] : vA[1][1]; }
            else { w0[0] = 0u; w0[1] = 0u; w1[0] = 0u; w1[1] = 0u; }
            if (last && has_next) S.a_ready(nxt);
            if constexpr (Epi::KSCALE) { if (t == Epi::KS_TOP) { if constexpr (FP8) asm volatile("s_nop 15\n\ts_nop 15" ::: "memory"); PG8_SCHED; E.kscale(acc, cur, 1, wr); PG8_SCHED; } }
            PG8_LDB(B0, 0, 0); PG8_LDB(B1, 0, 1); PG8_SCHED; PG8_LDA(At, 0, 0); if (!SHARE || cur_new) PG8_STAGE_A(PG8_SA(1, 1), a1, 1, vA[1]);
            if constexpr (SHARE) { if (cur_new) PG8_WAIT_V(8); } else PG8_WAIT_V(8);
            PG8_WAIT_L(0); PG8_BAR; PG8_MMA(0, 0, At, B0); PG8_MMA(0, 1, At, B1); PG8_BAR; PG8_SCHED;
            PG8_LDA(At, 0, 1); PG8_STAGE(PG8_SB(0, 0), b2, voffB); PG8_STAGE(PG8_SB(0, 1), b2 + hstep, voffB); if (!SHARE || nxt_new) PG8_STAGE_A(PG8_SA(0, 0), a2, 0, w0);
            if constexpr (SHARE) { if (cur_new && nxt_new) PG8_WAIT_V(8); else if (cur_new || nxt_new) PG8_WAIT_V(6); else PG8_WAIT_V(4); } else PG8_WAIT_V(8);
            PG8_WAIT_L(0); PG8_BAR; PG8_MMA(1, 0, At, B0); PG8_MMA(1, 1, At, B1); PG8_BAR; PG8_SCHED;
            if constexpr (Epi::KSCALE) { if (t + 1 == Epi::KS_MID) { if constexpr (FP8) asm volatile("s_nop 15\n\ts_nop 15" ::: "memory"); PG8_SCHED; E.kscale(acc, cur, 0, wr); PG8_SCHED; } }
            PG8_LDB(B0, 1, 0); PG8_LDB(B1, 1, 1); PG8_SCHED; PG8_LDA(At, 1, 0); if (!SHARE || nxt_new) PG8_STAGE_A(PG8_SA(0, 1), a2, 1, w1);
            if constexpr (SHARE) { if (cur_new) { if (nxt_new) PG8_WAIT_V(8); else PG8_WAIT_V(4); } } else PG8_WAIT_V(8);
            PG8_WAIT_L(0); PG8_BAR; PG8_MMA(0, 0, At, B0); PG8_MMA(0, 1, At, B1); PG8_BAR; PG8_SCHED;
            PG8_LDA(At, 1, 1); PG8_STAGE(PG8_SB(1, 0), b3, voffB); PG8_STAGE(PG8_SB(1, 1), b3 + hstep, voffB); if (!SHARE || nxt_new) PG8_STAGE_A(PG8_SA(1, 0), a3, 0, w0);
            if constexpr (SHARE) { if (nxt_new) PG8_WAIT_V(8); else PG8_WAIT_V(4); } else PG8_WAIT_V(8);
            PG8_WAIT_L(0); PG8_BAR; PG8_MMA(1, 0, At, B0); PG8_MMA(1, 1, At, B1); PG8_BAR; PG8_SCHED;
        }
        if constexpr (GATHER) { has_nn = has_next && S.next(ui + 2, nn); if (has_nn) S.offsets_raw(nn, rawn, sR[0], sR[1]); }
        if constexpr (ALIGN_EPI) { if (wr == 0) PG8_BAR; }
        if constexpr (FP8) { asm volatile("s_nop 15\n\ts_nop 15" ::: "memory"); PG8_SCHED; }
        E(acc, cur, wr, wc, fr, fq); S.done(cur);
        if (!has_next) break;
#pragma unroll
        for (int a = 0; a < 2; ++a)
#pragma unroll
            for (int b = 0; b < 2; ++b)
#pragma unroll
                for (int m = 0; m < 4; ++m)
#pragma unroll
                    for (int n = 0; n < 2; ++n) acc[a][b][m][n] = (f32x4){0.f, 0.f, 0.f, 0.f};
        cur = nxt; cA = nA; cB = nB; ++ui; if constexpr (SHARE) cur_new = nxt_new;
        if constexpr (GATHER) { vA[0][0] = vAn[0][0]; vA[0][1] = vAn[0][1]; vA[1][0] = vAn[1][0]; vA[1][1] = vAn[1][1]; if (has_nn) S.offsets_fin(rawn, vAn, sC[0], sC[1]); nxt = nn; has_next = has_nn; }
        if constexpr (ALIGN_EPI) { if (wr == 1) PG8_BAR; }
    }
    PG8_WAIT_V(0);
    if constexpr (!ALIGN_EPI) { if (wr == 0) PG8_BAR; }
    PG8_BAR;
#undef PG8_SA
#undef PG8_SB
#undef PG8_STAGE
#undef PG8_GLDS
#undef PG8_STAGE_A
#undef PG8_LDA
#undef PG8_LDB
#undef PG8_MMA
#undef PG8_CAT8
#undef PG8_WAIT_V
#undef PG8_WAIT_L
#undef PG8_BAR
#undef PG8_SCHED
}
}
namespace sat {
using bf16x8 = __attribute__((ext_vector_type(8))) short;
using s16x4 = __attribute__((ext_vector_type(4))) short;
using f32x16 = __attribute__((ext_vector_type(16))) float;
using u32x4 = __attribute__((ext_vector_type(4))) unsigned;
typedef unsigned short bf16_t;
#define SAT_LAS __attribute__((address_space(3)))
constexpr int KSLOT = 12288, VSLOT = 8192;
constexpr int L_K = 0, L_V = 2 * KSLOT, L_WS = L_V + 2 * VSLOT, L_OST = L_WS + 8 * 256, L_BYTES = L_OST + 8 * 4096;
__device__ __forceinline__ int crow(int r, int hi) { return (r & 3) + 8 * (r >> 2) + 4 * hi; }
__device__ __forceinline__ void glds16(const void* gsrc, unsigned lds_dst) { unsigned keep;
    asm volatile("s_mov_b32 %0, m0\n\ts_mov_b32 m0, %2\n\ts_nop 0\n\tglobal_load_lds_dwordx4 %1, off\n\ts_mov_b32 m0, %0" : "=&s"(keep) : "v"(gsrc), "s"(lds_dst) : "memory"); }
typedef float f32x2_t __attribute__((ext_vector_type(2))); typedef __bf16 bf16x2_t __attribute__((ext_vector_type(2)));
__device__ __forceinline__ unsigned cvtpk_s(float lo, float hi) { f32x2_t v = {lo, hi}; bf16x2_t b = __builtin_convertvector(v, bf16x2_t); return __builtin_bit_cast(unsigned, b); }
#define SAT_MX3(a, b, c) __builtin_fmaxf(__builtin_fmaxf((a), (b)), (c))
__device__ __forceinline__ float rowmax(const f32x16& p0, const f32x16& p1) {
    float a = SAT_MX3(p0[0], p0[1], p1[0]), b = SAT_MX3(p0[2], p0[3], p1[1]); a = SAT_MX3(a, p1[2], p1[3]);
#pragma unroll
    for (int r = 4; r < 16; r += 4) { a = SAT_MX3(a, p0[r], p0[r + 1]); b = SAT_MX3(b, p0[r + 2], p0[r + 3]); a = SAT_MX3(a, p1[r], p1[r + 1]); b = SAT_MX3(b, p1[r + 2], p1[r + 3]); }
    float m = __builtin_fmaxf(a, b); auto rr = __builtin_amdgcn_permlane32_swap(__float_as_uint(m), __float_as_uint(m), false, false);
    return __builtin_fmaxf(__uint_as_float(rr[0]), __uint_as_float(rr[1])); }
__device__ __forceinline__ void pv(f32x16* o, int vb, bf16x8 pa0, bf16x8 pa1, bf16x8 pa2, bf16x8 pa3) {
#pragma unroll
    for (int d0 = 0; d0 < 2; ++d0) { s16x4 lo[4], hi[4];
#pragma unroll
        for (int ks = 0; ks < 4; ++ks) {
            asm volatile("ds_read_b64_tr_b16 %0,%1 offset:%c2" : "=&v"(lo[ks]) : "v"(vb), "i"(d0 * 4096 + ks * 1024) : "memory");
            asm volatile("ds_read_b64_tr_b16 %0,%1 offset:%c2" : "=&v"(hi[ks]) : "v"(vb), "i"(d0 * 4096 + ks * 1024 + 512) : "memory"); }
        asm volatile("s_waitcnt lgkmcnt(0)" : "+v"(lo[0]), "+v"(lo[1]), "+v"(lo[2]), "+v"(lo[3]), "+v"(hi[0]), "+v"(hi[1]), "+v"(hi[2]), "+v"(hi[3]) :: "memory"); __builtin_amdgcn_sched_barrier(0);
#define SAT_PK(k) (bf16x8){lo[k][0], lo[k][1], lo[k][2], lo[k][3], hi[k][0], hi[k][1], hi[k][2], hi[k][3]}
        o[d0] = __builtin_amdgcn_mfma_f32_32x32x16_bf16(pa0, SAT_PK(0), o[d0], 0, 0, 0);
        o[d0] = __builtin_amdgcn_mfma_f32_32x32x16_bf16(pa1, SAT_PK(1), o[d0], 0, 0, 0);
        o[d0] = __builtin_amdgcn_mfma_f32_32x32x16_bf16(pa2, SAT_PK(2), o[d0], 0, 0, 0);
        o[d0] = __builtin_amdgcn_mfma_f32_32x32x16_bf16(pa3, SAT_PK(3), o[d0], 0, 0, 0);
#undef SAT_PK
    }
}
#define SAT_WAIT_BAR() asm volatile("s_waitcnt vmcnt(0) lgkmcnt(0)\n\ts_barrier" ::: "memory")

template <int DQK, int MODE>
__device__ __forceinline__ void unit(const bf16_t* Qp, int qpitch, const bf16_t* __restrict__ Kp, int kpitch, const bf16_t* __restrict__ Vp, int vpitch, bf16_t* Op, int opitch,
                                     int q0, int t_lo, int t_hi, float slope2, float sink2, SAT_LAS unsigned char* shm) {
    constexpr int NCH = DQK / 8, ND0 = DQK / 16;
    int tid_ = threadIdx.x; asm volatile("" : "+v"(tid_));
    const int tid = tid_, lane = tid & 63, r32 = lane & 31, hi = lane >> 5; const int wid = __builtin_amdgcn_readfirstlane(tid >> 6);
    const unsigned lds0 = (unsigned)(uintptr_t)shm;
    SAT_LAS float* wsf = (SAT_LAS float*)(shm + L_WS) + wid * 64;
    const bf16_t* ksrc = Kp + (size_t)lane * kpitch + wid * 8;
    const bf16_t* vsrc = Vp + (size_t)(16 * (wid & 3) + (lane >> 2)) * vpitch + (wid >> 2) * 32 + (lane & 3) * 8;
    const unsigned kdst = lds0 + L_K + wid * 1024, vdst = lds0 + L_V + wid * 1024;
#define SAT_DMA(t, bsel) do { glds16(ksrc + (size_t)(t) * 64 * kpitch, (unsigned)__builtin_amdgcn_readfirstlane(kdst + (bsel) * KSLOT)); \
        if (NCH > 8 && wid < NCH - 8) glds16(ksrc + (size_t)(t) * 64 * kpitch + 64, (unsigned)__builtin_amdgcn_readfirstlane(kdst + (bsel) * KSLOT + 8192)); \
        glds16(vsrc + (size_t)(t) * 64 * vpitch, (unsigned)__builtin_amdgcn_readfirstlane(vdst + (bsel) * VSLOT)); } while (0)
    const int vb0 = (int)(lds0 + L_V) + ((lane >> 4) & 1) * 32 + (lane & 3) * 8 + (4 * hi + ((lane & 15) >> 2)) * 64;
    SAT_DMA(t_lo, 0);
    bf16x8 qr[ND0];
    { const bf16_t* Qw = Qp + (size_t)(q0 + wid * 32 + r32) * qpitch + hi * 8;
#pragma unroll
      for (int d0 = 0; d0 < ND0; ++d0) qr[d0] = *reinterpret_cast<const bf16x8*>(Qw + d0 * 16); }
    float mhat = (MODE == 1) ? sink2 : -1e30f, l_reg = (MODE == 1 && hi == 0) ? 1.f : 0.f;
    f32x16 o[2]; o[0] = f32x16{}; o[1] = f32x16{};
    const int qrow = q0 + wid * 32 + r32;
    const int wlo = q0 + wid * 32 - 128, whi = q0 + wid * 32 + 31 + 128;
    SAT_WAIT_BAR();
    int bsel = 0;
    for (int t = t_lo; t < t_hi; ++t) {
        if (t + 1 < t_hi) SAT_DMA(t + 1, bsel ^ 1);
        const bool active = (MODE == 0) || (64 * t + 63 >= wlo && 64 * t <= whi);
        if (active) {
            const SAT_LAS unsigned char* kb = shm + L_K + bsel * KSLOT + hi * 1024 + r32 * 16;
            f32x16 p0 = f32x16{}, p1 = f32x16{};
#pragma unroll
            for (int d0 = 0; d0 < ND0; ++d0) {
                const bf16x8 b0 = *reinterpret_cast<const SAT_LAS bf16x8*>(kb + d0 * 2048);
                const bf16x8 b1 = *reinterpret_cast<const SAT_LAS bf16x8*>(kb + d0 * 2048 + 512);
                p0 = __builtin_amdgcn_mfma_f32_32x32x16_bf16(b0, qr[d0], p0, 0, 0, 0); p1 = __builtin_amdgcn_mfma_f32_32x32x16_bf16(b1, qr[d0], p1, 0, 0, 0); }
            if (MODE == 1) {
                const int kbase = 64 * t + 4 * hi - qrow;
#pragma unroll
                for (int r = 0; r < 16; ++r) { const int rel = kbase + (r & 3) + 8 * (r >> 2); const int d0_ = rel < 0 ? -rel : rel; const int rel1 = rel + 32; const int d1_ = rel1 < 0 ? -rel1 : rel1;
                    p0[r] = d0_ <= 128 ? p0[r] - slope2 * (float)d0_ : -INFINITY; p1[r] = d1_ <= 128 ? p1[r] - slope2 * (float)d1_ : -INFINITY; } }
            const float rm = rowmax(p0, p1);
            const float mnew = __builtin_fmaxf(mhat, rm); const float alpha = __builtin_amdgcn_exp2f(mhat - mnew); mhat = mnew;
            float psum = 0.f;
#pragma unroll
            for (int r = 0; r < 16; ++r) { p0[r] = __builtin_amdgcn_exp2f(p0[r] - mnew); p1[r] = __builtin_amdgcn_exp2f(p1[r] - mnew); psum += p0[r] + p1[r]; }
            l_reg = l_reg * alpha + psum;
            if (hi == 0) wsf[r32] = alpha;
            asm volatile("s_waitcnt lgkmcnt(0)" ::: "memory");
#pragma unroll
            for (int r = 0; r < 16; ++r) { const float f = wsf[crow(r, hi)]; o[0][r] *= f; o[1][r] *= f; }
            u32x4 pw0, pw1, pw2, pw3;
#define SAT_PKW(P, B) cvtpk_s(P[B], P[B + 1])
            pw0 = (u32x4){SAT_PKW(p0, 0), SAT_PKW(p0, 2), SAT_PKW(p0, 4), SAT_PKW(p0, 6)}; pw1 = (u32x4){SAT_PKW(p0, 8), SAT_PKW(p0, 10), SAT_PKW(p0, 12), SAT_PKW(p0, 14)};
            pw2 = (u32x4){SAT_PKW(p1, 0), SAT_PKW(p1, 2), SAT_PKW(p1, 4), SAT_PKW(p1, 6)}; pw3 = (u32x4){SAT_PKW(p1, 8), SAT_PKW(p1, 10), SAT_PKW(p1, 12), SAT_PKW(p1, 14)};
#undef SAT_PKW
            asm volatile("s_waitcnt lgkmcnt(0)" ::: "memory"); __builtin_amdgcn_sched_barrier(0);
            pv(o, vb0 + bsel * VSLOT, __builtin_bit_cast(bf16x8, pw0), __builtin_bit_cast(bf16x8, pw1), __builtin_bit_cast(bf16x8, pw2), __builtin_bit_cast(bf16x8, pw3));
        }
        SAT_WAIT_BAR();
        bsel ^= 1;
    }
    { auto rr = __builtin_amdgcn_permlane32_swap(__float_as_uint(l_reg), __float_as_uint(l_reg), false, false); l_reg = __uint_as_float(rr[0]) + __uint_as_float(rr[1]); }
    if (hi == 0) wsf[32 + r32] = l_reg; asm volatile("s_waitcnt lgkmcnt(0)" ::: "memory");
    float rli[16];
#pragma unroll
    for (int r = 0; r < 16; ++r) rli[r] = __builtin_amdgcn_rcpf(wsf[32 + crow(r, hi)]);
    bf16_t* Ow = Op + (size_t)(q0 + wid * 32) * opitch;
    { SAT_LAS bf16_t* stg = (SAT_LAS bf16_t*)(shm + L_OST) + wid * 2048;
#pragma unroll
      for (int r = 0; r < 16; ++r) { const int orow = crow(r, hi);
#pragma unroll
          for (int d0 = 0; d0 < 2; ++d0) stg[orow * 64 + d0 * 32 + r32] = (bf16_t)(cvtpk_s(o[d0][r] * rli[r], 0.f) & 0xffffu); }
      asm volatile("s_waitcnt lgkmcnt(0)" ::: "memory");
#pragma unroll
      for (int i = 0; i < 4; ++i) { const int row = i * 8 + (lane >> 3), ch = lane & 7; const u32x4 v = *(const SAT_LAS u32x4*)(stg + row * 64 + ch * 8); *(u32x4*)(Ow + (size_t)row * opitch + ch * 8) = v; } }
    asm volatile("s_waitcnt lgkmcnt(0)\n\ts_barrier" ::: "memory");
#undef SAT_DMA
}
}
namespace tat {
using bf16=__hip_bfloat16;
using bf16x8=__attribute__((ext_vector_type(8)))short;
using s16x4=__attribute__((ext_vector_type(4)))short;
using f32x16=__attribute__((ext_vector_type(16)))float;
using u32x4=__attribute__((ext_vector_type(4)))unsigned;
constexpr int SEQ=8192,D=64;
constexpr int NW=8,QBLK=32,QB=QBLK*NW,KVBLK=64,NQB=SEQ/QB;
__device__ __forceinline__ int crow(int r,int hi){return (r&3)+8*(r>>2)+4*hi;}
#define SBAR() __builtin_amdgcn_sched_barrier(0)
__device__ __forceinline__ void cmask(f32x16&p0,f32x16&p1,int jb,int qrel,int hi){
  const float NEG=-INFINITY; int kb=64*jb+4*hi;
  #pragma unroll
  for(int r=0;r<16;++r){int kv=kb+(r&3)+8*(r>>2); if(kv>qrel)p0[r]=NEG; if(kv+32>qrel)p1[r]=NEG;}
}

constexpr int NSLOT=3, SLOTB=8192;
constexpr int LDS_K=0, LDS_V=NSLOT*SLOTB, LDS_WS=2*NSLOT*SLOTB, LDS_OST=LDS_WS+NW*64*4, LDS_BYTES=LDS_OST+NW*4096;
constexpr float C2=0.125f*1.4426950408889634f;
__device__ __forceinline__ void glds16(const void*gsrc,unsigned lds_dst){unsigned keep;
  asm volatile("s_mov_b32 %0, m0\n\ts_mov_b32 m0, %2\n\ts_nop 0\n\tglobal_load_lds_dwordx4 %1, off\n\ts_mov_b32 m0, %0":"=&s"(keep):"v"(gsrc),"s"(lds_dst):"memory");}
__device__ __forceinline__ void glds16s(const void*sbase,unsigned voff,unsigned lds_dst){unsigned keep;
  asm volatile("s_mov_b32 %0, m0\n\ts_mov_b32 m0, %3\n\ts_nop 0\n\tglobal_load_lds_dwordx4 %1, %2\n\ts_mov_b32 m0, %0":"=&s"(keep):"v"(voff),"s"(sbase),"s"(lds_dst):"memory");}
__device__ __forceinline__ float max3f(float a,float b,float c){float r;asm("v_max3_f32 %0, %1, %2, %3":"=v"(r):"v"(a),"v"(b),"v"(c));return r;}
__device__ __forceinline__ float max2f(float a,float b){float r;asm("v_max_f32_e32 %0, %1, %2":"=v"(r):"v"(a),"v"(b));return r;}
__device__ __forceinline__ float fadd_s(float a,float b){float r;asm("v_add_f32_e32 %0, %1, %2":"=v"(r):"v"(a),"v"(b));return r;}
__device__ __forceinline__ float fsub_s(float a,float b){float r;asm("v_sub_f32_e32 %0, %1, %2":"=v"(r):"v"(a),"v"(b));return r;}
typedef float f32x2_t __attribute__((ext_vector_type(2))); typedef __bf16 bf16x2_t __attribute__((ext_vector_type(2)));
__device__ __forceinline__ unsigned cvtpk_s(float lo,float hi){f32x2_t v={lo,hi};bf16x2_t b=__builtin_convertvector(v,bf16x2_t);return __builtin_bit_cast(unsigned,b);}
#define WAIT_BAR(N) asm volatile("s_waitcnt vmcnt(" #N ") lgkmcnt(0)\n\ts_barrier":::"memory")

typedef __attribute__((address_space(3))) const char* lds_cptr;
template<int CTRL> __device__ __forceinline__ float dppf(float v){const int i=__builtin_bit_cast(int,v);return __builtin_bit_cast(float,__builtin_amdgcn_update_dpp(i,i,CTRL,0xF,0xF,false));}
__device__ __forceinline__ void qkt(f32x16&p0,f32x16&p1,lds_cptr Kslot,const bf16x8*qr,const f32x16&negm,int r32,int hi){
  const lds_cptr kb=Kslot+hi*1024+r32*16;
  #pragma unroll
  for(int d0=0;d0<4;++d0){
    const bf16x8 b0=*(const __attribute__((address_space(3))) bf16x8*)(kb+d0*2048);
    const bf16x8 b1=*(const __attribute__((address_space(3))) bf16x8*)(kb+d0*2048+512);
    if(d0==0){p0=__builtin_amdgcn_mfma_f32_32x32x16_bf16(b0,qr[0],negm,0,0,0);p1=__builtin_amdgcn_mfma_f32_32x32x16_bf16(b1,qr[0],negm,0,0,0);}
    else{p0=__builtin_amdgcn_mfma_f32_32x32x16_bf16(b0,qr[d0],p0,0,0,0);p1=__builtin_amdgcn_mfma_f32_32x32x16_bf16(b1,qr[d0],p1,0,0,0);}}
}
typedef short v4i16_t __attribute__((ext_vector_type(4)));
__device__ __forceinline__ void kload8(bf16x8*kf,lds_cptr kp){
  kf[0]=*(const __attribute__((address_space(3))) bf16x8*)(kp);      kf[1]=*(const __attribute__((address_space(3))) bf16x8*)(kp+512);
  kf[2]=*(const __attribute__((address_space(3))) bf16x8*)(kp+2048); kf[3]=*(const __attribute__((address_space(3))) bf16x8*)(kp+2560);
  kf[4]=*(const __attribute__((address_space(3))) bf16x8*)(kp+4096); kf[5]=*(const __attribute__((address_space(3))) bf16x8*)(kp+4608);
  kf[6]=*(const __attribute__((address_space(3))) bf16x8*)(kp+6144); kf[7]=*(const __attribute__((address_space(3))) bf16x8*)(kp+6656);
}
__device__ __forceinline__ void kload2(bf16x8*kf,lds_cptr kp,int j){ kf[2*j]=*(const __attribute__((address_space(3))) bf16x8*)(kp+j*2048); kf[2*j+1]=*(const __attribute__((address_space(3))) bf16x8*)(kp+j*2048+512); }
__device__ __forceinline__ s16x4 vtr(lds_cptr p){ return __builtin_bit_cast(s16x4,__builtin_amdgcn_ds_read_tr16_b64_v4i16((__attribute__((address_space(3))) v4i16_t*)p)); }
__device__ __forceinline__ float rowmax(const f32x16&p0,const f32x16&p1){
  float a=max3f(p0[0],p0[1],p1[0]),b=max3f(p0[2],p0[3],p1[1]);a=max3f(a,p1[2],p1[3]);
  #pragma unroll
  for(int r=4;r<16;r+=4){a=max3f(a,p0[r],p0[r+1]);b=max3f(b,p0[r+2],p0[r+3]);a=max3f(a,p1[r],p1[r+1]);b=max3f(b,p1[r+2],p1[r+3]);}
  const float m=max2f(a,b);
  auto rr=__builtin_amdgcn_permlane32_swap(__float_as_uint(m),__float_as_uint(m),false,false);
  return max2f(__uint_as_float(rr[0]),__uint_as_float(rr[1]));
}
__device__ __forceinline__ void pv(f32x16*o,int vb,bf16x8 pa0,bf16x8 pa1,bf16x8 pa2,bf16x8 pa3){
  #pragma unroll
  for(int d0=0;d0<2;++d0){s16x4 lo[4],hi[4];
    #pragma unroll
    for(int ks=0;ks<4;++ks){
      asm volatile("ds_read_b64_tr_b16 %0,%1 offset:%c2":"=&v"(lo[ks]):"v"(vb),"i"(d0*4096+ks*1024):"memory");
      asm volatile("ds_read_b64_tr_b16 %0,%1 offset:%c2":"=&v"(hi[ks]):"v"(vb),"i"(d0*4096+ks*1024+512):"memory");}
    asm volatile("s_waitcnt lgkmcnt(0)":::"memory");SBAR();
    #define PK(k) (bf16x8){lo[k][0],lo[k][1],lo[k][2],lo[k][3],hi[k][0],hi[k][1],hi[k][2],hi[k][3]}
    o[d0]=__builtin_amdgcn_mfma_f32_32x32x16_bf16(pa0,PK(0),o[d0],0,0,0);
    o[d0]=__builtin_amdgcn_mfma_f32_32x32x16_bf16(pa1,PK(1),o[d0],0,0,0);
    o[d0]=__builtin_amdgcn_mfma_f32_32x32x16_bf16(pa2,PK(2),o[d0],0,0,0);
    o[d0]=__builtin_amdgcn_mfma_f32_32x32x16_bf16(pa3,PK(3),o[d0],0,0,0);
    #undef PK
  }
}

typedef unsigned u32x2_t __attribute__((ext_vector_type(2)));
__device__ __forceinline__ unsigned pk4f8(float a,float b,float c,float d){int w=0;w=__builtin_amdgcn_cvt_pk_fp8_f32(a,b,w,false);w=__builtin_amdgcn_cvt_pk_fp8_f32(c,d,w,true);return (unsigned)w;}
__device__ __forceinline__ float clampf8(float x){return __builtin_fminf(__builtin_fmaxf(x,-448.f),448.f);}
template<int OSC> __device__ __forceinline__ void store8_f8(unsigned char*p,const u32x4&v){ float f[8];
  #pragma unroll
  for(int k=0;k<4;++k){f[2*k]=clampf8(__builtin_bit_cast(float,v[k]<<16)*(float)OSC);f[2*k+1]=clampf8(__builtin_bit_cast(float,v[k]&0xffff0000u)*(float)OSC);}
  *(u32x2_t*)p=(u32x2_t){pk4f8(f[0],f[1],f[2],f[3]),pk4f8(f[4],f[5],f[6],f[7])}; }
#ifndef ATTN_STORE16
#define ATTN_STORE16(p,v) (*(u32x4*)(p)=(v))
#endif
template<int THRL,int QP,int KP,int VP,int OP,int OSC,class Side> __device__ __forceinline__ void unit(const bf16*Qp,const bf16*__restrict__ Kp,const bf16*__restrict__ Vp,unsigned char*Op  ,float*ssq  ,int q0,__attribute__((address_space(3))) char*shm,const Side&side){
  int tid_=threadIdx.x; asm volatile("":"+v"(tid_));
  const int tid=tid_,lane=tid&63,r32=lane&31,hi=lane>>5; const int wid=__builtin_amdgcn_readfirstlane(tid>>6);
  const bf16*Qw=Qp+(long)(q0+wid*QBLK)*QP;
  const bf16*Kh=Kp,*Vh=Vp;
  const unsigned lds0=(unsigned)(uintptr_t)shm;
  __attribute__((address_space(3))) float*wsf=(__attribute__((address_space(3))) float*)(shm+LDS_WS)+wid*64;
  const unsigned koff=(unsigned)(lane*KP+wid*8)*2u;
  const unsigned voff=(unsigned)((16*(wid&3)+(lane>>2))*VP+(wid>>2)*32+(lane&3)*8)*2u;
  const unsigned kdst=lds0+LDS_K+wid*1024, vdst=lds0+LDS_V+wid*1024;
  #define DMA_K(t,slot) glds16s((const char*)Kh+(long)(t)*(KVBLK*KP*2),koff,(unsigned)__builtin_amdgcn_readfirstlane(kdst+(slot)))
  #define DMA_V(t,slot) glds16s((const char*)Vh+(long)(t)*(KVBLK*VP*2),voff,(unsigned)__builtin_amdgcn_readfirstlane(vdst+(slot)))
  const int vb0=(int)(lds0+LDS_V)+((lane>>4)&1)*32+(lane&3)*8+(4*hi+((lane&15)>>2))*64;
  const lds_cptr Kbase=(lds_cptr)shm+LDS_K; bf16x8 kf[8];
  const lds_cptr shm3=(lds_cptr)shm; const lds_cptr kp0=shm3+LDS_K+hi*1024+r32*16; const lds_cptr vp0=shm3+LDS_V+((lane>>4)&1)*32+(lane&3)*8+(4*hi+((lane&15)>>2))*64;
  constexpr int NT=SEQ/KVBLK;
  DMA_K(0,0);DMA_V(0,0);DMA_K(1,SLOTB);
  bf16x8 qr[4];
  #pragma unroll
  for(int d0=0;d0<4;++d0)qr[d0]=*reinterpret_cast<const bf16x8*>(&Qw[(long)r32*QP+d0*16+hi*8]);
  float mhat=0.f,l_reg=0.f;f32x16 o[2];o[0]=f32x16{};o[1]=f32x16{};f32x16 negm=f32x16{};asm volatile("":"+v"(negm));
  #define CMASK(P0,P1,t) do{}while(0)
  bool resc=false;
  #define START(P0,P1) do{ const float rm=rowmax(P0,P1); resc=false; \
    { const float dl=rm; mhat=fadd_s(mhat,dl); \
      _Pragma("unroll") for(int r=0;r<16;++r){P0[r]=fsub_s(P0[r],dl);P1[r]=fsub_s(P1[r],dl);} \
      _Pragma("unroll") for(int r=0;r<16;++r)negm[r]=-mhat; asm volatile("":"+v"(negm)); } \
    _Pragma("unroll") for(int r=0;r<16;++r)P0[r]=__builtin_amdgcn_exp2f(P0[r]); }while(0)
  #define RESC() do{ if(resc){ asm volatile("s_waitcnt lgkmcnt(0)":::"memory"); \
      _Pragma("unroll") for(int d_=0;d_<2;++d_) _Pragma("unroll") for(int r=0;r<16;++r)o[d_][r]*=wsf[crow(r,hi)]; } }while(0)
  f32x16 pA0,pA1,pB0,pB1;
  int sl_prev=0,sl_cur=0,sl_next=SLOTB;
  #define ROT() do{sl_prev=sl_cur;sl_cur=sl_next;sl_next=(sl_next==(NSLOT-1)*SLOTB)?0:sl_next+SLOTB;}while(0)
  DMA_K(2,2*SLOTB);
  side();
  WAIT_BAR(3);
  qkt(pA0,pA1,Kbase,qr,negm,r32,hi);asm volatile("s_nop 15\n\ts_nop 7":"+v"(pA0),"+v"(pA1));CMASK(pA0,pA1,0);
  START(pA0,pA1);
  _Pragma("unroll") for(int r=0;r<16;++r)pA1[r]=__builtin_amdgcn_exp2f(pA1[r]);
  WAIT_BAR(0);
  DMA_K(3,0);DMA_V(1,SLOTB);
  ROT();
  kload8(kf,kp0+sl_cur);
  WAIT_BAR(2);
  s16x4 vlo[8],vhi[8]; u32x4 pw0,pw1,pw2,pw3;
  #define PKW(P,B) cvtpk_s(P[B],P[B+1])
  #define PAF(k) __builtin_bit_cast(bf16x8,pw##k)
  #define VFR(i) (bf16x8){vlo[i][0],vlo[i][1],vlo[i][2],vlo[i][3],vhi[i][0],vhi[i][1],vhi[i][2],vhi[i][3]}
  #define PIN(x) asm volatile("":"+v"(x))
  #define MX3(a,b,c) __builtin_fmaxf(__builtin_fmaxf((a),(b)),(c))
  #define GAPA(MF,A0,A1,A2,A3,W0,W1,PW) do{ MF; sacc+=A0; sacc+=A1; sacc+=A2; sacc+=A3; PIN(sacc); W0; W1; PIN(PW); SBAR(); }while(0)
  #define EX(v) __builtin_amdgcn_exp2f(v)
  #define GAPB(MF,X,B) do{ MF; X[B]=EX(X[B]); X[B+1]=EX(X[B+1]); X[B+2]=EX(X[B+2]); X[B+3]=EX(X[B+3]); PIN(X); SBAR(); }while(0)
  #define VRD(i) do{ vlo[i]=vtr(vp_+(((i)>>2)*4096+((i)&3)*1024)); vhi[i]=vtr(vp_+(((i)>>2)*4096+((i)&3)*1024+512)); }while(0)
  #define KRD(G,j) do{ if(G){ kload2(kf,kp0+sl_next,j); SBAR(); } }while(0)
  #define STEP(C0,C1,P0,P1,t,GK,GV,GL) do{ SBAR(); \
    const lds_cptr vp_=vp0+sl_prev; \
    VRD(0); SBAR(); float sacc=(P0[0]+P0[1]); \
    GAPA(C0=__builtin_amdgcn_mfma_f32_32x32x16_bf16(kf[0],qr[0],negm,0,0,0), P0[2],P0[3],P0[4],P0[5],     pw0[0]=PKW(P0,0), pw0[1]=PKW(P0,2), pw0); \
    VRD(4); SBAR(); GAPA(C1=__builtin_amdgcn_mfma_f32_32x32x16_bf16(kf[1],qr[0],negm,0,0,0), P0[6],P0[7],P0[8],P0[9],     pw0[2]=PKW(P0,4), pw0[3]=PKW(P0,6), pw0); \
    VRD(1); SBAR(); GAPA(C0=__builtin_amdgcn_mfma_f32_32x32x16_bf16(kf[2],qr[1],C0,0,0,0),   P0[10],P0[11],P0[12],P0[13], pw1[0]=PKW(P0,8), pw1[1]=PKW(P0,10), pw1); \
    VRD(5); SBAR(); GAPA(C1=__builtin_amdgcn_mfma_f32_32x32x16_bf16(kf[3],qr[1],C1,0,0,0),   P0[14],P0[15],P1[0],P1[1],   pw1[2]=PKW(P0,12),pw1[3]=PKW(P0,14), pw1); \
    VRD(2); SBAR(); GAPA(C0=__builtin_amdgcn_mfma_f32_32x32x16_bf16(kf[4],qr[2],C0,0,0,0),   P1[2],P1[3],P1[4],P1[5],     pw2[0]=PKW(P1,0), pw2[1]=PKW(P1,2), pw2); \
    VRD(6); SBAR(); GAPA(C1=__builtin_amdgcn_mfma_f32_32x32x16_bf16(kf[5],qr[2],C1,0,0,0),   P1[6],P1[7],P1[8],P1[9],     pw2[2]=PKW(P1,4), pw2[3]=PKW(P1,6), pw2); \
    VRD(3); SBAR(); GAPA(C0=__builtin_amdgcn_mfma_f32_32x32x16_bf16(kf[6],qr[3],C0,0,0,0),   P1[10],P1[11],P1[12],P1[13], pw3[0]=PKW(P1,8), pw3[1]=PKW(P1,10), pw3); \
    VRD(7); SBAR(); GAPA(C1=__builtin_amdgcn_mfma_f32_32x32x16_bf16(kf[7],qr[3],C1,0,0,0),   P1[14],P1[15],0.f,0.f,       pw3[2]=PKW(P1,12),pw3[3]=PKW(P1,14), pw3); \
    l_reg+=sacc; \
    if(GK){DMA_K((t)+3,sl_cur);} if(GV){DMA_V((t)+1,sl_next);} \
    CMASK(C0,C1,t); \
    { float a=MX3(C0[0],C0[1],C1[0]),b=MX3(C0[2],C0[3],C1[1]); a=MX3(a,C1[2],C1[3]); \
      _Pragma("unroll") for(int r=4;r<16;r+=4){a=MX3(a,C0[r],C0[r+1]);b=MX3(b,C0[r+2],C0[r+3]);a=MX3(a,C1[r],C1[r+1]);b=MX3(b,C1[r+2],C1[r+3]);} \
      float rm=__builtin_fmaxf(a,b); { auto rr=__builtin_amdgcn_permlane32_swap(__float_as_uint(rm),__float_as_uint(rm),false,false); rm=__builtin_fmaxf(__uint_as_float(rr[0]),__uint_as_float(rr[1])); } \
      resc=false; \
      if(__builtin_expect(__any(rm>(float)THRL),0)){ const float dl=__builtin_fmaxf(rm,0.f); mhat+=dl; \
        _Pragma("unroll") for(int r=0;r<16;++r){C0[r]-=dl;C1[r]-=dl;} \
        _Pragma("unroll") for(int r=0;r<16;++r)negm[r]=-mhat; asm volatile("":"+v"(negm)); \
        const float f=__builtin_amdgcn_exp2f(-dl); l_reg*=f; if(hi==0)wsf[r32]=f; resc=true; } } \
    SBAR(); \
    GAPB(o[0]=__builtin_amdgcn_mfma_f32_32x32x16_bf16(PAF(0),VFR(0),o[0],0,0,0), C0,0); \
    GAPB(o[1]=__builtin_amdgcn_mfma_f32_32x32x16_bf16(PAF(0),VFR(4),o[1],0,0,0), C0,4); \
    KRD(GL,0); GAPB(o[0]=__builtin_amdgcn_mfma_f32_32x32x16_bf16(PAF(1),VFR(1),o[0],0,0,0), C0,8); \
    KRD(GL,1); GAPB(o[1]=__builtin_amdgcn_mfma_f32_32x32x16_bf16(PAF(1),VFR(5),o[1],0,0,0), C0,12); \
    KRD(GL,2); GAPB(o[0]=__builtin_amdgcn_mfma_f32_32x32x16_bf16(PAF(2),VFR(2),o[0],0,0,0), C1,0); \
    KRD(GL,3); GAPB(o[1]=__builtin_amdgcn_mfma_f32_32x32x16_bf16(PAF(2),VFR(6),o[1],0,0,0), C1,4); \
    GAPB(o[0]=__builtin_amdgcn_mfma_f32_32x32x16_bf16(PAF(3),VFR(3),o[0],0,0,0), C1,8); \
    GAPB(o[1]=__builtin_amdgcn_mfma_f32_32x32x16_bf16(PAF(3),VFR(7),o[1],0,0,0), C1,12); \
    }while(0)
  int t=1;
  #undef CMASK
  #define CMASK(P0,P1,t) do{}while(0)
  for(;t+5<NT;t+=2){
    STEP(pB0,pB1,pA0,pA1,t,true,true,true);     WAIT_BAR(2); RESC(); ROT();
    STEP(pA0,pA1,pB0,pB1,t+1,true,true,true);   WAIT_BAR(2); RESC(); ROT();
  }
  #undef CMASK
  #define CMASK(P0,P1,t) do{}while(0)
  #define ENDW(tt) do{ if((tt)+3<NT){WAIT_BAR(2);} else if((tt)+2<NT){WAIT_BAR(1);} else {WAIT_BAR(0);} }while(0)
  for(;t+1<NT;t+=2){
    STEP(pB0,pB1,pA0,pA1,t,(t+3<NT),(t+1<NT),(t+1<NT));       ENDW(t);   RESC(); ROT();
    STEP(pA0,pA1,pB0,pB1,t+1,(t+4<NT),(t+2<NT),(t+2<NT));     ENDW(t+1); RESC(); ROT();
  }
  STEP(pB0,pB1,pA0,pA1,NT-1,false,false,false); RESC();
  { float sacc=pB0[0]+pB0[1]; _Pragma("unroll") for(int r=2;r<16;++r)sacc+=pB0[r]; _Pragma("unroll") for(int r=0;r<16;++r)sacc+=pB1[r]; l_reg+=sacc;
    pw0=(u32x4){PKW(pB0,0),PKW(pB0,2),PKW(pB0,4),PKW(pB0,6)};pw1=(u32x4){PKW(pB0,8),PKW(pB0,10),PKW(pB0,12),PKW(pB0,14)};pw2=(u32x4){PKW(pB1,0),PKW(pB1,2),PKW(pB1,4),PKW(pB1,6)};pw3=(u32x4){PKW(pB1,8),PKW(pB1,10),PKW(pB1,12),PKW(pB1,14)};
    SBAR(); pv(o,vb0+sl_cur,PAF(0),PAF(1),PAF(2),PAF(3)); }
  #undef PKW
  #undef PAF
  #undef VFR
  #undef PIN
  #undef MX3
  #undef GAPA
  #undef GAPB
  #undef EX
  #undef VRD
  #undef KRD
  #undef STEP
  #undef ENDW
  {auto rr=__builtin_amdgcn_permlane32_swap(__float_as_uint(l_reg),__float_as_uint(l_reg),false,false);l_reg=__uint_as_float(rr[0])+__uint_as_float(rr[1]);}
  if(hi==0)wsf[32+r32]=l_reg;asm volatile("s_waitcnt lgkmcnt(0)":::"memory");
  float rli[16];
  #pragma unroll
  for(int r=0;r<16;++r)rli[r]=__builtin_amdgcn_rcpf(wsf[32+crow(r,hi)]);
  unsigned char*Ow=Op+(long)(q0+wid*QBLK)*OP; float*ssqw=ssq+(long)(q0+wid*QBLK)*16;
  { __attribute__((address_space(3))) unsigned short*stg=(__attribute__((address_space(3))) unsigned short*)(shm+LDS_OST)+wid*2048;
    #pragma unroll
    for(int r=0;r<16;++r){const int orow=crow(r,hi);
      #pragma unroll
      for(int d0=0;d0<2;++d0)stg[orow*64+d0*32+r32]=(unsigned short)(cvtpk_s(o[d0][r]*rli[r],0.f)&0xffffu);}
    asm volatile("s_waitcnt lgkmcnt(0)":::"memory");
    #pragma unroll
    for(int i=0;i<4;++i){const int row=i*8+(lane>>3),ch=lane&7; const u32x4 v=*(const __attribute__((address_space(3))) u32x4*)(stg+row*64+ch*8); store8_f8<OSC>(Ow+(long)row*OP+ch*8,v);
      float q_=0.f;
      #pragma unroll
      for(int k_=0;k_<4;++k_){const float lo_=__builtin_bit_cast(float,v[k_]<<16),hi_=__builtin_bit_cast(float,v[k_]&0xffff0000u); q_+=lo_*lo_+hi_*hi_;}
      q_+=dppf<0xB1>(q_); q_+=dppf<0x4E>(q_); q_+=dppf<0x141>(q_);
      if(ch==0) ssqw[(long)row*16]=q_; } }
  asm volatile("s_waitcnt lgkmcnt(0)\n\ts_barrier":::"memory");
  #undef DMA_K
  #undef DMA_V
  #undef CMASK
  #undef START
  #undef RESC
  #undef ROT
}

template<int THRL,int QP,int KP,int VP,int OP,int OSC> __device__ __forceinline__ void unitB(const bf16*Qp,const bf16*__restrict__ Kp,const bf16*__restrict__ Vp,unsigned char*Op  ,float*ssq  ,int q0,int t_lo,int NT,float slope2,float sink2,__attribute__((address_space(3))) char*shm){
  int tid_=threadIdx.x; asm volatile("":"+v"(tid_));
  const int tid=tid_,lane=tid&63,r32=lane&31,hi=lane>>5; const int wid=__builtin_amdgcn_readfirstlane(tid>>6);
  const bf16*Qw=Qp+(long)(q0+wid*QBLK)*QP;
  const bf16*Kh=Kp,*Vh=Vp;
  const unsigned lds0=(unsigned)(uintptr_t)shm;
  __attribute__((address_space(3))) float*wsf=(__attribute__((address_space(3))) float*)(shm+LDS_WS)+wid*64;
  const unsigned koff=(unsigned)(lane*KP+wid*8)*2u;
  const unsigned voff=(unsigned)((16*(wid&3)+(lane>>2))*VP+(wid>>2)*32+(lane&3)*8)*2u;
  const unsigned kdst=lds0+LDS_K+wid*1024, vdst=lds0+LDS_V+wid*1024;
  #define DMA_K(t,slot) glds16s((const char*)Kh+(long)(t_lo+(t))*(KVBLK*KP*2),koff,(unsigned)__builtin_amdgcn_readfirstlane(kdst+(slot)))
  #define DMA_V(t,slot) glds16s((const char*)Vh+(long)(t_lo+(t))*(KVBLK*VP*2),voff,(unsigned)__builtin_amdgcn_readfirstlane(vdst+(slot)))
  const int vb0=(int)(lds0+LDS_V)+((lane>>4)&1)*32+(lane&3)*8+(4*hi+((lane&15)>>2))*64;
  const lds_cptr Kbase=(lds_cptr)shm+LDS_K; bf16x8 kf[8];
  const lds_cptr shm3=(lds_cptr)shm; const lds_cptr kp0=shm3+LDS_K+hi*1024+r32*16; const lds_cptr vp0=shm3+LDS_V+((lane>>4)&1)*32+(lane&3)*8+(4*hi+((lane&15)>>2))*64;
  const int qrow=q0+wid*QBLK+r32;
  DMA_K(0,0);DMA_V(0,0);DMA_K(1,SLOTB);
  bf16x8 qr[4];
  #pragma unroll
  for(int d0=0;d0<4;++d0)qr[d0]=*reinterpret_cast<const bf16x8*>(&Qw[(long)r32*QP+d0*16+hi*8]);
  float mhat=0.f,l_reg=0.f;f32x16 o[2];o[0]=f32x16{};o[1]=f32x16{};f32x16 negm=f32x16{};asm volatile("":"+v"(negm));
  #define CMASK(P0,P1,t) do{ const float bl_=(float)(64*(t_lo+(t))+4*hi-qrow); _Pragma("unroll") for(int r=0;r<16;++r){ const float e0_=bl_+(float)((r&3)+8*(r>>2)), e1_=e0_+32.f; const float a0_=__builtin_fabsf(e0_), a1_=__builtin_fabsf(e1_); \
      P0[r]=(a0_<=128.f)?(P0[r]-slope2*a0_):-INFINITY; P1[r]=(a1_<=128.f)?(P1[r]-slope2*a1_):-INFINITY; } }while(0)
  bool resc=false;
  #define START(P0,P1) do{ const float rm=rowmax(P0,P1); resc=false; \
    { const float dl=__builtin_fmaxf(rm,-64.f); mhat=fadd_s(mhat,dl); \
      _Pragma("unroll") for(int r=0;r<16;++r){P0[r]=fsub_s(P0[r],dl);P1[r]=fsub_s(P1[r],dl);} \
      _Pragma("unroll") for(int r=0;r<16;++r)negm[r]=-mhat; asm volatile("":"+v"(negm)); } \
    _Pragma("unroll") for(int r=0;r<16;++r)P0[r]=__builtin_amdgcn_exp2f(P0[r]); }while(0)
  #define RESC() do{ if(resc){ asm volatile("s_waitcnt lgkmcnt(0)":::"memory"); \
      _Pragma("unroll") for(int d_=0;d_<2;++d_) _Pragma("unroll") for(int r=0;r<16;++r)o[d_][r]*=wsf[crow(r,hi)]; } }while(0)
  f32x16 pA0,pA1,pB0,pB1;
  int sl_prev=0,sl_cur=0,sl_next=SLOTB;
  #define ROT() do{sl_prev=sl_cur;sl_cur=sl_next;sl_next=(sl_next==(NSLOT-1)*SLOTB)?0:sl_next+SLOTB;}while(0)
  DMA_K(2,2*SLOTB);
  WAIT_BAR(3);
  qkt(pA0,pA1,Kbase,qr,negm,r32,hi);asm volatile("s_nop 15\n\ts_nop 7":"+v"(pA0),"+v"(pA1));CMASK(pA0,pA1,0);
  START(pA0,pA1);
  _Pragma("unroll") for(int r=0;r<16;++r)pA1[r]=__builtin_amdgcn_exp2f(pA1[r]);
  WAIT_BAR(0);
  DMA_K(3,0);DMA_V(1,SLOTB);
  ROT();
  kload8(kf,kp0+sl_cur);
  WAIT_BAR(2);
  s16x4 vlo[8],vhi[8]; u32x4 pw0,pw1,pw2,pw3;
  #define PKW(P,B) cvtpk_s(P[B],P[B+1])
  #define PAF(k) __builtin_bit_cast(bf16x8,pw##k)
  #define VFR(i) (bf16x8){vlo[i][0],vlo[i][1],vlo[i][2],vlo[i][3],vhi[i][0],vhi[i][1],vhi[i][2],vhi[i][3]}
  #define PIN(x) asm volatile("":"+v"(x))
  #define MX3(a,b,c) __builtin_fmaxf(__builtin_fmaxf((a),(b)),(c))
  #define GAPA(MF,A0,A1,A2,A3,W0,W1,PW) do{ MF; sacc+=A0; sacc+=A1; sacc+=A2; sacc+=A3; PIN(sacc); W0; W1; PIN(PW); SBAR(); }while(0)
  #define EX(v) __builtin_amdgcn_exp2f(v)
  #define GAPB(MF,X,B) do{ MF; X[B]=EX(X[B]); X[B+1]=EX(X[B+1]); X[B+2]=EX(X[B+2]); X[B+3]=EX(X[B+3]); PIN(X); SBAR(); }while(0)
  #define VRD(i) do{ vlo[i]=vtr(vp_+(((i)>>2)*4096+((i)&3)*1024)); vhi[i]=vtr(vp_+(((i)>>2)*4096+((i)&3)*1024+512)); }while(0)
  #define KRD(G,j) do{ if(G){ kload2(kf,kp0+sl_next,j); SBAR(); } }while(0)
  #define STEP(C0,C1,P0,P1,t,GK,GV,GL) do{ SBAR(); \
    const lds_cptr vp_=vp0+sl_prev; \
    VRD(0); SBAR(); float sacc=(P0[0]+P0[1]); \
    GAPA(C0=__builtin_amdgcn_mfma_f32_32x32x16_bf16(kf[0],qr[0],negm,0,0,0), P0[2],P0[3],P0[4],P0[5],     pw0[0]=PKW(P0,0), pw0[1]=PKW(P0,2), pw0); \
    VRD(4); SBAR(); GAPA(C1=__builtin_amdgcn_mfma_f32_32x32x16_bf16(kf[1],qr[0],negm,0,0,0), P0[6],P0[7],P0[8],P0[9],     pw0[2]=PKW(P0,4), pw0[3]=PKW(P0,6), pw0); \
    VRD(1); SBAR(); GAPA(C0=__builtin_amdgcn_mfma_f32_32x32x16_bf16(kf[2],qr[1],C0,0,0,0),   P0[10],P0[11],P0[12],P0[13], pw1[0]=PKW(P0,8), pw1[1]=PKW(P0,10), pw1); \
    VRD(5); SBAR(); GAPA(C1=__builtin_amdgcn_mfma_f32_32x32x16_bf16(kf[3],qr[1],C1,0,0,0),   P0[14],P0[15],P1[0],P1[1],   pw1[2]=PKW(P0,12),pw1[3]=PKW(P0,14), pw1); \
    VRD(2); SBAR(); GAPA(C0=__builtin_amdgcn_mfma_f32_32x32x16_bf16(kf[4],qr[2],C0,0,0,0),   P1[2],P1[3],P1[4],P1[5],     pw2[0]=PKW(P1,0), pw2[1]=PKW(P1,2), pw2); \
    VRD(6); SBAR(); GAPA(C1=__builtin_amdgcn_mfma_f32_32x32x16_bf16(kf[5],qr[2],C1,0,0,0),   P1[6],P1[7],P1[8],P1[9],     pw2[2]=PKW(P1,4), pw2[3]=PKW(P1,6), pw2); \
    VRD(3); SBAR(); GAPA(C0=__builtin_amdgcn_mfma_f32_32x32x16_bf16(kf[6],qr[3],C0,0,0,0),   P1[10],P1[11],P1[12],P1[13], pw3[0]=PKW(P1,8), pw3[1]=PKW(P1,10), pw3); \
    VRD(7); SBAR(); GAPA(C1=__builtin_amdgcn_mfma_f32_32x32x16_bf16(kf[7],qr[3],C1,0,0,0),   P1[14],P1[15],0.f,0.f,       pw3[2]=PKW(P1,12),pw3[3]=PKW(P1,14), pw3); \
    l_reg+=sacc; \
    if(GK){DMA_K((t)+3,sl_cur);} if(GV){DMA_V((t)+1,sl_next);} \
    CMASK(C0,C1,t); \
    { float a=MX3(C0[0],C0[1],C1[0]),b=MX3(C0[2],C0[3],C1[1]); a=MX3(a,C1[2],C1[3]); \
      _Pragma("unroll") for(int r=4;r<16;r+=4){a=MX3(a,C0[r],C0[r+1]);b=MX3(b,C0[r+2],C0[r+3]);a=MX3(a,C1[r],C1[r+1]);b=MX3(b,C1[r+2],C1[r+3]);} \
      float rm=__builtin_fmaxf(a,b); { auto rr=__builtin_amdgcn_permlane32_swap(__float_as_uint(rm),__float_as_uint(rm),false,false); rm=__builtin_fmaxf(__uint_as_float(rr[0]),__uint_as_float(rr[1])); } \
      resc=false; \
      if(__builtin_expect(__any(rm>(float)THRL),0)){ const float dl=__builtin_fmaxf(rm,0.f); mhat+=dl; \
        _Pragma("unroll") for(int r=0;r<16;++r){C0[r]-=dl;C1[r]-=dl;} \
        _Pragma("unroll") for(int r=0;r<16;++r)negm[r]=-mhat; asm volatile("":"+v"(negm)); \
        const float f=__builtin_amdgcn_exp2f(-dl); l_reg*=f; if(hi==0)wsf[r32]=f; resc=true; } } \
    SBAR(); \
    GAPB(o[0]=__builtin_amdgcn_mfma_f32_32x32x16_bf16(PAF(0),VFR(0),o[0],0,0,0), C0,0); \
    GAPB(o[1]=__builtin_amdgcn_mfma_f32_32x32x16_bf16(PAF(0),VFR(4),o[1],0,0,0), C0,4); \
    KRD(GL,0); GAPB(o[0]=__builtin_amdgcn_mfma_f32_32x32x16_bf16(PAF(1),VFR(1),o[0],0,0,0), C0,8); \
    KRD(GL,1); GAPB(o[1]=__builtin_amdgcn_mfma_f32_32x32x16_bf16(PAF(1),VFR(5),o[1],0,0,0), C0,12); \
    KRD(GL,2); GAPB(o[0]=__builtin_amdgcn_mfma_f32_32x32x16_bf16(PAF(2),VFR(2),o[0],0,0,0), C1,0); \
    KRD(GL,3); GAPB(o[1]=__builtin_amdgcn_mfma_f32_32x32x16_bf16(PAF(2),VFR(6),o[1],0,0,0), C1,4); \
    GAPB(o[0]=__builtin_amdgcn_mfma_f32_32x32x16_bf16(PAF(3),VFR(3),o[0],0,0,0), C1,8); \
    GAPB(o[1]=__builtin_amdgcn_mfma_f32_32x32x16_bf16(PAF(3),VFR(7),o[1],0,0,0), C1,12); \
    }while(0)
  int t=1;
  #undef CMASK
  #define CMASK(P0,P1,t) do{ const float bl_=(float)(64*(t_lo+(t))+4*hi-qrow); _Pragma("unroll") for(int r=0;r<16;++r){ const float e0_=bl_+(float)((r&3)+8*(r>>2)), e1_=e0_+32.f; const float a0_=__builtin_fabsf(e0_), a1_=__builtin_fabsf(e1_); \
      P0[r]=(a0_<=128.f)?(P0[r]-slope2*a0_):-INFINITY; P1[r]=(a1_<=128.f)?(P1[r]-slope2*a1_):-INFINITY; } }while(0)
  for(;t+5<NT;t+=2){
    STEP(pB0,pB1,pA0,pA1,t,true,true,true);     WAIT_BAR(2); RESC(); ROT();
    STEP(pA0,pA1,pB0,pB1,t+1,true,true,true);   WAIT_BAR(2); RESC(); ROT();
  }
  #undef CMASK
  #define CMASK(P0,P1,t) do{ const float bl_=(float)(64*(t_lo+(t))+4*hi-qrow); _Pragma("unroll") for(int r=0;r<16;++r){ const float e0_=bl_+(float)((r&3)+8*(r>>2)), e1_=e0_+32.f; const float a0_=__builtin_fabsf(e0_), a1_=__builtin_fabsf(e1_); \
      P0[r]=(a0_<=128.f)?(P0[r]-slope2*a0_):-INFINITY; P1[r]=(a1_<=128.f)?(P1[r]-slope2*a1_):-INFINITY; } }while(0)
  #define ENDW(tt) do{ if((tt)+3<NT){WAIT_BAR(2);} else if((tt)+2<NT){WAIT_BAR(1);} else {WAIT_BAR(0);} }while(0)
  for(;t+1<NT;t+=2){
    STEP(pB0,pB1,pA0,pA1,t,(t+3<NT),(t+1<NT),(t+1<NT));       ENDW(t);   RESC(); ROT();
    STEP(pA0,pA1,pB0,pB1,t+1,(t+4<NT),(t+2<NT),(t+2<NT));     ENDW(t+1); RESC(); ROT();
  }
  STEP(pB0,pB1,pA0,pA1,NT-1,false,false,false); RESC();
  { float sacc=pB0[0]+pB0[1]; _Pragma("unroll") for(int r=2;r<16;++r)sacc+=pB0[r]; _Pragma("unroll") for(int r=0;r<16;++r)sacc+=pB1[r]; l_reg+=sacc;
    pw0=(u32x4){PKW(pB0,0),PKW(pB0,2),PKW(pB0,4),PKW(pB0,6)};pw1=(u32x4){PKW(pB0,8),PKW(pB0,10),PKW(pB0,12),PKW(pB0,14)};pw2=(u32x4){PKW(pB1,0),PKW(pB1,2),PKW(pB1,4),PKW(pB1,6)};pw3=(u32x4){PKW(pB1,8),PKW(pB1,10),PKW(pB1,12),PKW(pB1,14)};
    SBAR(); pv(o,vb0+sl_cur,PAF(0),PAF(1),PAF(2),PAF(3)); }
  #undef PKW
  #undef PAF
  #undef VFR
  #undef PIN
  #undef MX3
  #undef GAPA
  #undef GAPB
  #undef EX
  #undef VRD
  #undef KRD
  #undef STEP
  #undef ENDW
  {auto rr=__builtin_amdgcn_permlane32_swap(__float_as_uint(l_reg),__float_as_uint(l_reg),false,false);l_reg=__uint_as_float(rr[0])+__uint_as_float(rr[1]);}
  l_reg+=__builtin_amdgcn_exp2f(sink2-mhat);
  if(hi==0)wsf[32+r32]=l_reg;asm volatile("s_waitcnt lgkmcnt(0)":::"memory");
  float rli[16];
  #pragma unroll
  for(int r=0;r<16;++r)rli[r]=__builtin_amdgcn_rcpf(wsf[32+crow(r,hi)]);
  unsigned char*Ow=Op+(long)(q0+wid*QBLK)*OP; float*ssqw=ssq+(long)(q0+wid*QBLK)*16;
  { __attribute__((address_space(3))) unsigned short*stg=(__attribute__((address_space(3))) unsigned short*)(shm+LDS_OST)+wid*2048;
    #pragma unroll
    for(int r=0;r<16;++r){const int orow=crow(r,hi);
      #pragma unroll
      for(int d0=0;d0<2;++d0)stg[orow*64+d0*32+r32]=(unsigned short)(cvtpk_s(o[d0][r]*rli[r],0.f)&0xffffu);}
    asm volatile("s_waitcnt lgkmcnt(0)":::"memory");
    #pragma unroll
    for(int i=0;i<4;++i){const int row=i*8+(lane>>3),ch=lane&7; const u32x4 v=*(const __attribute__((address_space(3))) u32x4*)(stg+row*64+ch*8); store8_f8<OSC>(Ow+(long)row*OP+ch*8,v);
      float q_=0.f;
      #pragma unroll
      for(int k_=0;k_<4;++k_){const float lo_=__builtin_bit_cast(float,v[k_]<<16),hi_=__builtin_bit_cast(float,v[k_]&0xffff0000u); q_+=lo_*lo_+hi_*hi_;}
      q_+=dppf<0xB1>(q_); q_+=dppf<0x4E>(q_); q_+=dppf<0x141>(q_);
      if(ch==0) ssqw[(long)row*16]=q_; } }
  asm volatile("s_waitcnt lgkmcnt(0)\n\ts_barrier":::"memory");
  #undef DMA_K
  #undef DMA_V
  #undef CMASK
  #undef START
  #undef RESC
  #undef ROT
}


__device__ __forceinline__ void qkt96(f32x16&p0,f32x16&p1,lds_cptr Kslot,const bf16x8*qr,const f32x16&negm,int r32,int hi){
  const lds_cptr kb=Kslot+hi*1024+r32*16;
  #pragma unroll
  for(int d0=0;d0<6;++d0){
    const bf16x8 b0=*(const __attribute__((address_space(3))) bf16x8*)(kb+d0*2048);
    const bf16x8 b1=*(const __attribute__((address_space(3))) bf16x8*)(kb+d0*2048+512);
    if(d0==0){p0=__builtin_amdgcn_mfma_f32_32x32x16_bf16(b0,qr[0],negm,0,0,0);p1=__builtin_amdgcn_mfma_f32_32x32x16_bf16(b1,qr[0],negm,0,0,0);}
    else{p0=__builtin_amdgcn_mfma_f32_32x32x16_bf16(b0,qr[d0],p0,0,0,0);p1=__builtin_amdgcn_mfma_f32_32x32x16_bf16(b1,qr[d0],p1,0,0,0);}}
}
__device__ __forceinline__ void kload12(bf16x8*kf,lds_cptr kp){
  #pragma unroll
  for(int j=0;j<6;++j){ kf[2*j]=*(const __attribute__((address_space(3))) bf16x8*)(kp+j*2048); kf[2*j+1]=*(const __attribute__((address_space(3))) bf16x8*)(kp+j*2048+512); }
}
template<int THRL,int QP,int KP,int VP,int OP,int OSC,class Side> __device__ __forceinline__ void unit96(const bf16*Qp,const bf16*__restrict__ Kp,const bf16*__restrict__ Vp,unsigned char*Op  ,float*ssq  ,int q0,__attribute__((address_space(3))) char*shm,const Side&side){
  int tid_=threadIdx.x; asm volatile("":"+v"(tid_));
  const int tid=tid_,lane=tid&63,r32=lane&31,hi=lane>>5; const int wid=__builtin_amdgcn_readfirstlane(tid>>6);
  const bf16*Qw=Qp+(long)(q0+wid*QBLK)*QP;
  const bf16*Kh=Kp,*Vh=Vp;
  constexpr int KSL=12288, L_K=0, L_V=3*KSL, L_WS=L_V+3*SLOTB, L_OST=L_WS+NW*64*4;
  const bool kx=wid<4;
  const unsigned lds0=(unsigned)(uintptr_t)shm;
  __attribute__((address_space(3))) float*wsf=(__attribute__((address_space(3))) float*)(shm+L_WS)+wid*64;
  const unsigned koff=(unsigned)(lane*KP+wid*8)*2u;
  const unsigned voff=(unsigned)((16*(wid&3)+(lane>>2))*VP+(wid>>2)*32+(lane&3)*8)*2u;
  const unsigned kdst=lds0+L_K+wid*1024, vdst=lds0+L_V+wid*1024;
  #define DMA_K(t,slot) do{ glds16s((const char*)Kh+(long)(t)*(KVBLK*KP*2),koff,(unsigned)__builtin_amdgcn_readfirstlane(kdst+(slot))); if(kx)glds16s((const char*)Kh+(long)(t)*(KVBLK*KP*2)+128,koff,(unsigned)__builtin_amdgcn_readfirstlane(kdst+(slot)+8192)); }while(0)
  #define DMA_V(t,slot) glds16s((const char*)Vh+(long)(t)*(KVBLK*VP*2),voff,(unsigned)__builtin_amdgcn_readfirstlane(vdst+(slot)))
  const int vb0=(int)(lds0+L_V)+((lane>>4)&1)*32+(lane&3)*8+(4*hi+((lane&15)>>2))*64;
  const lds_cptr Kbase=(lds_cptr)shm+L_K; bf16x8 kf[12];
  const lds_cptr shm3=(lds_cptr)shm; const lds_cptr kp0=shm3+L_K+hi*1024+r32*16; const lds_cptr vp0=shm3+L_V+((lane>>4)&1)*32+(lane&3)*8+(4*hi+((lane&15)>>2))*64;
  constexpr int NT=SEQ/KVBLK;
  DMA_K(0,0);DMA_V(0,0);DMA_K(1,KSL);
  bf16x8 qr[6];
  #pragma unroll
  for(int d0=0;d0<6;++d0)qr[d0]=*reinterpret_cast<const bf16x8*>(&Qw[(long)r32*QP+d0*16+hi*8]);
  float mhat=0.f,l_reg=0.f;f32x16 o[2];o[0]=f32x16{};o[1]=f32x16{};f32x16 negm=f32x16{};asm volatile("":"+v"(negm));
  #define CMASK(P0,P1,t) do{}while(0)
  bool resc=false;
  #define START(P0,P1) do{ const float rm=rowmax(P0,P1); resc=false; \
    { const float dl=rm; mhat=fadd_s(mhat,dl); \
      _Pragma("unroll") for(int r=0;r<16;++r){P0[r]=fsub_s(P0[r],dl);P1[r]=fsub_s(P1[r],dl);} \
      _Pragma("unroll") for(int r=0;r<16;++r)negm[r]=-mhat; asm volatile("":"+v"(negm)); } \
    _Pragma("unroll") for(int r=0;r<16;++r)P0[r]=__builtin_amdgcn_exp2f(P0[r]); }while(0)
  #define RESC() do{ if(resc){ asm volatile("s_waitcnt lgkmcnt(0)":::"memory"); \
      _Pragma("unroll") for(int d_=0;d_<2;++d_) _Pragma("unroll") for(int r=0;r<16;++r)o[d_][r]*=wsf[crow(r,hi)]; } }while(0)
  f32x16 pA0,pA1,pB0,pB1;
  int sl_prev=0,sl_cur=0,sl_next=SLOTB;
  int ks_cur=0,ks_next=KSL;
  #define ROT() do{sl_prev=sl_cur;sl_cur=sl_next;sl_next=(sl_next==(NSLOT-1)*SLOTB)?0:sl_next+SLOTB; ks_cur=ks_next;ks_next=(ks_next==(NSLOT-1)*KSL)?0:ks_next+KSL;}while(0)
  #define WB_KV() do{ if(kx){WAIT_BAR(3);}else{WAIT_BAR(2);} }while(0)
  DMA_K(2,2*KSL);
  side();
  WAIT_BAR(3);
  qkt96(pA0,pA1,Kbase,qr,negm,r32,hi);asm volatile("s_nop 15\n\ts_nop 7":"+v"(pA0),"+v"(pA1));CMASK(pA0,pA1,0);
  START(pA0,pA1);
  _Pragma("unroll") for(int r=0;r<16;++r)pA1[r]=__builtin_amdgcn_exp2f(pA1[r]);
  WAIT_BAR(0);
  DMA_K(3,0);DMA_V(1,SLOTB);
  ROT();
  kload12(kf,kp0+ks_cur);
  WB_KV();
  s16x4 vlo[8],vhi[8]; u32x4 pw0,pw1,pw2,pw3;
  #define PKW(P,B) cvtpk_s(P[B],P[B+1])
  #define PAF(k) __builtin_bit_cast(bf16x8,pw##k)
  #define VFR(i) (bf16x8){vlo[i][0],vlo[i][1],vlo[i][2],vlo[i][3],vhi[i][0],vhi[i][1],vhi[i][2],vhi[i][3]}
  #define PIN(x) asm volatile("":"+v"(x))
  #define MX3(a,b,c) __builtin_fmaxf(__builtin_fmaxf((a),(b)),(c))
  #define GAPA(MF,A0,A1,A2,A3,W0,W1,PW) do{ MF; sacc+=A0; sacc+=A1; sacc+=A2; sacc+=A3; PIN(sacc); W0; W1; PIN(PW); SBAR(); }while(0)
  #define EX(v) __builtin_amdgcn_exp2f(v)
  #define GAPB(MF,X,B) do{ MF; X[B]=EX(X[B]); X[B+1]=EX(X[B+1]); X[B+2]=EX(X[B+2]); X[B+3]=EX(X[B+3]); PIN(X); SBAR(); }while(0)
  #define VRD(i) do{ vlo[i]=vtr(vp_+(((i)>>2)*4096+((i)&3)*1024)); vhi[i]=vtr(vp_+(((i)>>2)*4096+((i)&3)*1024+512)); }while(0)
  #define KRD(G,j) do{ if(G){ kload2(kf,kp0+ks_next,j); SBAR(); } }while(0)
  #define STEP(C0,C1,P0,P1,t,GK,GV,GL) do{ SBAR(); \
    const lds_cptr vp_=vp0+sl_prev; \
    VRD(0); SBAR(); float sacc=(P0[0]+P0[1]); \
    GAPA(C0=__builtin_amdgcn_mfma_f32_32x32x16_bf16(kf[0],qr[0],negm,0,0,0), P0[2],P0[3],P0[4],P0[5],     pw0[0]=PKW(P0,0), pw0[1]=PKW(P0,2), pw0); \
    VRD(1); SBAR(); GAPA(C1=__builtin_amdgcn_mfma_f32_32x32x16_bf16(kf[1],qr[0],negm,0,0,0), P0[6],P0[7],P0[8],P0[9],     pw0[2]=PKW(P0,4), pw0[3]=PKW(P0,6), pw0); \
    VRD(2); SBAR(); GAPA(C0=__builtin_amdgcn_mfma_f32_32x32x16_bf16(kf[2],qr[1],C0,0,0,0),   P0[10],P0[11],P0[12],P0[13], pw1[0]=PKW(P0,8), pw1[1]=PKW(P0,10), pw1); \
    VRD(3); SBAR(); GAPA(C1=__builtin_amdgcn_mfma_f32_32x32x16_bf16(kf[3],qr[1],C1,0,0,0),   P0[14],P0[15],P1[0],P1[1],   pw1[2]=PKW(P0,12),pw1[3]=PKW(P0,14), pw1); \
    GAPA(C0=__builtin_amdgcn_mfma_f32_32x32x16_bf16(kf[4],qr[2],C0,0,0,0),   P1[2],P1[3],P1[4],P1[5],     pw2[0]=PKW(P1,0), pw2[1]=PKW(P1,2), pw2); \
    GAPA(C1=__builtin_amdgcn_mfma_f32_32x32x16_bf16(kf[5],qr[2],C1,0,0,0),   P1[6],P1[7],P1[8],P1[9],     pw2[2]=PKW(P1,4), pw2[3]=PKW(P1,6), pw2); \
    GAPA(C0=__builtin_amdgcn_mfma_f32_32x32x16_bf16(kf[6],qr[3],C0,0,0,0),   P1[10],P1[11],P1[12],P1[13], pw3[0]=PKW(P1,8), pw3[1]=PKW(P1,10), pw3); \
    GAPA(C1=__builtin_amdgcn_mfma_f32_32x32x16_bf16(kf[7],qr[3],C1,0,0,0),   P1[14],P1[15],0.f,0.f,       pw3[2]=PKW(P1,12),pw3[3]=PKW(P1,14), pw3); \
    VRD(4); SBAR(); C0=__builtin_amdgcn_mfma_f32_32x32x16_bf16(kf[8],qr[4],C0,0,0,0);  SBAR(); \
    VRD(5); SBAR(); C1=__builtin_amdgcn_mfma_f32_32x32x16_bf16(kf[9],qr[4],C1,0,0,0);  SBAR(); \
    VRD(6); SBAR(); C0=__builtin_amdgcn_mfma_f32_32x32x16_bf16(kf[10],qr[5],C0,0,0,0); SBAR(); \
    VRD(7); SBAR(); C1=__builtin_amdgcn_mfma_f32_32x32x16_bf16(kf[11],qr[5],C1,0,0,0); SBAR(); \
    l_reg+=sacc; \
    if(GK){DMA_K((t)+3,ks_cur);} if(GV){DMA_V((t)+1,sl_next);} \
    CMASK(C0,C1,t); \
    { float a=MX3(C0[0],C0[1],C1[0]),b=MX3(C0[2],C0[3],C1[1]); a=MX3(a,C1[2],C1[3]); \
      _Pragma("unroll") for(int r=4;r<16;r+=4){a=MX3(a,C0[r],C0[r+1]);b=MX3(b,C0[r+2],C0[r+3]);a=MX3(a,C1[r],C1[r+1]);b=MX3(b,C1[r+2],C1[r+3]);} \
      float rm=__builtin_fmaxf(a,b); { auto rr=__builtin_amdgcn_permlane32_swap(__float_as_uint(rm),__float_as_uint(rm),false,false); rm=__builtin_fmaxf(__uint_as_float(rr[0]),__uint_as_float(rr[1])); } \
      resc=false; \
      if(__builtin_expect(__any(rm>(float)THRL),0)){ const float dl=__builtin_fmaxf(rm,0.f); mhat+=dl; \
        _Pragma("unroll") for(int r=0;r<16;++r){C0[r]-=dl;C1[r]-=dl;} \
        _Pragma("unroll") for(int r=0;r<16;++r)negm[r]=-mhat; asm volatile("":"+v"(negm)); \
        const float f=__builtin_amdgcn_exp2f(-dl); l_reg*=f; if(hi==0)wsf[r32]=f; resc=true; } } \
    SBAR(); \
    GAPB(o[0]=__builtin_amdgcn_mfma_f32_32x32x16_bf16(PAF(0),VFR(0),o[0],0,0,0), C0,0); \
    GAPB(o[1]=__builtin_amdgcn_mfma_f32_32x32x16_bf16(PAF(0),VFR(4),o[1],0,0,0), C0,4); \
    KRD(GL,0); GAPB(o[0]=__builtin_amdgcn_mfma_f32_32x32x16_bf16(PAF(1),VFR(1),o[0],0,0,0), C0,8); \
    KRD(GL,1); GAPB(o[1]=__builtin_amdgcn_mfma_f32_32x32x16_bf16(PAF(1),VFR(5),o[1],0,0,0), C0,12); \
    KRD(GL,2); GAPB(o[0]=__builtin_amdgcn_mfma_f32_32x32x16_bf16(PAF(2),VFR(2),o[0],0,0,0), C1,0); \
    KRD(GL,3); GAPB(o[1]=__builtin_amdgcn_mfma_f32_32x32x16_bf16(PAF(2),VFR(6),o[1],0,0,0), C1,4); \
    KRD(GL,4); GAPB(o[0]=__builtin_amdgcn_mfma_f32_32x32x16_bf16(PAF(3),VFR(3),o[0],0,0,0), C1,8); \
    KRD(GL,5); GAPB(o[1]=__builtin_amdgcn_mfma_f32_32x32x16_bf16(PAF(3),VFR(7),o[1],0,0,0), C1,12); \
    }while(0)
  int t=1;
  #undef CMASK
  #define CMASK(P0,P1,t) do{}while(0)
  for(;t+5<NT;t+=2){
    STEP(pB0,pB1,pA0,pA1,t,true,true,true);     WB_KV(); RESC(); ROT();
    STEP(pA0,pA1,pB0,pB1,t+1,true,true,true);   WB_KV(); RESC(); ROT();
  }
  #undef CMASK
  #define CMASK(P0,P1,t) do{}while(0)
  #define ENDW(tt) do{ if((tt)+3<NT){WB_KV();} else if((tt)+2<NT){WAIT_BAR(1);} else {WAIT_BAR(0);} }while(0)
  for(;t+1<NT;t+=2){
    STEP(pB0,pB1,pA0,pA1,t,(t+3<NT),(t+1<NT),(t+1<NT));       ENDW(t);   RESC(); ROT();
    STEP(pA0,pA1,pB0,pB1,t+1,(t+4<NT),(t+2<NT),(t+2<NT));     ENDW(t+1); RESC(); ROT();
  }
  STEP(pB0,pB1,pA0,pA1,NT-1,false,false,false); RESC();
  { float sacc=pB0[0]+pB0[1]; _Pragma("unroll") for(int r=2;r<16;++r)sacc+=pB0[r]; _Pragma("unroll") for(int r=0;r<16;++r)sacc+=pB1[r]; l_reg+=sacc;
    pw0=(u32x4){PKW(pB0,0),PKW(pB0,2),PKW(pB0,4),PKW(pB0,6)};pw1=(u32x4){PKW(pB0,8),PKW(pB0,10),PKW(pB0,12),PKW(pB0,14)};pw2=(u32x4){PKW(pB1,0),PKW(pB1,2),PKW(pB1,4),PKW(pB1,6)};pw3=(u32x4){PKW(pB1,8),PKW(pB1,10),PKW(pB1,12),PKW(pB1,14)};
    SBAR(); pv(o,vb0+sl_cur,PAF(0),PAF(1),PAF(2),PAF(3)); }
  #undef PKW
  #undef PAF
  #undef VFR
  #undef PIN
  #undef MX3
  #undef GAPA
  #undef GAPB
  #undef EX
  #undef VRD
  #undef KRD
  #undef STEP
  #undef ENDW
  {auto rr=__builtin_amdgcn_permlane32_swap(__float_as_uint(l_reg),__float_as_uint(l_reg),false,false);l_reg=__uint_as_float(rr[0])+__uint_as_float(rr[1]);}
  if(hi==0)wsf[32+r32]=l_reg;asm volatile("s_waitcnt lgkmcnt(0)":::"memory");
  float rli[16];
  #pragma unroll
  for(int r=0;r<16;++r)rli[r]=__builtin_amdgcn_rcpf(wsf[32+crow(r,hi)]);
  unsigned char*Ow=Op+(long)(q0+wid*QBLK)*OP; float*ssqw=ssq+(long)(q0+wid*QBLK)*16;
  { __attribute__((address_space(3))) unsigned short*stg=(__attribute__((address_space(3))) unsigned short*)(shm+L_OST)+wid*2048;
    #pragma unroll
    for(int r=0;r<16;++r){const int orow=crow(r,hi);
      #pragma unroll
      for(int d0=0;d0<2;++d0)stg[orow*64+d0*32+r32]=(unsigned short)(cvtpk_s(o[d0][r]*rli[r],0.f)&0xffffu);}
    asm volatile("s_waitcnt lgkmcnt(0)":::"memory");
    #pragma unroll
    for(int i=0;i<4;++i){const int row=i*8+(lane>>3),ch=lane&7; const u32x4 v=*(const __attribute__((address_space(3))) u32x4*)(stg+row*64+ch*8); store8_f8<OSC>(Ow+(long)row*OP+ch*8,v);
      float q_=0.f;
      #pragma unroll
      for(int k_=0;k_<4;++k_){const float lo_=__builtin_bit_cast(float,v[k_]<<16),hi_=__builtin_bit_cast(float,v[k_]&0xffff0000u); q_+=lo_*lo_+hi_*hi_;}
      q_+=dppf<0xB1>(q_); q_+=dppf<0x4E>(q_); q_+=dppf<0x141>(q_);
      if(ch==0) ssqw[(long)row*16]=q_; } }
  asm volatile("s_waitcnt lgkmcnt(0)\n\ts_barrier":::"memory");
  #undef DMA_K
  #undef DMA_V
  #undef CMASK
  #undef START
  #undef RESC
  #undef ROT
  #undef WB_KV
}

#undef SBAR
#undef WAIT_BAR
}
constexpr int D = 1024, NBATCH = 8, SEQ = 8192, M = NBATCH * SEQ, DEPTH = 2;
constexpr int IN_W = 1696, IN_WP = 1792;
constexpr int NE = 256, NEX = 257, TOPK = 8;
constexpr int LCAP = 65536;
constexpr float EPS = 1e-6f;
constexpr float LOG2E = 1.4426950408889634f;
constexpr float C2A = 0.125f * LOG2E;
constexpr float C2C = 0.10206207261596575f * LOG2E;
constexpr int NWAVES = 8, NTHREADS = 512;

constexpr size_t MiB = 1u << 20;
constexpr size_t WS_CTL = 0, CTL_ZERO_BYTES = 1 * MiB;
constexpr size_t WS_MODV = 1 * MiB;
constexpr size_t WS_TABC = 2 * MiB, WS_TABS = 2 * MiB + 512 * 1024;
constexpr size_t WS_WC = 3 * MiB;
constexpr size_t WS_WR = 5 * MiB;
constexpr size_t WS_WIN = 6 * MiB;
constexpr size_t WS_WOUT = 13 * MiB;
constexpr size_t WS_TOPW = 18 * MiB;
constexpr size_t WS_W13 = 20 * MiB;
constexpr size_t WS_W2 = 277 * MiB;
constexpr size_t WS_LIST = 406 * MiB;
constexpr size_t WS_XN = 470 * MiB;
constexpr size_t WS_ACT = 598 * MiB;
constexpr size_t WS_PROJ = WS_ACT;
constexpr size_t WS_QA = WS_ACT + 224 * MiB;
constexpr size_t WS_KA = WS_QA + 48 * MiB;
constexpr size_t WS_VA = WS_KA + 16 * MiB;
constexpr size_t WS_QB = WS_VA + 16 * MiB;
constexpr size_t WS_KB = WS_QB + 48 * MiB;
constexpr size_t WS_VB = WS_KB + 16 * MiB;
constexpr size_t WS_CQK = WS_VB + 16 * MiB;
constexpr size_t WS_QC = WS_CQK + 48 * MiB;
constexpr size_t WS_KC = WS_QC + 48 * MiB;
constexpr size_t WS_VC = WS_KC + 48 * MiB;
constexpr size_t WS_MIX = WS_VC + 32 * MiB;
constexpr size_t WS_ATT_END = WS_MIX + 128 * MiB;
constexpr size_t WS_H = WS_ACT;
constexpr size_t WS_SSQ = 1728 * MiB;
constexpr size_t WS_XB = 1600 * MiB;
constexpr size_t WS_U2F = 1536 * MiB;
constexpr size_t WS_LOGITS = WS_ACT + 320 * MiB;
constexpr size_t WS_Y = WS_ACT + 384 * MiB;
constexpr size_t WS_END = WS_Y + 512 * MiB;
static_assert(WS_ATT_END <= WS_U2F && WS_END <= WS_U2F && WS_U2F + 64 * MiB <= WS_XB && WS_XB + 128 * MiB <= 2048 * MiB, "d_ws map");
constexpr int CW_BAR = 4096;
constexpr int CW_GCNT = 16384;

constexpr int RING_BYTES = 131072;
constexpr int LDSCTL_OFF = RING_BYTES, MISC_OFF = LDSCTL_OFF + 320;
constexpr int TAB_OFF = LDSCTL_OFF + 1024;
constexpr int LDS_BYTES = 147456;

#define GAS __attribute__((address_space(1)))
#define LAS __attribute__((address_space(3)))
typedef unsigned short bf16;
typedef unsigned v4u __attribute__((ext_vector_type(4)));
typedef unsigned v2u __attribute__((ext_vector_type(2)));
typedef float f32x4 __attribute__((ext_vector_type(4)));
typedef GAS unsigned gu32;
#define RLX_AGENT __ATOMIC_RELAXED, __HIP_MEMORY_SCOPE_AGENT
#define LDS_WAIT() asm volatile("s_waitcnt lgkmcnt(0)" ::: "memory")
#define VM_WAIT() asm volatile("s_waitcnt vmcnt(0)" ::: "memory")
__device__ __forceinline__ unsigned f2bf(float f) { unsigned u = __builtin_bit_cast(unsigned, f); return (u + 0x7fffu + ((u >> 16) & 1u)) >> 16; }
__device__ __forceinline__ unsigned pk2(float lo, float hi) { return f2bf(lo) | (f2bf(hi) << 16); }
__device__ __forceinline__ float bflo(unsigned w) { return __builtin_bit_cast(float, w << 16); }
__device__ __forceinline__ float bfhi(unsigned w) { return __builtin_bit_cast(float, w & 0xffff0000u); }
template <int K> __device__ __forceinline__ float sx(float v) { return __builtin_bit_cast(float, __builtin_amdgcn_ds_swizzle(__builtin_bit_cast(int, v), 0x1F | (K << 10))); }
template <int K> __device__ __forceinline__ int sxi(int v) { return __builtin_amdgcn_ds_swizzle(v, 0x1F | (K << 10)); }
template <int CTRL> __device__ __forceinline__ float dx(float v) { const int i = __builtin_bit_cast(int, v); return __builtin_bit_cast(float, __builtin_amdgcn_update_dpp(i, i, CTRL, 0xF, 0xF, false)); }
template <int CTRL> __device__ __forceinline__ int dxi(int v) { return __builtin_amdgcn_update_dpp(v, v, CTRL, 0xF, 0xF, false); }
__device__ __forceinline__ float red8(float v) { v += dx<0xB1>(v); v += dx<0x4E>(v); v += dx<0x141>(v); return v; }
__device__ __forceinline__ float red16(float v) { v = red8(v); v += dx<0x140>(v); return v; }
__device__ __forceinline__ float red32(float v) { v = red16(v); v += sx<16>(v); return v; }
__device__ __forceinline__ float wave_sum(float v) {
    v = red32(v);
    auto rr = __builtin_amdgcn_permlane32_swap(__float_as_uint(v), __float_as_uint(v), false, false);
    return __uint_as_float(rr[0]) + __uint_as_float(rr[1]);
}
__device__ __forceinline__ float fast_sigmoid(float x) { return __builtin_amdgcn_rcpf(1.f + __builtin_amdgcn_exp2f(-x * LOG2E)); }

#define XB_TMO      128
#define XB_XCNT(j)  (256  + 64 * (j))
#define XB_XSUB(j)  (1280 + 64 * (j))
#define XB_XGEN(j)  (2304 + 64 * (j))
#define XB_TOP      3328
#define XB_TOPGEN   3392
#define XCD_BAR_WORDS 3456
#define XB_SPIN_CAP (1u << 18)
__device__ __forceinline__ unsigned xb_ld(unsigned* p)              { return __hip_atomic_load(p, __ATOMIC_RELAXED, __HIP_MEMORY_SCOPE_AGENT); }
__device__ __forceinline__ unsigned xb_add(unsigned* p, unsigned v) { return __hip_atomic_fetch_add(p, v, __ATOMIC_RELAXED, __HIP_MEMORY_SCOPE_AGENT); }
__device__ __forceinline__ unsigned xb_xcc_id() { return (unsigned)__builtin_amdgcn_s_getreg((3 << 11) | 20) & 0xFu; }
#define XB_SPIN(cond, bar) do { unsigned _sp = 0; while (cond) { __builtin_amdgcn_s_sleep(1); \
    if ((++_sp & 255u) == 0u) { if (xb_ld(&(bar)[XB_TMO])) break; if (_sp > XB_SPIN_CAP) { atomicAdd(&(bar)[XB_TMO], 1u); break; } } } } while (0)
struct XcdBarrier { unsigned* bar; unsigned x; volatile LAS unsigned* st; };
__device__ __forceinline__ XcdBarrier xcd_barrier_post(unsigned* bar, volatile LAS unsigned* st) {
    XcdBarrier b; b.bar = bar; b.x = xb_xcc_id(); b.st = st;
    if (threadIdx.x == 0) (void)xb_add(&bar[XB_XCNT(b.x)], 1u);
    return b;
}
__device__ __forceinline__ void xcd_barrier_complete(unsigned* bar, unsigned x, unsigned& nloc, unsigned& nx) {
    const unsigned G = gridDim.x * gridDim.y * gridDim.z;
    unsigned sum, cnt, mine, sp = 0u;
    for (;;) {
        sum = 0u; cnt = 0u; mine = 0u;
#pragma unroll
        for (unsigned j = 0; j < 16; ++j) { const unsigned c = xb_ld(&bar[XB_XCNT(j)]); sum += c; cnt += (c > 0u) ? 1u : 0u; mine = (j == x) ? c : mine; }
        if (sum == G) break;
        __builtin_amdgcn_s_sleep(1);
        if ((++sp & 255u) == 0u) { if (xb_ld(&bar[XB_TMO])) break; if (sp > XB_SPIN_CAP) { atomicAdd(&bar[XB_TMO], 1u); break; } }
    }
    nloc = mine > 0u ? mine : 1u; nx = cnt > 0u ? cnt : 1u;
}
__device__ __forceinline__ void xcd_barrier(const XcdBarrier& b) {
    asm volatile("s_waitcnt vmcnt(0)" ::: "memory");
    __syncthreads();
    if (threadIdx.x == 0) {
        unsigned* bar = b.bar;
        __builtin_amdgcn_s_waitcnt(0);
        unsigned nloc = b.st[0], nx = b.st[1];
        if (nloc == 0u) { xcd_barrier_complete(bar, b.x, nloc, nx); b.st[0] = nloc; b.st[1] = nx; }
        const unsigned old = xb_add(&bar[XB_XSUB(b.x)], 1u);
        const unsigned gen = old / nloc;
        if (old + 1u == (gen + 1u) * nloc) {
            __builtin_amdgcn_fence(__ATOMIC_RELEASE, "agent");
            asm volatile("s_waitcnt vmcnt(0)" ::: "memory");
            const unsigned og = xb_add(&bar[XB_TOP], 1u);
            const unsigned tg = og / nx;
            if (og + 1u == (tg + 1u) * nx) xb_add(&bar[XB_TOPGEN], 1u);
            else XB_SPIN(xb_ld(&bar[XB_TOPGEN]) == tg, bar);
            __builtin_amdgcn_fence(__ATOMIC_ACQUIRE, "agent");
            xb_add(&bar[XB_XGEN(b.x)], 1u);
            asm volatile("s_waitcnt vmcnt(0)" ::: "memory");
        } else {
            XB_SPIN(xb_ld(&bar[XB_XGEN(b.x)]) == gen, bar);
            __builtin_amdgcn_fence(__ATOMIC_ACQUIRE, "agent");
            asm volatile("s_waitcnt vmcnt(0)" ::: "memory");
        }
    }
    __syncthreads();
}
constexpr size_t WS_DRY0 = 1792ull << 20, WS_DRY1 = 1920ull << 20;
#define DRY(p) (NREP(p) == 2 && rep_ == 0)
#ifndef REP_MASK
#define REP_MASK 0
#endif
#define NREP(p) ((((REP_MASK) >> (p)) & 1) ? 2 : 1)
enum InIdx { I_X = 0, I_C, I_MODW, I_MODB, I_N1G, I_N2G, I_WIN, I_AQG, I_AKG, I_BSINK, I_CQG, I_CKVG, I_WUQ, I_WUK, I_WUV, I_ONG, I_WOUT, I_RW, I_RB, I_EW1, I_EW3, I_EW2, I_SW1, I_SW3, I_SW2, I_FG, N_IN };
struct Args { const float* in[N_IN]; float* out; unsigned char* ws; int ph_lo, ph_hi; };
constexpr int PH_PER_LAYER = 13, N_PHASES = 1 + PH_PER_LAYER * DEPTH;

typedef __attribute__((address_space(4))) const Args* KArgs;
__device__ __forceinline__ KArgs kargs() { KArgs p = (KArgs)__builtin_amdgcn_kernarg_segment_ptr(); asm volatile("" : "+s"(p)); return p; }
struct Ctx {
    LAS unsigned char* lds; unsigned char* ws;
    int tid, lane, wave, G, vcu, gw, NGW;
};

__device__ __forceinline__ void tr_item(const float* W, int N, bf16* WT, int ldk, int koff, int drow0, LAS float* scr, int k0, int n0, int lane, const float* ks = nullptr  ) {
    float tv[32];
#pragma unroll
    for (int i = 0; i < 32; ++i) { const int kk = 2 * i + (lane >> 5); tv[i] = __builtin_nontemporal_load(W + (size_t)(k0 + kk) * N + n0 + (lane & 31)); }
#pragma unroll
    for (int i = 0; i < 32; ++i) { const int kk = 2 * i + (lane >> 5); scr[kk * 33 + (lane & 31)] = tv[i] * (ks ? ks[k0 + kk] : 1.f); }
    LDS_WAIT(); asm volatile("" ::: "memory");
    const int c = lane & 7;
#pragma unroll
    for (int j = 0; j < 4; ++j) { const int n = (lane >> 3) + 8 * j; const LAS float* s = scr + (8 * c) * 33 + n;
        v4u o; o.x = pk2(s[0 * 33], s[1 * 33]); o.y = pk2(s[2 * 33], s[3 * 33]); o.z = pk2(s[4 * 33], s[5 * 33]); o.w = pk2(s[6 * 33], s[7 * 33]);
        *(GAS v4u*)(WT + (size_t)(drow0 + n) * ldk + koff + k0 + 8 * c) = o; }
    LDS_WAIT(); asm volatile("" ::: "memory");
}
__device__ __forceinline__ unsigned pk4_fp8(float a, float b, float c, float d) { int w = 0; w = __builtin_amdgcn_cvt_pk_fp8_f32(a, b, w, false); w = __builtin_amdgcn_cvt_pk_fp8_f32(c, d, w, true); return (unsigned)w; }
__device__ __forceinline__ void tr_load(const float* W, int N, int k0, int n0, int lane, float (&tv)[32]) {
#pragma unroll
    for (int i = 0; i < 32; ++i) { const int kk = 2 * i + (lane >> 5); tv[i] = __builtin_nontemporal_load(W + (size_t)(k0 + kk) * N + n0 + (lane & 31)); }
}
__device__ __forceinline__ void tr_store_f8(const float (&tv)[32], unsigned char* WT, int ldk, int drow0, float sc, LAS float* scr, int k0, int lane, const float* ks = nullptr  ) {
#pragma unroll
    for (int i = 0; i < 32; ++i) { const int kk = 2 * i + (lane >> 5); scr[kk * 33 + (lane & 31)] = tv[i] * (ks ? ks[k0 + kk] : 1.f); }
    LDS_WAIT(); asm volatile("" ::: "memory");
    const int c = lane & 7;
#pragma unroll
    for (int j = 0; j < 4; ++j) { const int n = (lane >> 3) + 8 * j; const LAS float* s = scr + (8 * c) * 33 + n;
        v2u o; o.x = pk4_fp8(s[0 * 33] * sc, s[1 * 33] * sc, s[2 * 33] * sc, s[3 * 33] * sc); o.y = pk4_fp8(s[4 * 33] * sc, s[5 * 33] * sc, s[6 * 33] * sc, s[7 * 33] * sc);
        *(GAS v2u*)(WT + (size_t)(drow0 + n) * ldk + k0 + 8 * c) = o; }
    LDS_WAIT(); asm volatile("" ::: "memory");
}
__device__ __forceinline__ void tr_item_f8(const float* W, int N, unsigned char* WT, int ldk, int drow0, float sc, LAS float* scr, int k0, int n0, int lane, const float* ks = nullptr) {
    float tv[32]; tr_load(W, N, k0, n0, lane, tv); tr_store_f8(tv, WT, ldk, drow0, sc, scr, k0, lane, ks);
}
constexpr float SC_W13 = 64.f, SC_W2 = 32.f, SC_H = 8.f;
constexpr int SC_MIXA = 256, SC_MIXB = 32, SC_MIXC = 256; constexpr float SC_WO = 64.f;
struct ExpItem { const float* src; unsigned char* dst; int N, ldk, drow0, k0, n0; float sc; };
__device__ __forceinline__ ExpItem expert_item(const KArgs ap, unsigned char* ws, int l, int it) {
    ExpItem x; const int e = it / 384, r = it % 384, which = r >> 7, q = r & 127;
    if (which < 2) {
        const float* ew = which == 0 ? ap->in[I_EW1] : ap->in[I_EW3]; const float* sw = which == 0 ? ap->in[I_SW1] : ap->in[I_SW3];
        x.src = (e < NE) ? ew + (size_t)(l * NE + e) * 262144 : sw + (size_t)l * 262144;
        const int kb = q >> 3, nb = q & 7;
        x.dst = ws + WS_W13 + (size_t)e * 524288; x.N = 256; x.ldk = 1024; x.drow0 = (nb >> 2) * 256 + (nb & 3) * 32 + which * 128; x.k0 = kb * 64; x.n0 = nb * 32; x.sc = SC_W13;
    } else {
        x.src = (e < NE) ? ap->in[I_EW2] + (size_t)(l * NE + e) * 262144 : ap->in[I_SW2] + (size_t)l * 262144;
        const int kb = q >> 5, nb = q & 31;
        x.dst = ws + WS_W2 + (size_t)e * 262144; x.N = 1024; x.ldk = 256; x.drow0 = nb * 32; x.k0 = kb * 64; x.n0 = nb * 32; x.sc = SC_W2;
    }
    return x;
}
__device__ __forceinline__ void convert_experts(const Ctx& c, int l) {
    LAS float* scr = (LAS float*)(c.lds + c.wave * 16384);
    const KArgs ap = kargs();
    constexpr int NIT = NEX * 384;
    for (int it = c.gw; it < NIT; it += 2 * c.NGW) {
        const ExpItem a0 = expert_item(ap, c.ws, l, it); const bool two = it + c.NGW < NIT; const ExpItem a1 = expert_item(ap, c.ws, l, two ? it + c.NGW : it);
        float t0[32], t1[32];
        tr_load(a0.src, a0.N, a0.k0, a0.n0, c.lane, t0); tr_load(a1.src, a1.N, a1.k0, a1.n0, c.lane, t1);
        tr_store_f8(t0, a0.dst, a0.ldk, a0.drow0, a0.sc, scr, a0.k0, c.lane);
        if (two) tr_store_f8(t1, a1.dst, a1.ldk, a1.drow0, a1.sc, scr, a1.k0, c.lane);
    }
}
__device__ __forceinline__ void tr_store_f8_half(const float (&tv)[32], int half, unsigned char* WT, int ldk, int drow0, float sc, LAS float* scr, int k0, int lane) {
#pragma unroll
    for (int i = 0; i < 16; ++i) { const int kk = 2 * i + (lane >> 5); scr[kk * 33 + (lane & 31)] = tv[16 * half + i]; }
    LDS_WAIT(); asm volatile("" ::: "memory");
    const int c = lane & 3;
#pragma unroll
    for (int j = 0; j < 2; ++j) { const int n = (lane >> 2) + 16 * j; const LAS float* s = scr + (8 * c) * 33 + n;
        v2u o; o.x = pk4_fp8(s[0 * 33] * sc, s[1 * 33] * sc, s[2 * 33] * sc, s[3 * 33] * sc); o.y = pk4_fp8(s[4 * 33] * sc, s[5 * 33] * sc, s[6 * 33] * sc, s[7 * 33] * sc);
        *(GAS v2u*)(WT + (size_t)(drow0 + n) * ldk + k0 + 32 * half + 8 * c) = o; }
    LDS_WAIT(); asm volatile("" ::: "memory");
}
struct ExpItem2 { const float* src; unsigned char* dst; int N, ldk; float sc; };
__device__ __forceinline__ ExpItem2 expert_item2(const KArgs ap, unsigned char* ws, int l, int it) {
    ExpItem2 x; const int e = it / 192, r = it % 192, which = r >> 6, q = r & 63;
    if (which < 2) {
        const float* ew = which == 0 ? ap->in[I_EW1] : ap->in[I_EW3]; const float* sw = which == 0 ? ap->in[I_SW1] : ap->in[I_SW3];
        const float* base = (e < NE) ? ew + (size_t)(l * NE + e) * 262144 : sw + (size_t)l * 262144;
        const int k0 = (q >> 3) * 128, n0 = (q & 7) * 32;
        x.N = 256; x.ldk = 1024; x.sc = SC_W13; x.src = base + (size_t)k0 * 256 + n0;
        x.dst = ws + WS_W13 + (size_t)e * 524288 + (size_t)((n0 >> 7) * 256 + which * 128 + (n0 & 127)) * 1024 + k0;
    } else {
        const float* base = (e < NE) ? ap->in[I_EW2] + (size_t)(l * NE + e) * 262144 : ap->in[I_SW2] + (size_t)l * 262144;
        const int k0 = (q >> 5) * 128, n0 = (q & 31) * 32;
        x.N = 1024; x.ldk = 256; x.sc = SC_W2; x.src = base + (size_t)k0 * 1024 + n0;
        x.dst = ws + WS_W2 + (size_t)e * 262144 + (size_t)n0 * 256 + k0;
    }
    return x;
}
__device__ __forceinline__ void cvt_item_load(const ExpItem2& a, int lane, f32x4 (&v)[4][4]) {
    const float* p = a.src + (size_t)(16 * (lane >> 3)) * a.N + 4 * (lane & 7);
#pragma unroll
    for (int s_ = 0; s_ < 4; ++s_)
#pragma unroll
        for (int i = 0; i < 4; ++i) v[s_][i] = __builtin_nontemporal_load((const GAS f32x4*)(p + (size_t)(4 * s_ + i) * a.N));
}
__device__ __forceinline__ void cvt_item_store(const ExpItem2& a, int lane, const f32x4 (&v)[4][4]) {
    unsigned char* d = a.dst + (size_t)(4 * (lane & 7)) * a.ldk + 16 * (lane >> 3); const float sc = a.sc;
#pragma unroll
    for (int j = 0; j < 4; ++j) { v4u o;
        o.x = pk4_fp8(v[0][0][j] * sc, v[0][1][j] * sc, v[0][2][j] * sc, v[0][3][j] * sc); o.y = pk4_fp8(v[1][0][j] * sc, v[1][1][j] * sc, v[1][2][j] * sc, v[1][3][j] * sc);
        o.z = pk4_fp8(v[2][0][j] * sc, v[2][1][j] * sc, v[2][2][j] * sc, v[2][3][j] * sc); o.w = pk4_fp8(v[3][0][j] * sc, v[3][1][j] * sc, v[3][2][j] * sc, v[3][3][j] * sc);
        *(GAS v4u*)(d + (size_t)j * a.ldk) = o; }
}
__device__ __forceinline__ void convert_experts_part(const Ctx& c, int l, int part, int nparts) {
    const KArgs ap = kargs();
    constexpr int NIT = NEX * 192;
    const int K = (NIT - c.gw + 2 * c.NGW - 1) / (2 * c.NGW); const int k_lo = (int)((long)part * K / nparts), k_hi = (int)((long)(part + 1) * K / nparts);
    for (int k = k_lo; k < k_hi; ++k) { const int it = c.gw + k * 2 * c.NGW;
        const bool two = it + c.NGW < NIT;
        const ExpItem2 a0 = expert_item2(ap, c.ws, l, it), a1 = expert_item2(ap, c.ws, l, two ? it + c.NGW : it);
        f32x4 v0[4][4], v1[4][4];
        cvt_item_load(a0, c.lane, v0); cvt_item_load(a1, c.lane, v1);
        cvt_item_store(a0, c.lane, v0); if (two) cvt_item_store(a1, c.lane, v1);
    }
    VM_WAIT();
}
__device__ __forceinline__ void zero_rect(const Ctx& c, bf16* base, int ld, int r0, int nr, int c0, int nc) {
    const int cpr = nc / 8, total = nr * cpr;
    for (int i = c.gw * 64 + c.lane; i < total; i += c.NGW * 64) { const int r = i / cpr, cc = i % cpr; *(GAS v4u*)(base + (size_t)(r0 + r) * ld + c0 + cc * 8) = (v4u){0u, 0u, 0u, 0u}; }
}
__device__ __forceinline__ void prologue(const Ctx& c) {
    const KArgs ap = kargs(); const auto& a = *ap;
    for (int item = blockIdx.x; item < DEPTH * 128; item += c.G) {
        const int l = item / 128, grp = item % 128;
        LAS float* cact = (LAS float*)c.lds; LAS float* part = cact + 8192;
        for (int i = c.tid; i < 8192; i += NTHREADS) { const float v = a.in[I_C][i]; cact[i] = v * fast_sigmoid(v); }
        __syncthreads();
        const int col = grp * 48 + (c.lane < 48 ? c.lane : 47); const float* W = a.in[I_MODW] + (size_t)l * 1024 * 6144 + col;
        float acc[8];
#pragma unroll
        for (int b = 0; b < 8; ++b) acc[b] = 0.f;
#pragma unroll 16
        for (int d = c.wave * 128; d < c.wave * 128 + 128; ++d) { const float w = __builtin_nontemporal_load(W + (size_t)d * 6144);
#pragma unroll
            for (int b = 0; b < 8; ++b) acc[b] += cact[b * 1024 + d] * w; }
#pragma unroll
        for (int b = 0; b < 8; ++b) part[(c.wave * 8 + b) * 64 + c.lane] = acc[b];
        __syncthreads();
        { const int b = c.wave; float s = a.in[I_MODB][l * 6144 + col];
#pragma unroll
          for (int w = 0; w < 8; ++w) s += part[(w * 8 + b) * 64 + c.lane];
          if (c.lane < 48) ((float*)(c.ws + WS_MODV))[(size_t)(l * 8 + b) * 6144 + col] = s; }
        __syncthreads();
    }
    { float* TC = (float*)(c.ws + WS_TABC); float* TS = (float*)(c.ws + WS_TABS);
      for (int idx = c.gw * 64 + c.lane; idx < 8192 * 16; idx += c.NGW * 64) { const int p = idx >> 4, j = idx & 15;
          const double inv = exp2(-(double)j * (13.287712379549449 / 16.0)); double rev = (double)p * inv * 0.15915494309189535; rev -= rint(rev);
          TC[idx] = __builtin_amdgcn_cosf((float)rev); TS[idx] = __builtin_amdgcn_sinf((float)rev); } }
    __syncthreads();
    { LAS float* scr = (LAS float*)(c.lds + c.wave * 16384);
      constexpr int I0 = 16 * 53, I1 = I0 + 16 * 32, I2 = I1 + 16 * 8, I3 = I2 + 4 * 12, I4 = I3 + 2 * 8, I5 = I4 + 2 * 8;
      for (int it = c.gw; it < DEPTH * I5; it += c.NGW) {
          const int l = it / I5; int r = it % I5;
          if (r < I0) { tr_item(a.in[I_WIN] + (size_t)l * 1024 * IN_W, IN_W, (bf16*)(c.ws + WS_WIN) + (size_t)l * IN_WP * 1024, 1024, 0, (r % 53) * 32, scr, (r / 53) * 64, (r % 53) * 32, c.lane); continue; } r -= I0;
          if (r < 16 * 32) { tr_item_f8(a.in[I_WOUT] + (size_t)l * 1024 * 1024, 1024, c.ws + WS_WOUT + (size_t)l * 1024 * 1024, 1024, (r & 31) * 32, SC_WO, scr, (r >> 5) * 64, (r & 31) * 32, c.lane, a.in[I_ONG] + l * 1024); continue; } r -= 16 * 32;
          if (r < 16 * 8) { tr_item(a.in[I_RW] + (size_t)l * 1024 * 256, 256, (bf16*)(c.ws + WS_WR) + (size_t)l * 256 * 1024, 1024, 0, (r & 7) * 32, scr, (r >> 3) * 64, (r & 7) * 32, c.lane); continue; } r -= 16 * 8;
          bf16* WC = (bf16*)(c.ws + WS_WC) + (size_t)l * 1024 * 384;
          if (r < 48) { tr_item(a.in[I_WUQ] + (size_t)l * 256 * 384, 384, WC, 384, 0, (r % 12) * 32, scr, (r / 12) * 64, (r % 12) * 32, c.lane); continue; } r -= 48;
          if (r < 16) { tr_item(a.in[I_WUK] + (size_t)l * 128 * 256, 256, WC, 384, 256, 384 + (r & 7) * 32, scr, (r >> 3) * 64, (r & 7) * 32, c.lane); continue; } r -= 16;
          tr_item(a.in[I_WUV] + (size_t)l * 128 * 256, 256, WC, 384, 256, 640 + (r & 7) * 32, scr, (r >> 3) * 64, (r & 7) * 32, c.lane);
      }
      for (int l = 0; l < DEPTH; ++l) {
          zero_rect(c, (bf16*)(c.ws + WS_WIN) + (size_t)l * IN_WP * 1024, 1024, IN_W, IN_WP - IN_W, 0, 1024);
          bf16* WC = (bf16*)(c.ws + WS_WC) + (size_t)l * 1024 * 384;
          zero_rect(c, WC, 384, 0, 384, 256, 128); zero_rect(c, WC, 384, 384, 512, 0, 256); zero_rect(c, WC, 384, 896, 128, 0, 384);
      } }
}

template <bool SRC_F32>
__device__ __forceinline__ void norm_mod_rows(const Ctx& c, const void* X, bf16* Y, unsigned char* Y8  , const float* g, const float* modv  , int i_shift, int i_scale) {
    constexpr int NRF = 4;
    for (int m0 = c.gw; m0 < M; m0 += NRF * c.NGW) {
        f32x4 v[NRF][4]; float s[NRF];
#pragma unroll
        for (int u = 0; u < NRF; ++u) { const int m = m0 + u * c.NGW; const size_t ro = (size_t)(m < M ? m : m0) * D;
            if constexpr (SRC_F32) { const GAS f32x4* xr = (const GAS f32x4*)((const float*)X + ro) + c.lane;
#pragma unroll
                for (int j = 0; j < 4; ++j) v[u][j] = __builtin_nontemporal_load(xr + 64 * j); }
            else { const GAS v2u* xr = (const GAS v2u*)((const bf16*)X + ro) + c.lane;
#pragma unroll
                for (int j = 0; j < 4; ++j) { const v2u w = xr[64 * j]; v[u][j] = (f32x4){bflo(w.x), bfhi(w.x), bflo(w.y), bfhi(w.y)}; } } }
#pragma unroll
        for (int u = 0; u < NRF; ++u) { float q = 0.f;
#pragma unroll
            for (int j = 0; j < 4; ++j) q += (v[u][j].x * v[u][j].x + v[u][j].y * v[u][j].y) + (v[u][j].z * v[u][j].z + v[u][j].w * v[u][j].w);
            s[u] = q; }
#pragma unroll
        for (int u = 0; u < NRF; ++u) { const int m = m0 + u * c.NGW; if (m >= M) break;
            const int b = m >> 13; const float rstd = 1.f / sqrtf(wave_sum(s[u]) * (1.f / D) + EPS);
            const f32x4* gp = (const f32x4*)g + c.lane; const f32x4* scp = (const f32x4*)(modv + (size_t)(b * 6 + i_scale) * 1024) + c.lane; const f32x4* shp = (const f32x4*)(modv + (size_t)(b * 6 + i_shift) * 1024) + c.lane;
            GAS v2u* o8 = (GAS v2u*)(Y + (size_t)m * D) + c.lane;
#pragma unroll
            for (int j = 0; j < 4; ++j) { const f32x4 gg = gp[64 * j], sc = scp[64 * j], sh = shp[64 * j]; const f32x4 y = v[u][j] * rstd * gg * (sc + 1.f) + sh;
                o8[64 * j] = (v2u){pk2(y.x, y.y), pk2(y.z, y.w)};
                if (Y8) *((GAS unsigned*)(Y8 + (size_t)m * D) + c.lane + 64 * j) = pk4_fp8(y.x, y.y, y.z, y.w); } }
    }
}
__device__ __forceinline__ void unpack8(const v4u w, float (&v)[8]) { v[0] = bflo(w.x); v[1] = bfhi(w.x); v[2] = bflo(w.y); v[3] = bfhi(w.y); v[4] = bflo(w.z); v[5] = bfhi(w.z); v[6] = bflo(w.w); v[7] = bfhi(w.w); }
__device__ __forceinline__ v4u pack8(const float (&v)[8]) { return (v4u){pk2(v[0], v[1]), pk2(v[2], v[3]), pk2(v[4], v[5]), pk2(v[6], v[7])}; }
__device__ __forceinline__ float sumsq8(const float (&v)[8]) { float s = 0.f;
#pragma unroll
    for (int i = 0; i < 8; ++i) s += v[i] * v[i]; return s; }
__device__ __forceinline__ void norm2_rows(const Ctx& c, const bf16* X, bf16* Y, unsigned char* Y8, const float* g, const float* modv, int i_shift, int i_scale) {
    const int lane = c.lane;
    for (int m0 = c.gw; m0 < M; m0 += 4 * c.NGW) {
        v4u w0[4], w1[4];
#pragma unroll
        for (int u = 0; u < 4; ++u) { const int m = (m0 + u * c.NGW) < M ? (m0 + u * c.NGW) : m0; const bf16* row = X + (size_t)m * D; w0[u] = *(const GAS v4u*)(row + 8 * lane); w1[u] = *(const GAS v4u*)(row + 512 + 8 * lane); }
#pragma unroll
        for (int u = 0; u < 4; ++u) { const int m = m0 + u * c.NGW; if (m >= M) break;
            const int b = m >> 13; float v0[8], v1[8]; unpack8(w0[u], v0); unpack8(w1[u], v1);
            const float rstd = 1.f / sqrtf(wave_sum(sumsq8(v0) + sumsq8(v1)) * (1.f / D) + EPS);
            const float* scp = modv + (size_t)(b * 6 + i_scale) * 1024; const float* shp = modv + (size_t)(b * 6 + i_shift) * 1024;
#pragma unroll
            for (int h = 0; h < 2; ++h) { const int e0 = h * 512 + 8 * lane; float (&v)[8] = h == 0 ? v0 : v1;
                const f32x4 ga = *(const f32x4*)(g + e0), gb = *(const f32x4*)(g + e0 + 4), sa = *(const f32x4*)(scp + e0), sb = *(const f32x4*)(scp + e0 + 4), ha = *(const f32x4*)(shp + e0), hb = *(const f32x4*)(shp + e0 + 4);
                float y[8];
                y[0] = v[0] * rstd * ga.x * (1.f + sa.x) + ha.x; y[1] = v[1] * rstd * ga.y * (1.f + sa.y) + ha.y; y[2] = v[2] * rstd * ga.z * (1.f + sa.z) + ha.z; y[3] = v[3] * rstd * ga.w * (1.f + sa.w) + ha.w;
                y[4] = v[4] * rstd * gb.x * (1.f + sb.x) + hb.x; y[5] = v[5] * rstd * gb.y * (1.f + sb.y) + hb.y; y[6] = v[6] * rstd * gb.z * (1.f + sb.z) + hb.z; y[7] = v[7] * rstd * gb.w * (1.f + sb.w) + hb.w;
                *(GAS v4u*)(Y + (size_t)m * D + e0) = pack8(y);
                *(GAS v2u*)(Y8 + (size_t)m * D + e0) = (v2u){pk4_fp8(y[0], y[1], y[2], y[3]), pk4_fp8(y[4], y[5], y[6], y[7])}; } }
    }
}
__device__ __forceinline__ void rope8(float (&y)[8], int r8, int pos, const float* TC, const float* TS) {
    float py[8];
#pragma unroll
    for (int i = 0; i < 8; ++i) py[i] = dx<0x4E>(y[i]);
    const int j0 = (r8 & 1) * 8; const f32x4* cp = (const f32x4*)(TC + pos * 16 + j0); const f32x4* sp = (const f32x4*)(TS + pos * 16 + j0);
    const f32x4 c0 = cp[0], c1 = cp[1], s0 = sp[0], s1 = sp[1];
    const float cs[8] = {c0.x, c0.y, c0.z, c0.w, c1.x, c1.y, c1.z, c1.w}, sn[8] = {s0.x, s0.y, s0.z, s0.w, s1.x, s1.y, s1.z, s1.w};
    const bool first = r8 < 2;
#pragma unroll
    for (int i = 0; i < 8; ++i) y[i] = first ? (y[i] * cs[i] - py[i] * sn[i]) : (py[i] * sn[i] + y[i] * cs[i]);
}
struct QkvDst { bf16 *QA, *KA, *VA, *QB, *KB, *VB, *CQK, *KC; const float *TC, *TS, *aqg, *akg, *cqg, *ckvg; };
__device__ __forceinline__ void qkv_row(const QkvDst& d, int t, int lane, const v4u w0, const v4u w2, const v4u w3) {
    const int pos = t & (SEQ - 1), prow = pos >> 6, pcol = pos & 63;
    { float v[8]; unpack8(w0, v);
      const float ss = red8(sumsq8(v));
      const float rstd = 1.f / sqrtf(ss * (1.f / 64.f) + EPS);
      const int head = lane >> 3, d0 = (lane & 7) * 8; const float* gg = (head < 6 ? d.aqg : d.akg) + d0;
#pragma unroll
      for (int i = 0; i < 8; ++i) v[i] = v[i] * rstd * gg[i];
      rope8(v, (lane & 3), (d0 < 32) ? prow : pcol, d.TC, d.TS);
      if (head < 6) {
#pragma unroll
          for (int i = 0; i < 8; ++i) v[i] *= C2A;
          *(GAS v4u*)(d.QA + (size_t)t * 384 + head * 64 + d0) = pack8(v);
      } else *(GAS v4u*)(d.KA + (size_t)t * 128 + (head - 6) * 64 + d0) = pack8(v); }
    { const int e0 = 1024 + 8 * lane; float v[8]; unpack8(w2, v);
      const float ss = red32(sumsq8(v));
      if (e0 >= 1280) { const float rstd = 1.f / sqrtf(ss * (1.f / 256.f) + EPS); const float* gg = d.cqg + (e0 - 1280);
#pragma unroll
          for (int i = 0; i < 8; ++i) v[i] = v[i] * rstd * gg[i];
          *(GAS v4u*)(d.CQK + (size_t)t * 384 + (e0 - 1280)) = pack8(v); } }
    { const int e0 = 1536 + 8 * lane; float v[8]; unpack8(w3, v);
      const float ss = red16(sumsq8(v));
      float y[8];
#pragma unroll
      for (int i = 0; i < 8; ++i) y[i] = v[i];
      rope8(y, (lane & 3), pos, d.TC, d.TS);
      if (lane < 16) { const float rstd = 1.f / sqrtf(ss * (1.f / 128.f) + EPS); const float* gg = d.ckvg + (e0 - 1536);
#pragma unroll
          for (int i = 0; i < 8; ++i) v[i] = v[i] * rstd * gg[i];
          *(GAS v4u*)(d.CQK + (size_t)t * 384 + 256 + (e0 - 1536)) = pack8(v); }
      else if (lane < 20) { const v4u o = pack8(y); const int r = (lane - 16) * 8;
#pragma unroll
          for (int h = 0; h < 4; ++h) *(GAS v4u*)(d.KC + (size_t)t * 384 + h * 96 + 64 + r) = o; } }
}
__device__ __forceinline__ void qkv_prep_rows(const Ctx& c, int l) {
    const KArgs ap = kargs(); unsigned char* ws = c.ws;
    const bf16* PROJ = (const bf16*)(ws + WS_PROJ);
    QkvDst d{(bf16*)(ws + WS_QA), (bf16*)(ws + WS_KA), (bf16*)(ws + WS_VA), (bf16*)(ws + WS_QB), (bf16*)(ws + WS_KB), (bf16*)(ws + WS_VB), (bf16*)(ws + WS_CQK), (bf16*)(ws + WS_KC),
             (const float*)(ws + WS_TABC), (const float*)(ws + WS_TABS), ap->in[I_AQG] + l * 64, ap->in[I_AKG] + l * 64, ap->in[I_CQG] + l * 256, ap->in[I_CKVG] + l * 128};
    const int lane = c.lane;
    for (int t0 = c.gw; t0 < M; t0 += 8 * c.NGW) {
        v4u w[8][3];
#pragma unroll
        for (int u = 0; u < 8; ++u) { const int t = (t0 + u * c.NGW) < M ? (t0 + u * c.NGW) : t0; const bf16* pr = PROJ + (size_t)t * IN_WP;
            w[u][0] = __builtin_nontemporal_load((const GAS v4u*)(pr + 8 * lane));
            w[u][1] = (v4u){0u, 0u, 0u, 0u}; if (lane >= 32) w[u][1] = __builtin_nontemporal_load((const GAS v4u*)(pr + 1024 + 8 * lane));
            w[u][2] = (v4u){0u, 0u, 0u, 0u}; if (lane < 20) w[u][2] = __builtin_nontemporal_load((const GAS v4u*)(pr + 1536 + 8 * lane)); }
#pragma unroll
        for (int u = 0; u < 8; ++u) if (t0 + u * c.NGW < M) qkv_row(d, t0 + u * c.NGW, lane, w[u][0], w[u][1], w[u][2]);
    }
}
__device__ __forceinline__ void mixnorm_rows(const Ctx& c, int l, bool dry = false) {
    bf16* MIX = (bf16*)(c.ws + WS_MIX); bf16* MIXO = dry ? (bf16*)(c.ws + WS_DRY0) : MIX; const float* g = kargs()->in[I_ONG] + l * 1024; const int lane = c.lane;
    const float* g0 = g + 8 * lane; const float* g1 = g + 512 + 8 * lane;
    float gg0[8], gg1[8];
#pragma unroll
    for (int i = 0; i < 8; ++i) { gg0[i] = g0[i]; gg1[i] = g1[i]; }
    for (int t0 = c.gw; t0 < M; t0 += 4 * c.NGW) {
        v4u w0[4], w1[4];
#pragma unroll
        for (int u = 0; u < 4; ++u) { const int t = (t0 + u * c.NGW) < M ? (t0 + u * c.NGW) : t0; const bf16* row = MIX + (size_t)t * 1024; w0[u] = __builtin_nontemporal_load((const GAS v4u*)(row + 8 * lane)); w1[u] = __builtin_nontemporal_load((const GAS v4u*)(row + 512 + 8 * lane)); }
#pragma unroll
        for (int u = 0; u < 4; ++u) { const int t = t0 + u * c.NGW; if (t >= M) break;
            bf16* row = MIXO + (size_t)t * 1024;
            float v0[8], v1[8]; unpack8(w0[u], v0); unpack8(w1[u], v1);
            const float q0 = sumsq8(v0), q1 = sumsq8(v1);
            const float sA = wave_sum(lane < 48 ? q0 : 0.f), sB = wave_sum((lane >= 48 ? q0 : 0.f) + (lane < 32 ? q1 : 0.f)), sC = wave_sum(lane >= 32 ? q1 : 0.f);
            const float rA = 1.f / sqrtf(sA * (1.f / 384.f) + EPS), rB = 1.f / sqrtf(sB * (1.f / 384.f) + EPS), rC = 1.f / sqrtf(sC * (1.f / 256.f) + EPS);
            const float r0 = lane < 48 ? rA : rB, r1 = lane < 32 ? rB : rC;
#pragma unroll
            for (int i = 0; i < 8; ++i) { v0[i] = v0[i] * r0 * gg0[i]; v1[i] = v1[i] * r1 * gg1[i]; }
            *(GAS v4u*)(row + 8 * lane) = pack8(v0); *(GAS v4u*)(row + 512 + 8 * lane) = pack8(v1); }
    }
}
__device__ __forceinline__ void combine_rows(const Ctx& c, int l, bool dry = false) {
    const unsigned char* Y8 = (const unsigned char*)(c.ws + WS_Y); bf16* YS = (bf16*)(c.ws + WS_XN); float* OUT = kargs()->out; bf16* XB = (bf16*)(c.ws + WS_XB);
    const float* modv = (const float*)(c.ws + WS_MODV) + (size_t)l * 8 * 6144; const int lane = c.lane;
    const bool lastl = (l + 1 == DEPTH);
    const float* gn = lastl ? kargs()->in[I_FG] : kargs()->in[I_N1G] + (l + 1) * 1024;
    const float* modn = (const float*)(c.ws + WS_MODV) + (size_t)(lastl ? l : l + 1) * 8 * 6144;
    const int cA = (lane >> 4) * 256 + ((lane >> 2) & 3) * 32 + (lane & 3) * 8;
    for (int t = c.gw; t < M; t += c.NGW) {
        const int b = t >> 13;
        float acc[16], ys[16];
#pragma unroll
        for (int i = 0; i < 16; ++i) acc[i] = 0.f;
        { const bf16* yp = YS + (size_t)t * 1024 + cA; float a0[8], a1[8]; unpack8(__builtin_nontemporal_load((const GAS v4u*)yp), a0); unpack8(__builtin_nontemporal_load((const GAS v4u*)(yp + 128)), a1);
#pragma unroll
          for (int i = 0; i < 8; ++i) { ys[i] = a0[i]; ys[8 + i] = a1[i]; } }
#pragma unroll
        for (int k = 0; k < 8; ++k) { const v4u w = __builtin_nontemporal_load((const GAS v4u*)(Y8 + ((size_t)t * 8 + k) * 1024 + 16 * lane));
            const unsigned ww[4] = {w.x, w.y, w.z, w.w};
#pragma unroll
            for (int q = 0; q < 4; ++q) { const auto lo = __builtin_amdgcn_cvt_pk_f32_fp8((int)ww[q], false), hi = __builtin_amdgcn_cvt_pk_f32_fp8((int)ww[q], true);
                acc[4 * q + 0] += lo[0]; acc[4 * q + 1] += lo[1]; acc[4 * q + 2] += hi[0]; acc[4 * q + 3] += hi[1]; } }
        const float* g2 = modv + (size_t)(b * 6 + 5) * 1024;
        bf16* xb = XB + (size_t)t * 1024 + cA; bf16* xbo = dry ? (bf16*)(c.ws + WS_DRY0) + (size_t)t * 1024 + cA : xb; float* xr = OUT + (size_t)t * 1024; float ss = 0.f;
        float xv[16];
        { float a0[8], a1[8]; unpack8(__builtin_nontemporal_load((const GAS v4u*)xb), a0); unpack8(__builtin_nontemporal_load((const GAS v4u*)(xb + 128)), a1);
#pragma unroll
          for (int i = 0; i < 8; ++i) { xv[i] = a0[i]; xv[8 + i] = a1[i]; } }
#define COL(q) (cA + ((q) >> 1) * 128 + ((q) & 1) * 4)
#pragma unroll
        for (int q = 0; q < 4; ++q) { const f32x4 ga = *(const f32x4*)(g2 + COL(q));
            acc[4 * q + 0] = xv[4 * q + 0] + ga.x * (acc[4 * q + 0] * 0.0625f + ys[4 * q + 0]); acc[4 * q + 1] = xv[4 * q + 1] + ga.y * (acc[4 * q + 1] * 0.0625f + ys[4 * q + 1]);
            acc[4 * q + 2] = xv[4 * q + 2] + ga.z * (acc[4 * q + 2] * 0.0625f + ys[4 * q + 2]); acc[4 * q + 3] = xv[4 * q + 3] + ga.w * (acc[4 * q + 3] * 0.0625f + ys[4 * q + 3]);
            ss += (acc[4 * q] * acc[4 * q] + acc[4 * q + 1] * acc[4 * q + 1]) + (acc[4 * q + 2] * acc[4 * q + 2] + acc[4 * q + 3] * acc[4 * q + 3]); }
        const float rstd = 1.f / sqrtf(wave_sum(ss) * (1.f / D) + EPS);
        if (lastl) {
#pragma unroll
            for (int q = 0; q < 4; ++q) { const f32x4 na = *(const f32x4*)(gn + COL(q));
                *(GAS f32x4*)(xr + COL(q)) = (f32x4){acc[4 * q] * rstd * na.x, acc[4 * q + 1] * rstd * na.y, acc[4 * q + 2] * rstd * na.z, acc[4 * q + 3] * rstd * na.w}; }
        } else {
            const float* scp = modn + (size_t)(b * 6 + 1) * 1024; const float* shp = modn + (size_t)(b * 6 + 0) * 1024;
            float y[16];
#pragma unroll
            for (int q = 0; q < 4; ++q) { const f32x4 na = *(const f32x4*)(gn + COL(q)), sa = *(const f32x4*)(scp + COL(q)), ha = *(const f32x4*)(shp + COL(q));
                y[4 * q] = acc[4 * q] * rstd * na.x * (1.f + sa.x) + ha.x; y[4 * q + 1] = acc[4 * q + 1] * rstd * na.y * (1.f + sa.y) + ha.y;
                y[4 * q + 2] = acc[4 * q + 2] * rstd * na.z * (1.f + sa.z) + ha.z; y[4 * q + 3] = acc[4 * q + 3] * rstd * na.w * (1.f + sa.w) + ha.w; }
            *(GAS v4u*)xbo = (v4u){pk2(acc[0], acc[1]), pk2(acc[2], acc[3]), pk2(acc[4], acc[5]), pk2(acc[6], acc[7])};
            *(GAS v4u*)(xbo + 128) = (v4u){pk2(acc[8], acc[9]), pk2(acc[10], acc[11]), pk2(acc[12], acc[13]), pk2(acc[14], acc[15])};
            bf16* yo = (dry ? (bf16*)(c.ws + WS_DRY1) : YS) + (size_t)t * 1024 + cA;
            *(GAS v4u*)yo = (v4u){pk2(y[0], y[1]), pk2(y[2], y[3]), pk2(y[4], y[5]), pk2(y[6], y[7])};
            *(GAS v4u*)(yo + 128) = (v4u){pk2(y[8], y[9]), pk2(y[10], y[11]), pk2(y[12], y[13]), pk2(y[14], y[15])};
        }
#undef COL
    }
}

__device__ __forceinline__ void select_phase(const Ctx& c, int l, bool dry = false) {
    LAS int* lcnt = (LAS int*)c.lds; LAS int* lbase = lcnt + 256; LAS int* sel_e = lbase + 256; LAS int* sel_p = sel_e + 2048; LAS int* sel_w = sel_p + 2048;
    const float* LOG = (const float*)(c.ws + WS_LOGITS); const float* rb = kargs()->in[I_RB] + l * NE; int* LIST = (int*)(c.ws + (dry ? WS_Y : WS_LIST));
    unsigned* gcnt = (unsigned*)(c.ws + WS_CTL) + CW_GCNT + l * 512 + (dry ? 1024 : 0);
    const int lane = c.lane;
    for (int chunk = blockIdx.x; chunk < M / 256; chunk += c.G) {
        if (c.tid < 256) lcnt[c.tid] = 0;
        __syncthreads();
        const f32x4 rbv = *(const f32x4*)(rb + 4 * lane);
        f32x4 lgn[2];
#pragma unroll
        for (int u = 0; u < 2; ++u) lgn[u] = __builtin_nontemporal_load((const GAS f32x4*)(LOG + (size_t)(chunk * 256 + c.wave * 32 + u) * 256 + 4 * lane));
        for (int tt = 0; tt < 32; tt += 2) {
            float s[2][4], cv[2][4], myw[2], ssum[2]; int mye[2];
            f32x4 lgc[2] = {lgn[0], lgn[1]};
            if (tt + 2 < 32) {
#pragma unroll
                for (int u = 0; u < 2; ++u) lgn[u] = __builtin_nontemporal_load((const GAS f32x4*)(LOG + (size_t)(chunk * 256 + c.wave * 32 + tt + 2 + u) * 256 + 4 * lane)); }
#pragma unroll
            for (int u = 0; u < 2; ++u) {
                const f32x4 lg = lgc[u];
                s[u][0] = fast_sigmoid(lg.x); s[u][1] = fast_sigmoid(lg.y); s[u][2] = fast_sigmoid(lg.z); s[u][3] = fast_sigmoid(lg.w);
                cv[u][0] = s[u][0] + rbv.x; cv[u][1] = s[u][1] + rbv.y; cv[u][2] = s[u][2] + rbv.z; cv[u][3] = s[u][3] + rbv.w; myw[u] = 0.f; ssum[u] = 0.f; mye[u] = 0; }
            float m1[2], m2[2];
#pragma unroll
            for (int u = 0; u < 2; ++u) { const float a = fmaxf(cv[u][0], cv[u][1]), b = fminf(cv[u][0], cv[u][1]), cc = fmaxf(cv[u][2], cv[u][3]), d = fminf(cv[u][2], cv[u][3]); m1[u] = fmaxf(a, cc); m2[u] = fmaxf(fminf(a, cc), fmaxf(b, d)); }
#define TOP2_STEP(K) { _Pragma("unroll") for (int u = 0; u < 2; ++u) { const float o1 = dx<K>(m1[u]), o2 = dx<K>(m2[u]); const float n1 = fmaxf(m1[u], o1), n2 = fmaxf(fminf(m1[u], o1), fmaxf(m2[u], o2)); m1[u] = n1; m2[u] = n2; } }
            TOP2_STEP(0xB1) TOP2_STEP(0x4E) TOP2_STEP(0x141)
#undef TOP2_STEP
            unsigned key[2][4];
#pragma unroll
            for (int u = 0; u < 2; ++u) { const float gs = m1[u] + m2[u]; const int grp = lane >> 3; int rank = 0;
#pragma unroll
                for (int gp = 0; gp < 8; ++gp) { const float sg = __builtin_bit_cast(float, __builtin_amdgcn_readlane(__builtin_bit_cast(int, gs), gp * 8)); rank += (int)((sg > gs) | ((sg == gs) & (gp < grp))); }
                const bool drop = rank >= 4;
#pragma unroll
                for (int jj = 0; jj < 4; ++jj) { const unsigned b = __builtin_bit_cast(unsigned, cv[u][jj]); const unsigned ok = (b & 0x80000000u) ? ~b : (b | 0x80000000u);
                    key[u][jj] = drop ? 0u : ((ok & 0xFFFFFF00u) | (unsigned)(255 - (4 * lane + jj))); } }
#pragma unroll
            for (int k = 0; k < 8; ++k) {
                unsigned bk[2];
#pragma unroll
                for (int u = 0; u < 2; ++u) { const unsigned a = key[u][0] > key[u][1] ? key[u][0] : key[u][1], b = key[u][2] > key[u][3] ? key[u][2] : key[u][3]; bk[u] = a > b ? a : b; }
#define KMAX_STEP(K) { _Pragma("unroll") for (int u = 0; u < 2; ++u) { const unsigned o = (unsigned)dxi<K>((int)bk[u]); bk[u] = o > bk[u] ? o : bk[u]; } }
                KMAX_STEP(0xB1) KMAX_STEP(0x4E) KMAX_STEP(0x141) KMAX_STEP(0x140)
#undef KMAX_STEP
#pragma unroll
                for (int u = 0; u < 2; ++u) { const unsigned o = (unsigned)sxi<16>((int)bk[u]); bk[u] = o > bk[u] ? o : bk[u]; }
#pragma unroll
                for (int u = 0; u < 2; ++u) {
                    { auto rk = __builtin_amdgcn_permlane32_swap(bk[u], bk[u], false, false); bk[u] = rk[0] > rk[1] ? rk[0] : rk[1]; }
                    const unsigned best = (unsigned)__builtin_amdgcn_readfirstlane((int)bk[u]);
                    const int g = 255 - (int)(best & 0xFFu);
                    const int owner = g >> 2, slot = g & 3; float sc;
                    { const bool own = lane == owner; const float ssel = slot == 0 ? s[u][0] : slot == 1 ? s[u][1] : slot == 2 ? s[u][2] : s[u][3]; sc = own ? ssel : 0.f;
#pragma unroll
                      for (int jj = 0; jj < 4; ++jj) key[u][jj] = (key[u][jj] == best) ? 0u : key[u][jj]; }
                    sc = __builtin_bit_cast(float, __builtin_amdgcn_readlane(__builtin_bit_cast(int, sc), owner)); ssum[u] += sc;
                    { const bool me = lane == k; mye[u] = me ? g : mye[u]; myw[u] = me ? sc : myw[u]; } }
            }
#pragma unroll
            for (int u = 0; u < 2; ++u) { const int tl = c.wave * 32 + tt + u;
                if (lane < 8) { sel_w[tl * 8 + lane] = (int)(myw[u] / ssum[u] * 8191.f + 0.5f); const int p = __hip_atomic_fetch_add(&lcnt[mye[u]], 1, __ATOMIC_RELAXED, __HIP_MEMORY_SCOPE_WORKGROUP); sel_e[tl * 8 + lane] = mye[u]; sel_p[tl * 8 + lane] = p; } }
        }
        __syncthreads();
        if (c.tid < 256) lbase[c.tid] = (int)__hip_atomic_fetch_add(gcnt + c.tid, (unsigned)lcnt[c.tid], RLX_AGENT);
        __syncthreads();
        for (int i = c.tid; i < 2048; i += NTHREADS) { const int e = sel_e[i]; LIST[(size_t)e * LCAP + lbase[e] + sel_p[i]] = ((chunk * 2048 + i) << 13) | sel_w[i]; }
        __syncthreads();
    }
}

__device__ __forceinline__ void build_moe_tables(const Ctx& c, int l) {
    LAS int* cum = (LAS int*)(c.lds + TAB_OFF); LAS int* cnt = cum + 260;
    unsigned* gcnt = (unsigned*)(c.ws + WS_CTL) + CW_GCNT + l * 512;
    if (c.wave == 0) {
        int n[4], nb = 0;
#pragma unroll
        for (int i = 0; i < 4; ++i) { n[i] = (int)__hip_atomic_load(gcnt + 4 * c.lane + i, RLX_AGENT); cnt[4 * c.lane + i] = n[i]; nb += (n[i] + 255) >> 8; }
        int inc = nb;
#pragma unroll
        for (int off = 1; off < 64; off <<= 1) { const int o = __builtin_amdgcn_ds_bpermute((c.lane - off) << 2, inc); if (c.lane >= off) inc += o; }
        int run = inc - nb;
#pragma unroll
        for (int i = 0; i < 4; ++i) { cum[4 * c.lane + i] = run; run += (n[i] + 255) >> 8; }
        if (c.lane == 63) { cum[256] = run; cum[257] = run + M / 256; cnt[256] = M; }
    }
    __syncthreads();
}
constexpr int ULIST_OFF = LDSCTL_OFF + 4096, ULIST_MAX = 128;
constexpr int ETAB_OFF = LDSCTL_OFF + 8192;
template <bool SHARE> struct MoeOrderT {
    static constexpr bool SHARE_A = SHARE;
    const LAS int* cum; const LAS int* cnt; const LAS int* ulist; const int* LIST; int G, c, NT, total, nblk, nlist, nfull, rem; unsigned etab; bool use_tab;
    __device__ __forceinline__ bool locate(int i, int& blkidx, int& pnl) const {
        if constexpr (SHARE) {
            const int j = i >> 2;
            if (j < nfull) { blkidx = j * G + c; pnl = i & 3; return true; }
            if (j > nfull) return false;
            if (2 * rem <= G) { if ((i & 3) >= 2 || (c >> 1) >= rem) return false; blkidx = nfull * G + (c >> 1); pnl = (c & 1) * 2 + (i & 3); return true; }
            if (c >= rem) return false; blkidx = nfull * G + c; pnl = i & 3; return true; }
        else { const long L = (long)i * G + c; if (L >= total) return false; blkidx = (int)(L / NT); pnl = (int)(L % NT); return true; }
    }
    __device__ __forceinline__ void search(int blkidx, int pnl, pg8::Unit& u) const {
        int lo = 0, hi = 257;
#pragma unroll 1
        while (hi - lo > 1) { const int mid = (lo + hi) >> 1; const int cm = cum[mid]; if (cm <= blkidx) lo = mid; else hi = mid; }
        u.e = lo; u.blk = blkidx - cum[lo]; u.pm = blkidx; u.pn = lo * NT + pnl; const int left = cnt[lo] - u.blk * 256; u.rows = left < 256 ? left : 256;
    }
    __device__ __forceinline__ void init(const Ctx& cx, int NT_, bool use_tab_) {
        cum = (const LAS int*)(cx.lds + TAB_OFF); cnt = cum + 260; LIST = (const int*)(cx.ws + WS_LIST); G = cx.G; c = cx.vcu; NT = NT_; nblk = __builtin_amdgcn_readfirstlane(cum[257]); total = nblk * NT_; nfull = nblk / G; rem = nblk - nfull * G;
        ulist = (const LAS int*)(cx.lds + ULIST_OFF); etab = (unsigned)(uintptr_t)(cx.lds + ETAB_OFF); use_tab = use_tab_;
        int mine;
        if constexpr (SHARE) mine = nfull * 4 + (2 * rem <= G ? ((c >> 1) < rem ? 2 : 0) : (c < rem ? 4 : 0)); else mine = total > c ? (total - c + G - 1) / G : 0;
        nlist = mine < ULIST_MAX ? mine : ULIST_MAX;
        if (cx.tid < nlist) { pg8::Unit u; int bi, pl; locate(cx.tid, bi, pl); search(bi, pl, u); LAS int* w = (LAS int*)(cx.lds + ULIST_OFF) + cx.tid * 8; w[0] = u.e; w[1] = u.blk; w[2] = u.pm; w[3] = u.pn; w[4] = u.rows; }
        __syncthreads();
    }
    __device__ __forceinline__ bool next(int i, pg8::Unit& u) const {
        int bi, pl; if (!locate(i, bi, pl)) return false;
        if (i < nlist) { const LAS int* w = ulist + i * 8; u.e = __builtin_amdgcn_readfirstlane(w[0]); u.blk = __builtin_amdgcn_readfirstlane(w[1]); u.pm = __builtin_amdgcn_readfirstlane(w[2]); u.pn = __builtin_amdgcn_readfirstlane(w[3]); u.rows = __builtin_amdgcn_readfirstlane(w[4]); }
        else { search(bi, pl, u); u.e = __builtin_amdgcn_readfirstlane(u.e); u.blk = __builtin_amdgcn_readfirstlane(u.blk); u.pm = __builtin_amdgcn_readfirstlane(u.pm); u.pn = __builtin_amdgcn_readfirstlane(u.pn); u.rows = __builtin_amdgcn_readfirstlane(u.rows); }
        if constexpr (SHARE) u.slot = ((i >> 2) % 3) | ((i & 3) ? 0 : 256); else u.slot = i % 3;
        return true;
    }
    __device__ __forceinline__ void a_ready(const pg8::Unit& u) const {
        if (use_tab && u.e != NE && (!SHARE || (u.slot & 256))) { int t_ = threadIdx.x; asm volatile("" : "+v"(t_));
            if (__builtin_amdgcn_readfirstlane(t_ >> 6) == 0) sat::glds16(LIST + (size_t)u.e * LCAP + u.blk * 256 + (t_ & 63) * 4, (unsigned)__builtin_amdgcn_readfirstlane((int)(etab + (u.slot & 255) * 1024))); }
    }
    __device__ __forceinline__ void done(const pg8::Unit&) const {}
    __device__ __forceinline__ void offsets_raw(const pg8::Unit& u, unsigned (&raw)[2][2], int R0, int R1) const {
#pragma unroll
        for (int h = 0; h < 2; ++h) { const int r0 = h * 128 + R0, r1 = h * 128 + R1;
            if (u.e == NE) { raw[h][0] = (unsigned)(u.blk * 256 + r0) << 16; raw[h][1] = (unsigned)(u.blk * 256 + r1) << 16; }
            else { const int* lp = LIST + (size_t)u.e * LCAP + u.blk * 256; raw[h][0] = r0 < u.rows ? (unsigned)lp[r0] : 0u; raw[h][1] = r1 < u.rows ? (unsigned)lp[r1] : 0u; } }
    }
    __device__ __forceinline__ void offsets_fin(const unsigned (&raw)[2][2], unsigned (&v)[2][2], int C0, int C1) const {
#pragma unroll
        for (int h = 0; h < 2; ++h) { v[h][0] = (raw[h][0] >> 16) * 1024u + (unsigned)(C0 * 2); v[h][1] = (raw[h][1] >> 16) * 1024u + (unsigned)(C1 * 2); }
    }
    __device__ __forceinline__ void offsets(const pg8::Unit& u, unsigned (&v)[2][2], int R0, int C0, int R1, int C1) const {
#pragma unroll
        for (int h = 0; h < 2; ++h) {
            const int r0 = h * 128 + R0, r1 = h * 128 + R1;
            int t0, t1;
            if (u.e == NE) { t0 = u.blk * 256 + r0; t1 = u.blk * 256 + r1; }
            else { const int* lp = LIST + (size_t)u.e * LCAP + u.blk * 256; t0 = r0 < u.rows ? (int)((unsigned)lp[r0] >> 16) : 0; t1 = r1 < u.rows ? (int)((unsigned)lp[r1] >> 16) : 0; }
            v[h][0] = (unsigned)(t0 * 1024 + C0 * 2); v[h][1] = (unsigned)(t1 * 1024 + C1 * 2);
        }
    }
};
using MoeOrder = MoeOrderT<false>;
struct EpiE1 {
    static constexpr bool PERM = true, KSCALE = false;
    unsigned char* H;
    __device__ __forceinline__ void operator()(const pg8::f32x4 (&acc)[2][2][4][2], const pg8::Unit& u, int wr, int wc, int fr_, int fq_) const {
        int t_ = threadIdx.x; asm volatile("" : "+v"(t_)); const int fr = t_ & 15, fq = (t_ >> 4) & 3; (void)fr_; (void)fq_;
        const int pnl = u.pn & 1; const int col0 = pnl * 128 + wc * 32 + 8 * fq;
        constexpr float KX = -LOG2E / SC_W13, CI = SC_W13 * SC_W13 / SC_H;
#pragma unroll
        for (int ai = 0; ai < 2; ++ai)
#pragma unroll
            for (int m = 0; m < 4; ++m) { const int r = ai * 128 + wr * 64 + m * 16 + fr;
                const pg8::f32x4 a0 = acc[ai][0][m][0], a1 = acc[ai][0][m][1], b0 = acc[ai][1][m][0], b1 = acc[ai][1][m][1];
                const pg8::f32x4 x0 = a0 * KX, x1 = a1 * KX, t0 = a0 * b0, t1 = a1 * b1;
                pg8::f32x4 e0, e1;
#pragma unroll
                for (int i = 0; i < 4; ++i) { e0[i] = __builtin_amdgcn_exp2f(x0[i]); e1[i] = __builtin_amdgcn_exp2f(x1[i]); }
                const pg8::f32x4 d0 = e0 * CI + CI, d1 = e1 * CI + CI;
                pg8::f32x4 r0, r1;
#pragma unroll
                for (int i = 0; i < 4; ++i) { r0[i] = __builtin_amdgcn_rcpf(d0[i]); r1[i] = __builtin_amdgcn_rcpf(d1[i]); }
                const pg8::f32x4 h0 = t0 * r0, h1 = t1 * r1;
                *(GAS v2u*)(H + ((size_t)u.pm * 256 + r) * 256 + col0) = (v2u){pk4_fp8(h0[0], h0[1], h0[2], h0[3]), pk4_fp8(h1[0], h1[1], h1[2], h1[3])}; }
    }
};
struct EpiE2 {
    static constexpr bool PERM = true, KSCALE = false;
    unsigned char* Y8; bf16* YS; const LAS int* etab;
    __device__ __forceinline__ void operator()(const pg8::f32x4 (&acc)[2][2][4][2], const pg8::Unit& u, int wr, int wc, int fr_, int fq_) const {
        int t_ = threadIdx.x; asm volatile("" : "+v"(t_)); const int fr = t_ & 15, fq = (t_ >> 4) & 3; (void)fr_; (void)fq_;
        const int pnl = u.pn & 3; const int col0 = pnl * 256 + wc * 32 + 8 * fq;
#pragma unroll
        for (int ai = 0; ai < 2; ++ai)
#pragma unroll
            for (int m = 0; m < 4; ++m) { const int r = ai * 128 + wr * 64 + m * 16 + fr;
                if (r < u.rows) {
                    if (u.e == NE) { bf16* dst = YS + ((size_t)u.blk * 256 + r) * 1024;
#pragma unroll
                        for (int bj = 0; bj < 2; ++bj) { const pg8::f32x4 v0 = acc[ai][bj][m][0] * (1.f / (SC_W2 * SC_H)), v1 = acc[ai][bj][m][1] * (1.f / (SC_W2 * SC_H));
                            *(GAS v4u*)(dst + col0 + bj * 128) = (v4u){pg8::cvt_pk_bf16(v0[0], v0[1]), pg8::cvt_pk_bf16(v0[2], v0[3]), pg8::cvt_pk_bf16(v1[0], v1[1]), pg8::cvt_pk_bf16(v1[2], v1[3])}; }
                    } else { const unsigned ent = (unsigned)etab[(u.slot & 255) * 256 + r]; unsigned char* dst = Y8 + (size_t)(ent >> 13) * 1024; const float w = (float)(ent & 8191u) * (16.f * 2.5f / 8191.f / (SC_W2 * SC_H));
                        unsigned q[4];
#pragma unroll
                        for (int bj = 0; bj < 2; ++bj) { const pg8::f32x4 v0 = acc[ai][bj][m][0] * w, v1 = acc[ai][bj][m][1] * w;
                            int w0 = 0, w1 = 0; w0 = __builtin_amdgcn_cvt_pk_fp8_f32(v0[0], v0[1], w0, false); w0 = __builtin_amdgcn_cvt_pk_fp8_f32(v0[2], v0[3], w0, true);
                            w1 = __builtin_amdgcn_cvt_pk_fp8_f32(v1[0], v1[1], w1, false); w1 = __builtin_amdgcn_cvt_pk_fp8_f32(v1[2], v1[3], w1, true);
                            q[2 * bj] = (unsigned)w0; q[2 * bj + 1] = (unsigned)w1; }
                        __builtin_nontemporal_store((v4u){q[0], q[1], q[2], q[3]}, (GAS v4u*)(dst + pnl * 256 + wc * 64 + fq * 16));
                    }
                } }
    }
};
struct EpiInProj {
    static constexpr bool PERM = true, KSCALE = false;
    bf16 *PROJ, *VA, *QB, *KB, *VB;
    __device__ __forceinline__ void operator()(const pg8::f32x4 (&acc)[2][2][4][2], const pg8::Unit& u, int wr, int wc, int fr_, int fq_) const {
        int t_ = threadIdx.x; asm volatile("" : "+v"(t_)); const int fr = t_ & 15, fq = (t_ >> 4) & 3; (void)fr_; (void)fq_;
        const int row0 = u.pm * 256 + wr * 64 + fr;
#pragma unroll
        for (int bj = 0; bj < 2; ++bj) {
            const int cg = u.pn * 256 + bj * 128 + wc * 32;
            bf16* base; int pitch, cc; float sc = 1.f;
            if (cg < 512 || cg >= 1280) { base = PROJ; pitch = IN_WP; cc = cg; }
            else if (cg < 640) { base = VA; pitch = 128; cc = cg - 512; }
            else if (cg < 1024) { base = QB; pitch = 384; cc = cg - 640; sc = C2A; }
            else if (cg < 1152) { base = KB; pitch = 128; cc = cg - 1024; }
            else { base = VB; pitch = 128; cc = cg - 1152; }
#pragma unroll
            for (int ai = 0; ai < 2; ++ai)
#pragma unroll
                for (int m = 0; m < 4; ++m) { const pg8::f32x4 v0 = acc[ai][bj][m][0] * sc, v1 = acc[ai][bj][m][1] * sc;
                    *(GAS v4u*)(base + (size_t)(row0 + ai * 128 + m * 16) * pitch + cc + 8 * fq) = (v4u){pg8::cvt_pk_bf16(v0[0], v0[1]), pg8::cvt_pk_bf16(v0[2], v0[3]), pg8::cvt_pk_bf16(v1[0], v1[1]), pg8::cvt_pk_bf16(v1[2], v1[3])}; }
        }
    }
};
struct EpiCup {
    static constexpr bool PERM = false, KSCALE = false;
    bf16* QC; bf16* KC; bf16* VC; const float* TC; const float* TS;
    __device__ __forceinline__ void operator()(const pg8::f32x4 (&acc)[2][2][4][2], const pg8::Unit& u, int wr, int wc, int fr_, int fq_) const {
        int t_ = threadIdx.x; asm volatile("" : "+v"(t_)); const int fr = t_ & 15, fq = (t_ >> 4) & 3; (void)fr_; (void)fq_;
#pragma unroll
        for (int bj = 0; bj < 2; ++bj) {
            const int cg = u.pn * 256 + bj * 128 + wc * 32;
            if (cg >= 896) continue;
            const bool rope = cg < 384 && (cg % 96) == 64;
#pragma unroll
            for (int ai = 0; ai < 2; ++ai) {
                pg8::f32x4 cs[4], sn[4];
                if (rope) {
#pragma unroll
                    for (int m = 0; m < 4; ++m) { const int pos = (u.pm * 256 + ai * 128 + wr * 64 + m * 16 + fr) & (SEQ - 1); cs[m] = *(const pg8::f32x4*)(TC + pos * 16 + 4 * fq); sn[m] = *(const pg8::f32x4*)(TS + pos * 16 + 4 * fq); } }
#pragma unroll
                for (int m = 0; m < 4; ++m) { const int row = u.pm * 256 + ai * 128 + wr * 64 + m * 16 + fr;
                    pg8::f32x4 v0 = acc[ai][bj][m][0], v1 = acc[ai][bj][m][1];
                    bf16* dst;
                    if (cg < 384) {
                        if (rope) { const pg8::f32x4 x1 = v0, x2 = v1; v0 = x1 * cs[m] - x2 * sn[m]; v1 = x1 * sn[m] + x2 * cs[m]; }
                        v0 = v0 * C2C; v1 = v1 * C2C; dst = QC + (size_t)row * 384 + cg;
                    } else if (cg < 640) { const int j = cg - 384; dst = KC + (size_t)row * 384 + (j >> 6) * 96 + (j & 63); }
                    else dst = VC + (size_t)row * 256 + (cg - 640);
                    *(GAS v2u*)(dst + 4 * fq) = (v2u){pg8::cvt_pk_bf16(v0[0], v0[1]), pg8::cvt_pk_bf16(v0[2], v0[3])};
                    *(GAS v2u*)(dst + 16 + 4 * fq) = (v2u){pg8::cvt_pk_bf16(v1[0], v1[1]), pg8::cvt_pk_bf16(v1[2], v1[3])}; }
            }
        }
    }
};
constexpr int RS_OFF = LDSCTL_OFF + 4096;
template <bool SRC_F32> struct EpiOutT {
    static constexpr bool PERM = true, KSCALE = true; static constexpr int KS_MID = 3, KS_TOP = 6;
    const void* Xs; bf16* Xd; const float* modv; const LAS float* rs;
    __device__ __forceinline__ void kscale(pg8::f32x4 (&acc)[2][2][4][2], const pg8::Unit& u, int which, int wr) const {
        int t_ = threadIdx.x; asm volatile("" : "+v"(t_)); const int fr = t_ & 15;
#pragma unroll
        for (int ai = 0; ai < 2; ++ai)
#pragma unroll
            for (int m = 0; m < 4; ++m) { const float f = rs[(u.slot * 256 + ai * 128 + wr * 64 + m * 16 + fr) * 3 + which];
#pragma unroll
                for (int bj = 0; bj < 2; ++bj)
#pragma unroll
                    for (int n = 0; n < 2; ++n) acc[ai][bj][m][n] = acc[ai][bj][m][n] * f; }
    }
    __device__ __forceinline__ void operator()(const pg8::f32x4 (&acc)[2][2][4][2], const pg8::Unit& u, int wr, int wc, int fr_, int fq_) const {
        int t_ = threadIdx.x; asm volatile("" : "+v"(t_)); const int fr = t_ & 15, fq = (t_ >> 4) & 3; (void)fr_; (void)fq_;
        const int row0 = u.pm * 256 + wr * 64 + fr, col0 = u.pn * 256 + wc * 32 + 8 * fq; const int b = (u.pm * 256) >> 13;
        const float* g1 = modv + (size_t)(b * 6 + 2) * 1024 + col0;
        pg8::f32x4 gv[2][2];
#pragma unroll
        for (int bj = 0; bj < 2; ++bj)
#pragma unroll
            for (int n = 0; n < 2; ++n) gv[bj][n] = *(const pg8::f32x4*)(g1 + bj * 128 + n * 4);
#pragma unroll
        for (int am = 0; am < 4; ++am) {
            const int ai = am >> 1, mb = (am & 1) * 2;
            pg8::f32x4 x0[2][2], x1[2][2];
#pragma unroll
            for (int mm = 0; mm < 2; ++mm) { const int m = mb + mm; const size_t off = (size_t)(row0 + ai * 128 + m * 16) * 1024 + col0;
#pragma unroll
                for (int bj = 0; bj < 2; ++bj) {
                    if constexpr (SRC_F32) { const float* xp = (const float*)Xs + off + bj * 128; x0[mm][bj] = __builtin_nontemporal_load((const GAS pg8::f32x4*)xp); x1[mm][bj] = __builtin_nontemporal_load((const GAS pg8::f32x4*)(xp + 4)); }
                    else { const v4u w = *(const GAS v4u*)((const bf16*)Xs + off + bj * 128); x0[mm][bj] = (pg8::f32x4){bflo(w.x), bfhi(w.x), bflo(w.y), bfhi(w.y)}; x1[mm][bj] = (pg8::f32x4){bflo(w.z), bfhi(w.z), bflo(w.w), bfhi(w.w)}; } } }
#pragma unroll
            for (int mm = 0; mm < 2; ++mm) { const int m = mb + mm; const size_t off = (size_t)(row0 + ai * 128 + m * 16) * 1024 + col0;
                const float f3 = rs[(u.slot * 256 + ai * 128 + wr * 64 + m * 16 + fr) * 3 + 2];
#pragma unroll
                for (int bj = 0; bj < 2; ++bj) {
                    const pg8::f32x4 y0 = x0[mm][bj] + gv[bj][0] * (acc[ai][bj][m][0] * f3), y1 = x1[mm][bj] + gv[bj][1] * (acc[ai][bj][m][1] * f3);
                    *(GAS v4u*)(Xd + off + bj * 128) = (v4u){pg8::cvt_pk_bf16(y0[0], y0[1]), pg8::cvt_pk_bf16(y0[2], y0[3]), pg8::cvt_pk_bf16(y1[0], y1[1]), pg8::cvt_pk_bf16(y1[2], y1[3])}; } }
        }
    }
};

__device__ __forceinline__ void attention_phase(const Ctx& c, int l) {
    unsigned char* ws = c.ws;
    const bf16 *QA = (const bf16*)(ws + WS_QA), *KA = (const bf16*)(ws + WS_KA), *VA = (const bf16*)(ws + WS_VA), *QB = (const bf16*)(ws + WS_QB), *KB = (const bf16*)(ws + WS_KB), *VB = (const bf16*)(ws + WS_VB);
    const bf16 *QC = (const bf16*)(ws + WS_QC), *KC = (const bf16*)(ws + WS_KC), *VC = (const bf16*)(ws + WS_VC); unsigned char* MIX8 = ws + WS_MIX;
    const float* sink = kargs()->in[I_BSINK] + l * 6; float* SSQ = (float*)(c.ws + WS_SSQ);
    for (int rep_ = 0; rep_ < NREP(16); ++rep_)
    for (int L = c.vcu; L < NBATCH * 6 * 32; L += c.G) {
        const int qb = L & 31, ph = L >> 5, idx = (ph & 7) * 6 + (ph >> 3), b = idx / 6, hq = idx % 6, kvh = hq / 3; const size_t rb = (size_t)b * SEQ;
        tat::unit<8, 384, 128, 128, 1024, SC_MIXA>((const tat::bf16*)(QA + rb * 384 + hq * 64), (const tat::bf16*)(KA + rb * 128 + kvh * 64), (const tat::bf16*)(VA + rb * 128 + kvh * 64), MIX8 + rb * 1024 + hq * 64, SSQ + rb * 16 + hq, qb * 256, (LAS char*)c.lds,
            [&]() { if (rep_ == 0) { const int nA = (NBATCH * 6 * 32 - c.vcu + c.G - 1) / c.G, nC = (NBATCH * 4 * 32 - c.vcu + c.G - 1) / c.G; convert_experts_part(c, l, (L - c.vcu) / c.G, nA + nC); } });
    }
    for (int rep_ = 0; rep_ < NREP(17); ++rep_)
    for (int L = c.vcu; L < NBATCH * 4 * 32; L += c.G) {
        const int qb = L & 31, ph = L >> 5, idx = (ph & 7) * 4 + (ph >> 3), b = idx >> 2, h = idx & 3; const size_t rb = (size_t)b * SEQ;
        tat::unit96<8, 384, 384, 256, 1024, SC_MIXC>((const tat::bf16*)(QC + rb * 384 + h * 96), (const tat::bf16*)(KC + rb * 384 + h * 96), (const tat::bf16*)(VC + rb * 256 + h * 64), MIX8 + rb * 1024 + 768 + h * 64, SSQ + rb * 16 + 12 + h, qb * 256, (LAS char*)c.lds,
            [&]() { if (rep_ == 0) { const int nA = (NBATCH * 6 * 32 - c.vcu + c.G - 1) / c.G, nC = (NBATCH * 4 * 32 - c.vcu + c.G - 1) / c.G; convert_experts_part(c, l, nA + (L - c.vcu) / c.G, nA + nC); } });
    }
    for (int rep_ = 0; rep_ < NREP(18); ++rep_)
    for (int L = c.vcu; L < NBATCH * 6 * 32; L += c.G) {
        const int qb = L & 31, ph = L >> 5, idx = (ph & 7) * 6 + (ph >> 3), b = idx / 6, hq = idx % 6, kvh = hq / 3; const size_t rb = (size_t)b * SEQ;
        const int t_lo = (4 * qb - 2) < 0 ? 0 : 4 * qb - 2, t_hi = (4 * qb + 6) > SEQ / 64 ? SEQ / 64 : 4 * qb + 6;
        const float slope2 = exp2f(-8.f * (float)(hq + 1) / 6.f) * LOG2E, sink2 = sink[hq] * LOG2E;
        tat::unitB<8, 384, 128, 128, 1024, SC_MIXB>((const tat::bf16*)(QB + rb * 384 + hq * 64), (const tat::bf16*)(KB + rb * 128 + kvh * 64), (const tat::bf16*)(VB + rb * 128 + kvh * 64), MIX8 + rb * 1024 + 384 + hq * 64, SSQ + rb * 16 + 6 + hq, qb * 256, t_lo, t_hi - t_lo, slope2, sink2, (LAS char*)c.lds);
    }
}

__global__ void __launch_bounds__(NTHREADS, 2) mega_fwd(Args args) {
    extern __shared__ __attribute__((aligned(16))) unsigned char lds_raw[];
    Ctx c;
#define NEWCTX() do { int t_ = threadIdx.x; asm volatile("" : "+v"(t_)); c.lds = (LAS unsigned char*)lds_raw; c.ws = kargs()->ws; c.tid = t_; c.lane = t_ & 63; c.wave = __builtin_amdgcn_readfirstlane(t_ >> 6); \
        c.G = gridDim.x; { const int bx = blockIdx.x; c.vcu = (c.G % 8 == 0) ? (bx % 8) * (c.G / 8) + bx / 8 : bx; } c.gw = c.vcu * NWAVES + c.wave; c.NGW = c.G * NWAVES; } while (0)
    NEWCTX();
    unsigned char* ws = c.ws;
    for (int u = c.tid; u < (LDS_BYTES - LDSCTL_OFF) / 4; u += NTHREADS) ((LAS unsigned*)(c.lds + LDSCTL_OFF))[u] = 0u;
    __syncthreads();
    const int lo = kargs()->ph_lo, hi = kargs()->ph_hi;
    const bool multi = (hi - lo) > 1;
    XcdBarrier bar; bar.bar = (unsigned*)(ws + WS_CTL) + CW_BAR; bar.x = 0; bar.st = nullptr;
    if (multi) bar = xcd_barrier_post((unsigned*)(ws + WS_CTL) + CW_BAR, (volatile LAS unsigned*)(c.lds + MISC_OFF) + 8);
#ifndef PH_MASK
#define PH_MASK 0x7fff
#endif
#define HAS(p) (((PH_MASK) >> (p)) & 1)

#define IN(k) (lo <= (k) && (k) < hi)
#define SEAM(k) do { if (IN(k) && IN((k) + 1)) { XcdBarrier b2_ = bar; asm volatile("" : "+s"(b2_.bar)); xcd_barrier(b2_); } } while (0)

    if (HAS(13) && IN(0)) for (int rep_ = 0; rep_ < NREP(13); ++rep_) { NEWCTX(); prologue(c); __syncthreads(); } SEAM(0);

    for (int l = 0; l < DEPTH; ++l) {
        const int P = 1 + PH_PER_LAYER * l;
#define MODV_L ((const float*)(c.ws + WS_MODV) + (size_t)l * 8 * 6144)
        if (l == 0) {
        if (HAS(0) && IN(P + 0)) for (int rep_ = 0; rep_ < NREP(0); ++rep_) { NEWCTX(); norm_mod_rows<true>(c, kargs()->in[I_X], (bf16*)(c.ws + WS_XN), nullptr, kargs()->in[I_N1G], MODV_L, 0, 1); }
        SEAM(P + 0); }
        if (HAS(1) && IN(P + 1)) for (int rep_ = 0; rep_ < NREP(1); ++rep_) { NEWCTX(); pg8::Gemm g{(const bf16*)(c.ws + WS_XN), (const bf16*)(c.ws + WS_WIN) + (size_t)l * IN_WP * 1024, M, IN_WP, 1024}; pg8::StaticOrder S; S.init(M, IN_WP, c.G, (int)blockIdx.x);
            EpiInProj E{(bf16*)(c.ws + WS_PROJ), (bf16*)(c.ws + WS_VA), (bf16*)(c.ws + WS_QB), (bf16*)(c.ws + WS_KB), (bf16*)(c.ws + WS_VB)}; pg8::gemm_phase<EpiInProj, pg8::StaticOrder, true, false>(c.lds, g, S, E); }
        SEAM(P + 1);
        if (HAS(2) && IN(P + 2)) for (int rep_ = 0; rep_ < NREP(2); ++rep_) { NEWCTX(); qkv_prep_rows(c, l); }
        SEAM(P + 2);
        if (HAS(3) && IN(P + 3)) for (int rep_ = 0; rep_ < NREP(3); ++rep_) { NEWCTX(); pg8::Gemm g{(const bf16*)(c.ws + WS_CQK), (const bf16*)(c.ws + WS_WC) + (size_t)l * 1024 * 384, M, 1024, 384}; pg8::StaticOrder S; S.init(M, 1024, c.G, (int)blockIdx.x);
            EpiCup E{(bf16*)(c.ws + WS_QC), (bf16*)(c.ws + WS_KC), (bf16*)(c.ws + WS_VC), (const float*)(c.ws + WS_TABC), (const float*)(c.ws + WS_TABS)}; pg8::gemm_phase<EpiCup, pg8::StaticOrder, true, false>(c.lds, g, S, E); }
        SEAM(P + 3);
        if (HAS(4) && IN(P + 4)) for (int rep_ = 0; rep_ < NREP(4); ++rep_) { NEWCTX(); attention_phase(c, l); }
        SEAM(P + 4);
        if (HAS(6) && IN(P + 6)) { NEWCTX(); pg8::Gemm g{(const bf16*)(c.ws + WS_MIX), (const bf16*)(c.ws + WS_WOUT + (size_t)l * 1024 * 1024), M, 1024, 1024};     pg8::StaticOrder S; S.init(M, 1024, c.G, (int)blockIdx.x);
            { LAS float* rs = (LAS float*)(c.lds + RS_OFF); const float* SSQ = (const float*)(c.ws + WS_SSQ); pg8::Unit u;
              for (int i = 0; i < 4 && S.next(i, u); ++i) if (c.tid < 256) { const f32x4* sp = (const f32x4*)(SSQ + (size_t)(u.pm * 256 + c.tid) * 16); const f32x4 a0 = sp[0], a1 = sp[1], a2 = sp[2], a3 = sp[3];
                  const float sA = (a0.x + a0.y) + (a0.z + a0.w) + (a1.x + a1.y), sB = (a1.z + a1.w) + (a2.x + a2.y) + (a2.z + a2.w), sC = (a3.x + a3.y) + (a3.z + a3.w);
                  const float rA = 1.f / sqrtf(sA * (1.f / 384.f) + EPS), rB = 1.f / sqrtf(sB * (1.f / 384.f) + EPS), rC = 1.f / sqrtf(sC * (1.f / 256.f) + EPS);
                  LAS float* w = rs + (i * 256 + c.tid) * 3; w[0] = rA / rB * ((float)SC_MIXB / (float)SC_MIXA); w[1] = rB / rC * ((float)SC_MIXC / (float)SC_MIXB); w[2] = rC * (1.f / (SC_WO * (float)SC_MIXC)); }
              __syncthreads(); }
            if (l == 0) { EpiOutT<true> E{kargs()->in[I_X], (bf16*)(c.ws + WS_XB), MODV_L, (const LAS float*)(c.lds + RS_OFF)}; pg8::gemm_phase<EpiOutT<true>, pg8::StaticOrder, true, false, true>(c.lds, g, S, E); }
            else { EpiOutT<false> E{c.ws + WS_XB, (bf16*)(c.ws + WS_XB), MODV_L, (const LAS float*)(c.lds + RS_OFF)}; pg8::gemm_phase<EpiOutT<false>, pg8::StaticOrder, true, false, true>(c.lds, g, S, E); } }
        SEAM(P + 6);
        if (HAS(7) && IN(P + 7)) for (int rep_ = 0; rep_ < NREP(7); ++rep_) { NEWCTX(); norm2_rows(c, (const bf16*)(c.ws + WS_XB), (bf16*)(c.ws + WS_XN), c.ws + WS_U2F, kargs()->in[I_N2G] + l * 1024, MODV_L, 3, 4); }
        SEAM(P + 7);
        if (HAS(8) && IN(P + 8)) for (int rep_ = 0; rep_ < NREP(8); ++rep_) { NEWCTX(); pg8::Gemm g{(const bf16*)(c.ws + WS_XN), (const bf16*)(c.ws + WS_WR) + (size_t)l * 256 * 1024, M, 256, 1024}; pg8::StaticOrder S; S.init(M, 256, c.G, (int)blockIdx.x);
            pg8::EpiF32 E{(float*)(c.ws + WS_LOGITS), 256}; pg8::gemm_phase<pg8::EpiF32, pg8::StaticOrder, true, false>(c.lds, g, S, E); }
        SEAM(P + 8);
        if (HAS(9) && IN(P + 9)) for (int rep_ = 0; rep_ < NREP(9); ++rep_) { NEWCTX(); select_phase(c, l, DRY(9)); }
        SEAM(P + 9);
        if (HAS(10) && IN(P + 10)) for (int rep_ = 0; rep_ < NREP(10); ++rep_) { NEWCTX(); build_moe_tables(c, l); pg8::Gemm g{(const bf16*)(c.ws + WS_U2F), (const bf16*)(c.ws + WS_W13), M, NEX * 512, 1024}; MoeOrder S; S.init(c, 2, false);
            EpiE1 E{c.ws + WS_H}; pg8::gemm_phase<EpiE1, MoeOrder, true, true, true>(c.lds, g, S, E); }
        SEAM(P + 10);
        if (HAS(11) && IN(P + 11)) for (int rep_ = 0; rep_ < NREP(11); ++rep_) { NEWCTX(); build_moe_tables(c, l); pg8::Gemm g{(const bf16*)(c.ws + WS_H), (const bf16*)(c.ws + WS_W2), M, NEX * 1024, 256}; MoeOrderT<true> S; S.init(c, 4, true);
            EpiE2 E{(unsigned char*)(c.ws + WS_Y), (bf16*)(c.ws + WS_XN), (const LAS int*)(c.lds + ETAB_OFF)}; pg8::gemm_phase<EpiE2, MoeOrderT<true>, true, false, true>(c.lds, g, S, E); }
        SEAM(P + 11);
        if (HAS(12) && IN(P + 12)) for (int rep_ = 0; rep_ < NREP(12); ++rep_) { NEWCTX(); combine_rows(c, l, DRY(12)); }
        SEAM(P + 12);
    }
#undef MODV_L
#undef IN
#undef SEAM
}

#ifndef MK_ONE_LAUNCH
#define MK_ONE_LAUNCH 1
#endif
extern "C" void kernel_launch(void* const* d_in, const int* in_sizes, int n_in, void* d_out, int out_size, void* d_ws, size_t ws_size, hipStream_t stream) {
    static int grid = 0;
    if (grid == 0) {
        if (n_in != N_IN || out_size != M * D || ws_size < WS_SSQ + 4 * MiB) { fprintf(stderr, "kernel_launch: unexpected shapes (n_in %d, out %d, ws %zu)\n", n_in, out_size, ws_size); grid = -1; return; }
        int dev = 0, cus = 0, per_cu = 0;
        if (hipGetDevice(&dev) != hipSuccess || hipDeviceGetAttribute(&cus, hipDeviceAttributeMultiprocessorCount, dev) != hipSuccess) { grid = -1; return; }
        if (hipFuncSetAttribute((const void*)mega_fwd, hipFuncAttributeMaxDynamicSharedMemorySize, LDS_BYTES) != hipSuccess) { fprintf(stderr, "kernel_launch: hipFuncSetAttribute failed\n"); grid = -1; return; }
        if (hipOccupancyMaxActiveBlocksPerMultiprocessor(&per_cu, (const void*)mega_fwd, NTHREADS, LDS_BYTES) != hipSuccess || per_cu < 1) fprintf(stderr, "kernel_launch: occupancy query says %d\n", per_cu);
        (void)hipGetLastError();
        grid = cus;
    }
    if (grid < 0) return;
    if (hipMemsetAsync((char*)d_ws + WS_CTL, 0, CTL_ZERO_BYTES, stream) != hipSuccess) return;
    Args a{};
    for (int i = 0; i < N_IN; ++i) a.in[i] = (const float*)d_in[i];
    a.out = (float*)d_out; a.ws = (unsigned char*)d_ws;
#if MK_ONE_LAUNCH
    a.ph_lo = 0; a.ph_hi = N_PHASES;
    hipLaunchKernelGGL(mega_fwd, dim3(grid), dim3(NTHREADS), LDS_BYTES, stream, a);
#else
    for (int p = 0; p < N_PHASES; ++p) { a.ph_lo = p; a.ph_hi = p + 1; hipLaunchKernelGGL(mega_fwd, dim3(grid), dim3(NTHREADS), LDS_BYTES, stream, a); }
#endif
}
```

```cpp
#include <hip/hip_runtime.h>
#include <hip/hip_bf16.h>
#include <cstdio>
#include <cstdint>
#include <cmath>
namespace pg8 {
#define PG8_LAS __attribute__((address_space(3)))
typedef unsigned short bf16_t;
typedef short bf16x8 __attribute__((ext_vector_type(8)));
typedef float f32x4 __attribute__((ext_vector_type(4)));
typedef unsigned u32x4 __attribute__((ext_vector_type(4)));
typedef unsigned u32x2 __attribute__((ext_vector_type(2)));
typedef int i32x4 __attribute__((ext_vector_type(4)));
typedef int i32x8 __attribute__((ext_vector_type(8)));
constexpr int BM = 256, BK = 64, HALF = 128, HTB = HALF * BK * 2  , STAGE_BYTES = 8 * HTB, NXCD = 8, WGM = 8;

__host__ __device__ __forceinline__ int lds_byte(int r, int c) { const int st = (r >> 4) * 2 + (c >> 5), rr = r & 15, cc = c & 31, ob = rr * 64 + cc * 2; return st * 1024 + (ob ^ (((ob >> 9) & 1) << 5)); }
__host__ __device__ __forceinline__ void stage_rc(int b, int& R, int& C) { const int st = b / 1024, sb = b % 1024, swz = sb ^ (((sb >> 9) & 1) << 5); R = (st >> 1) * 16 + swz / 64; C = (st & 1) * 32 + (swz % 64) / 2; }
__host__ __device__ __forceinline__ int perm32(int rho) { const int n = rho >> 4, i = rho & 15; return 8 * (i >> 2) + 4 * n + (i & 3); }

struct Unit { int pm, pn; int e, blk, rows, slot; };
struct Gemm { const bf16_t* A; const bf16_t* Bt; int M, N, K; };

struct StaticOrder {
    static constexpr bool SHARE_A = false;
    int nM, nN, nwg, G, c;
    __host__ __device__ __forceinline__ void init(int M, int N, int G_, int c_) { nM = M / BM; nN = N / BM; nwg = nM * nN; G = G_; c = c_; }
    __host__ __device__ __forceinline__ bool next(int i, Unit& u) const {
        const long L = (long)i * G + c; if (L >= nwg) return false;
        int wgid = (int)L; { const int q = nwg / NXCD, r = nwg % NXCD, xcd = wgid % NXCD, off = wgid / NXCD; wgid = (xcd < r ? xcd * (q + 1) : r * (q + 1) + (xcd - r) * q) + off; }
        const int nig = WGM * nN, gid = wgid / nig, fm = gid * WGM, gsz = (nM - fm) < WGM ? (nM - fm) : WGM;
        u.pm = fm + ((wgid % nig) % gsz); u.pn = (wgid % nig) / gsz; u.e = 0; u.blk = 0; u.rows = BM; u.slot = i; return true;
    }
    __device__ __forceinline__ void a_ready(const Unit&) const {}
    __device__ __forceinline__ void done(const Unit&) const {}
    __device__ __forceinline__ void offsets(const Unit&, unsigned (&)[2][2], int, int, int, int) const {}
};

__device__ __forceinline__ unsigned cvt_pk_bf16(float lo, float hi) { unsigned r; asm volatile("v_cvt_pk_bf16_f32 %0, %1, %2" : "=v"(r) : "v"(lo), "v"(hi)); return r; }

struct EpiBf16 {
    static constexpr bool PERM = true, KSCALE = false;
    bf16_t* O; int ldc;
    __device__ __forceinline__ void operator()(const f32x4 (&acc)[2][2][4][2], const Unit& u, int wr, int wc, int fr, int fq) const {
        const int row0 = u.pm * BM + wr * 64 + fr; const int col0 = u.pn * BM + wc * 32 + 8 * fq;
#pragma unroll
        for (int ai = 0; ai < 2; ++ai)
#pragma unroll
            for (int m = 0; m < 4; ++m) { bf16_t* rowp = O + (size_t)(row0 + ai * HALF + m * 16) * ldc + col0;
#pragma unroll
                for (int bj = 0; bj < 2; ++bj) { const f32x4 v0 = acc[ai][bj][m][0], v1 = acc[ai][bj][m][1];
                    u32x4 w; w.x = cvt_pk_bf16(v0[0], v0[1]); w.y = cvt_pk_bf16(v0[2], v0[3]); w.z = cvt_pk_bf16(v1[0], v1[1]); w.w = cvt_pk_bf16(v1[2], v1[3]);
                    *(u32x4*)(rowp + bj * HALF) = w; } }
    }
};
struct EpiF32 {
    static constexpr bool PERM = false, KSCALE = false;
    float* C; int ldc;
    __device__ __forceinline__ void operator()(const f32x4 (&acc)[2][2][4][2], const Unit& u, int wr, int wc, int fr, int fq) const {
        const int row0 = u.pm * BM + wr * 64 + fr, col0 = u.pn * BM + wc * 32 + 4 * fq;
#pragma unroll
        for (int ai = 0; ai < 2; ++ai)
#pragma unroll
            for (int m = 0; m < 4; ++m) { float* rowp = C + (size_t)(row0 + ai * HALF + m * 16) * ldc + col0;
#pragma unroll
                for (int bj = 0; bj < 2; ++bj)
#pragma unroll
                    for (int n = 0; n < 2; ++n) *(f32x4*)(rowp + bj * HALF + n * 16) = acc[ai][bj][m][n]; }
    }
};

template <class Epi, class Sched, bool ALIGN_EPI = false, bool GATHER = false, bool FP8 = false>
__device__ __forceinline__ void gemm_phase(PG8_LAS unsigned char* lds, const Gemm g, const Sched& S, const Epi& E) {
    int tid_ = threadIdx.x; asm volatile("" : "+v"(tid_));
    const int tid = tid_, wid = __builtin_amdgcn_readfirstlane(tid >> 6), lane = tid & 63, wr = wid >> 2, wc = wid & 3, fr = lane & 15, fq = lane >> 4;
    const int K = g.K; const int rowB = FP8 ? K : 2 * K; const int nt = rowB / (2 * BK);
    const size_t kstep = (size_t)(BK * 2);
    const size_t hstep = (size_t)HALF * rowB;
    const size_t tstep = 2 * hstep;
    unsigned voffA[2], voffB[2]; unsigned vA[2][2], vAn[2][2]; int sR[2], sC[2];
#pragma unroll
    for (int i = 0; i < 2; ++i) { int R, C; stage_rc(tid * 16 + i * 8192, R, C); const int Rb = Epi::PERM ? ((R & ~31) + perm32(R & 31)) : R; sR[i] = R; sC[i] = C;
        voffA[i] = (unsigned)(R * rowB + C * 2); voffB[i] = (unsigned)(Rb * rowB + C * 2);
        vA[0][i] = 0u; vA[1][i] = 0u; vAn[0][i] = 0u; vAn[1][i] = 0u; }
    const size_t ahs = GATHER ? (size_t)0 : hstep;
    const unsigned lds0 = (unsigned)(uintptr_t)lds;
    const unsigned ldsw = (unsigned)wid * 1024u;
    const int aoff = lds_byte(wr * 64 + fr, fq * 8), boff = lds_byte(wc * 32 + fr, fq * 8);
#define PG8_SA(b, h) (((b) * 2 + (h)) * HTB)
#define PG8_SB(b, h) ((4 + (b) * 2 + (h)) * HTB)
#define PG8_GLDS(base_, voff_, ldsdst_) do { unsigned keep_; asm volatile("s_mov_b32 %0, m0\n\ts_mov_b32 m0, %3\n\ts_nop 0\n\tglobal_load_lds_dwordx4 %1, %2\n\ts_mov_b32 m0, %0" \
        : "=&s"(keep_) : "v"(voff_), "s"(base_), "s"(ldsdst_) : "memory"); } while (0)
#define PG8_STAGE(bufoff, gbase, voff) do { const char* gb_ = (const char*)(gbase); _Pragma("unroll") for (int _i = 0; _i < 2; ++_i) \
        PG8_GLDS(gb_, (voff)[_i], (unsigned)__builtin_amdgcn_readfirstlane((int)(lds0 + (unsigned)(bufoff) + ldsw + _i * 8192))); } while (0)
#define PG8_STAGE_A(bufoff, gbase, h, vg) do { if constexpr (GATHER) PG8_STAGE(bufoff, gbase, vg); else PG8_STAGE(bufoff, (gbase) + (h) * ahs, voffA); } while (0)
#define PG8_LDA(dst, b, h) do { _Pragma("unroll") for (int m = 0; m < 4; ++m) _Pragma("unroll") for (int k = 0; k < 2; ++k) dst[m][k] = *(const PG8_LAS bf16x8*)(lds + PG8_SA(b, h) + aoff + m * 2048 + k * 1024); } while (0)
#define PG8_LDB(dst, b, h) do { _Pragma("unroll") for (int n = 0; n < 2; ++n) _Pragma("unroll") for (int k = 0; k < 2; ++k) dst[n][k] = *(const PG8_LAS bf16x8*)(lds + PG8_SB(b, h) + boff + n * 2048 + k * 1024); } while (0)
#define PG8_CAT8(x) __builtin_shufflevector(__builtin_bit_cast(i32x4, (x)[0]), __builtin_bit_cast(i32x4, (x)[1]), 0, 1, 2, 3, 4, 5, 6, 7)
#define PG8_MMA(ai, bj, At, Bt) do { __builtin_amdgcn_s_setprio(1); _Pragma("unroll") for (int m = 0; m < 4; ++m) _Pragma("unroll") for (int n = 0; n < 2; ++n) { \
        if constexpr (FP8) {   \
            asm volatile("v_mfma_scale_f32_16x16x128_f8f6f4 %0, %1, %2, %0, %3, %3 op_sel_hi:[0,0,0]" : "+v"(acc[ai][bj][m][n]) : "v"(PG8_CAT8(Bt[n])), "v"(PG8_CAT8(At[m])), "v"(sc_one)); } \
        else { _Pragma("unroll") for (int k = 0; k < 2; ++k) acc[ai][bj][m][n] = __builtin_amdgcn_mfma_f32_16x16x32_bf16(Bt[n][k], At[m][k], acc[ai][bj][m][n], 0, 0, 0); } } \
        __builtin_amdgcn_s_setprio(0); } while (0)
#define PG8_WAIT_V(n) asm volatile("s_waitcnt vmcnt(" #n ")" ::: "memory")
#define PG8_WAIT_L(n) asm volatile("s_waitcnt lgkmcnt(" #n ")" ::: "memory")
#define PG8_BAR __builtin_amdgcn_s_barrier()
#define PG8_SCHED __builtin_amdgcn_sched_barrier(0)
    Unit cur, nxt; int ui = 0;
    constexpr bool SHARE = Sched::SHARE_A; bool cur_new = true, nxt_new = true;
    if (!S.next(0, cur)) return;
    f32x4 acc[2][2][4][2];
#pragma unroll
    for (int a = 0; a < 2; ++a)
#pragma unroll
        for (int b = 0; b < 2; ++b)
#pragma unroll
            for (int m = 0; m < 4; ++m)
#pragma unroll
                for (int n = 0; n < 2; ++n) acc[a][b][m][n] = (f32x4){0.f, 0.f, 0.f, 0.f};
    bf16x8 At[4][2], B0[2][2], B1[2][2];
    int sc_one = 0x7F7F7F7F; asm volatile("" : "+v"(sc_one));
    const char* cA = GATHER ? (const char*)g.A : (const char*)g.A + (size_t)cur.pm * tstep; const char* cB = (const char*)g.Bt + (size_t)cur.pn * tstep;
    if constexpr (GATHER) S.offsets(cur, vA, sR[0], sC[0], sR[1], sC[1]);
    S.a_ready(cur);
    Unit nn; bool has_next = false, has_nn = false; unsigned rawn[2][2] = {{0u, 0u}, {0u, 0u}};
    if constexpr (GATHER) { has_next = S.next(1, nxt); if (has_next) S.offsets_raw(nxt, rawn, sR[0], sR[1]); }
    PG8_STAGE(PG8_SB(0, 0), cB, voffB); PG8_STAGE(PG8_SB(0, 1), cB + hstep, voffB); PG8_STAGE_A(PG8_SA(0, 0), cA, 0, vA[0]); PG8_STAGE_A(PG8_SA(0, 1), cA, 1, vA[1]);
    if (wr == 1) PG8_BAR;
    PG8_WAIT_V(2); PG8_BAR;
    PG8_STAGE(PG8_SB(1, 0), cB + kstep, voffB); PG8_STAGE_A(PG8_SA(1, 0), cA + kstep, 0, vA[0]); PG8_STAGE(PG8_SB(1, 1), cB + hstep + kstep, voffB);
    PG8_WAIT_V(6); PG8_BAR;
    if constexpr (GATHER) { if (has_next) S.offsets_fin(rawn, vAn, sC[0], sC[1]); else { vAn[0][0] = vA[0][0]; vAn[0][1] = vA[0][1]; vAn[1][0] = vA[1][0]; vAn[1][1] = vA[1][1]; } }
    for (;;) {
        if constexpr (!GATHER) has_next = S.next(ui + 1, nxt);
        if constexpr (SHARE) nxt_new = !(has_next && nxt.pm == cur.pm);
        const char* nA = GATHER ? cA : (has_next ? (const char*)g.A + (size_t)nxt.pm * tstep : cA); const char* nB = has_next ? (const char*)g.Bt + (size_t)nxt.pn * tstep : cB;
        for (int t = 0; t < nt; t += 2) {
            const bool last = (t == nt - 2);
            const char* a1 = cA + (size_t)(t + 1) * kstep;
            const char* a2 = last ? nA : cA + (size_t)(t + 2) * kstep; const char* b2 = last ? nB : cB + (size_t)(t + 2) * kstep;
            const char* a3 = a2 + kstep; const char* b3 = b2 + kstep;
            unsigned w0[2], w1[2];
            if constexpr (GATHER) { w0[0] = last ? vAn[0][0] : vA[0][0]; w0[1] = last ? vAn[0][1] : vA[0][1]; w1[0] = last ? vAn[1][0] : vA[1][0]; w1[1] = last ? vAn[1][1] : vA[1][1]; }
            else { w0[0] = 0u; w0[1] = 0u; w1[0] = 0u; w1[1] = 0u; }
            if (last && has_next) S.a_ready(nxt);
            if constexpr (Epi::KSCALE) { if (t == Epi::KS_TOP) { if constexpr (FP8) asm volatile("s_nop 15\n\ts_nop 15" ::: "memory"); PG8_SCHED; E.kscale(acc, cur, 1, wr); PG8_SCHED; } }
            PG8_LDB(B0, 0, 0); PG8_LDB(B1, 0, 1); PG8_SCHED; PG8_LDA(At, 0, 0); if (!SHARE || cur_new) PG8_STAGE_A(PG8_SA(1, 1), a1, 1, vA[1]);
            if constexpr (SHARE) { if (cur_new) PG8_WAIT_V(8); } else PG8_WAIT_V(8);
            PG8_WAIT_L(0); PG8_BAR; PG8_MMA(0, 0, At, B0); PG8_MMA(0, 1, At, B1); PG8_BAR; PG8_SCHED;
            PG8_LDA(At, 0, 1); PG8_STAGE(PG8_SB(0, 0), b2, voffB); PG8_STAGE(PG8_SB(0, 1), b2 + hstep, voffB); if (!SHARE || nxt_new) PG8_STAGE_A(PG8_SA(0, 0), a2, 0, w0);
            if constexpr (SHARE) { if (cur_new && nxt_new) PG8_WAIT_V(8); else if (cur_new || nxt_new) PG8_WAIT_V(6); else PG8_WAIT_V(4); } else PG8_WAIT_V(8);
            PG8_WAIT_L(0); PG8_BAR; PG8_MMA(1, 0, At, B0); PG8_MMA(1, 1, At, B1); PG8_BAR; PG8_SCHED;
            if constexpr (Epi::KSCALE) { if (t + 1 == Epi::KS_MID) { if constexpr (FP8) asm volatile("s_nop 15\n\ts_nop 15" ::: "memory"); PG8_SCHED; E.kscale(acc, cur, 0, wr); PG8_SCHED; } }
            PG8_LDB(B0, 1, 0); PG8_LDB(B1, 1, 1); PG8_SCHED; PG8_LDA(At, 1, 0); if (!SHARE || nxt_new) PG8_STAGE_A(PG8_SA(0, 1), a2, 1, w1);
            if constexpr (SHARE) { if (cur_new) { if (nxt_new) PG8_WAIT_V(8); else PG8_WAIT_V(4); } } else PG8_WAIT_V(8);
            PG8_WAIT_L(0); PG8_BAR; PG8_MMA(0, 0, At, B0); PG8_MMA(0, 1, At, B1); PG8_BAR; PG8_SCHED;
            PG8_LDA(At, 1, 1); PG8_STAGE(PG8_SB(1, 0), b3, voffB); PG8_STAGE(PG8_SB(1, 1), b3 + hstep, voffB); if (!SHARE || nxt_new) PG8_STAGE_A(PG8_SA(1, 0), a3, 0, w0);
            if constexpr (SHARE) { if (nxt_new) PG8_WAIT_V(8); else PG8_WAIT_V(4); } else PG8_WAIT_V(8);
            PG8_WAIT_L(0); PG8_BAR; PG8_MMA(1, 0, At, B0); PG8_MMA(1, 1, At, B1); PG8_BAR; PG8_SCHED;
        }
        if constexpr (GATHER) { has_nn = has_next && S.next(ui + 2, nn); if (has_nn) S.offsets_raw(nn, rawn, sR[0], sR[1]); }
        if constexpr (ALIGN_EPI) { if (wr == 0) PG8_BAR; }
        if constexpr (FP8) { asm volatile("s_nop 15\n\ts_nop 15" ::: "memory"); PG8_SCHED; }
        E(acc, cur, wr, wc, fr, fq); S.done(cur);
        if (!has_next) break;
#pragma unroll
        for (int a = 0; a < 2; ++a)
#pragma unroll
            for (int b = 0; b < 2; ++b)
#pragma unroll
                for (int m = 0; m < 4; ++m)
#pragma unroll
                    for (int n = 0; n < 2; ++n) acc[a][b][m][n] = (f32x4){0.f, 0.f, 0.f, 0.f};
        cur = nxt; cA = nA; cB = nB; ++ui; if constexpr (SHARE) cur_new = nxt_new;
        if constexpr (GATHER) { vA[0][0] = vAn[0][0]; vA[0][1] = vAn[0][1]; vA[1][0] = vAn[1][0]; vA[1][1] = vAn[1][1]; if (has_nn) S.offsets_fin(rawn, vAn, sC[0], sC[1]); nxt = nn; has_next = has_nn; }
        if constexpr (ALIGN_EPI) { if (wr == 1) PG8_BAR; }
    }
    PG8_WAIT_V(0);
    if constexpr (!ALIGN_EPI) { if (wr == 0) PG8_BAR; }
    PG8_BAR;
#undef PG8_SA
#undef PG8_SB
#undef PG8_STAGE
#undef PG8_GLDS
#undef PG8_STAGE_A
#undef PG8_LDA
#undef PG8_LDB
#undef PG8_MMA
#undef PG8_CAT8
#undef PG8_WAIT_V
#undef PG8_WAIT_L
#undef PG8_BAR
#undef PG8_SCHED
}
}
namespace sat {
using bf16x8 = __attribute__((ext_vector_type(8))) short;
using s16x4 = __attribute__((ext_vector_type(4))) short;
using f32x16 = __attribute__((ext_vector_type(16))) float;
using u32x4 = __attribute__((ext_vector_type(4))) unsigned;
typedef unsigned short bf16_t;
#define SAT_LAS __attribute__((address_space(3)))
constexpr int KSLOT = 12288, VSLOT = 8192;
constexpr int L_K = 0, L_V = 2 * KSLOT, L_WS = L_V + 2 * VSLOT, L_OST = L_WS + 8 * 256, L_BYTES = L_OST + 8 * 4096;
__device__ __forceinline__ int crow(int r, int hi) { return (r & 3) + 8 * (r >> 2) + 4 * hi; }
__device__ __forceinline__ void glds16(const void* gsrc, unsigned lds_dst) { unsigned keep;
    asm volatile("s_mov_b32 %0, m0\n\ts_mov_b32 m0, %2\n\ts_nop 0\n\tglobal_load_lds_dwordx4 %1, off\n\ts_mov_b32 m0, %0" : "=&s"(keep) : "v"(gsrc), "s"(lds_dst) : "memory"); }
typedef float f32x2_t __attribute__((ext_vector_type(2))); typedef __bf16 bf16x2_t __attribute__((ext_vector_type(2)));
__device__ __forceinline__ unsigned cvtpk_s(float lo, float hi) { f32x2_t v = {lo, hi}; bf16x2_t b = __builtin_convertvector(v, bf16x2_t); return __builtin_bit_cast(unsigned, b); }
#define SAT_MX3(a, b, c) __builtin_fmaxf(__builtin_fmaxf((a), (b)), (c))
__device__ __forceinline__ float rowmax(const f32x16& p0, const f32x16& p1) {
    float a = SAT_MX3(p0[0], p0[1], p1[0]), b = SAT_MX3(p0[2], p0[3], p1[1]); a = SAT_MX3(a, p1[2], p1[3]);
#pragma unroll
    for (int r = 4; r < 16; r += 4) { a = SAT_MX3(a, p0[r], p0[r + 1]); b = SAT_MX3(b, p0[r + 2], p0[r + 3]); a = SAT_MX3(a, p1[r], p1[r + 1]); b = SAT_MX3(b, p1[r + 2], p1[r + 3]); }
    float m = __builtin_fmaxf(a, b); auto rr = __builtin_amdgcn_permlane32_swap(__float_as_uint(m), __float_as_uint(m), false, false);
    return __builtin_fmaxf(__uint_as_float(rr[0]), __uint_as_float(rr[1])); }
__device__ __forceinline__ void pv(f32x16* o, int vb, bf16x8 pa0, bf16x8 pa1, bf16x8 pa2, bf16x8 pa3) {
#pragma unroll
    for (int d0 = 0; d0 < 2; ++d0) { s16x4 lo[4], hi[4];
#pragma unroll
        for (int ks = 0; ks < 4; ++ks) {
            asm volatile("ds_read_b64_tr_b16 %0,%1 offset:%c2" : "=&v"(lo[ks]) : "v"(vb), "i"(d0 * 4096 + ks * 1024) : "memory");
            asm volatile("ds_read_b64_tr_b16 %0,%1 offset:%c2" : "=&v"(hi[ks]) : "v"(vb), "i"(d0 * 4096 + ks * 1024 + 512) : "memory"); }
        asm volatile("s_waitcnt lgkmcnt(0)" : "+v"(lo[0]), "+v"(lo[1]), "+v"(lo[2]), "+v"(lo[3]), "+v"(hi[0]), "+v"(hi[1]), "+v"(hi[2]), "+v"(hi[3]) :: "memory"); __builtin_amdgcn_sched_barrier(0);
#define SAT_PK(k) (bf16x8){lo[k][0], lo[k][1], lo[k][2], lo[k][3], hi[k][0], hi[k][1], hi[k][2], hi[k][3]}
        o[d0] = __builtin_amdgcn_mfma_f32_32x32x16_bf16(pa0, SAT_PK(0), o[d0], 0, 0, 0);
        o[d0] = __builtin_amdgcn_mfma_f32_32x32x16_bf16(pa1, SAT_PK(1), o[d0], 0, 0, 0);
        o[d0] = __builtin_amdgcn_mfma_f32_32x32x16_bf16(pa2, SAT_PK(2), o[d0], 0, 0, 0);
        o[d0] = __builtin_amdgcn_mfma_f32_32x32x16_bf16(pa3, SAT_PK(3), o[d0], 0, 0, 0);
#undef SAT_PK
    }
}
#define SAT_WAIT_BAR() asm volatile("s_waitcnt vmcnt(0) lgkmcnt(0)\n\ts_barrier" ::: "memory")

template <int DQK, int MODE>
__device__ __forceinline__ void unit(const bf16_t* Qp, int qpitch, const bf16_t* __restrict__ Kp, int kpitch, const bf16_t* __restrict__ Vp, int vpitch, bf16_t* Op, int opitch,
                                     int q0, int t_lo, int t_hi, float slope2, float sink2, SAT_LAS unsigned char* shm) {
    constexpr int NCH = DQK / 8, ND0 = DQK / 16;
    int tid_ = threadIdx.x; asm volatile("" : "+v"(tid_));
    const int tid = tid_, lane = tid & 63, r32 = lane & 31, hi = lane >> 5; const int wid = __builtin_amdgcn_readfirstlane(tid >> 6);
    const unsigned lds0 = (unsigned)(uintptr_t)shm;
    SAT_LAS float* wsf = (SAT_LAS float*)(shm + L_WS) + wid * 64;
    const bf16_t* ksrc = Kp + (size_t)lane * kpitch + wid * 8;
    const bf16_t* vsrc = Vp + (size_t)(16 * (wid & 3) + (lane >> 2)) * vpitch + (wid >> 2) * 32 + (lane & 3) * 8;
    const unsigned kdst = lds0 + L_K + wid * 1024, vdst = lds0 + L_V + wid * 1024;
#define SAT_DMA(t, bsel) do { glds16(ksrc + (size_t)(t) * 64 * kpitch, (unsigned)__builtin_amdgcn_readfirstlane(kdst + (bsel) * KSLOT)); \
        if (NCH > 8 && wid < NCH - 8) glds16(ksrc + (size_t)(t) * 64 * kpitch + 64, (unsigned)__builtin_amdgcn_readfirstlane(kdst + (bsel) * KSLOT + 8192)); \
        glds16(vsrc + (size_t)(t) * 64 * vpitch, (unsigned)__builtin_amdgcn_readfirstlane(vdst + (bsel) * VSLOT)); } while (0)
    const int vb0 = (int)(lds0 + L_V) + ((lane >> 4) & 1) * 32 + (lane & 3) * 8 + (4 * hi + ((lane & 15) >> 2)) * 64;
    SAT_DMA(t_lo, 0);
    bf16x8 qr[ND0];
    { const bf16_t* Qw = Qp + (size_t)(q0 + wid * 32 + r32) * qpitch + hi * 8;
#pragma unroll
      for (int d0 = 0; d0 < ND0; ++d0) qr[d0] = *reinterpret_cast<const bf16x8*>(Qw + d0 * 16); }
    float mhat = (MODE == 1) ? sink2 : -1e30f, l_reg = (MODE == 1 && hi == 0) ? 1.f : 0.f;
    f32x16 o[2]; o[0] = f32x16{}; o[1] = f32x16{};
    const int qrow = q0 + wid * 32 + r32;
    const int wlo = q0 + wid * 32 - 128, whi = q0 + wid * 32 + 31 + 128;
    SAT_WAIT_BAR();
    int bsel = 0;
    for (int t = t_lo; t < t_hi; ++t) {
        if (t + 1 < t_hi) SAT_DMA(t + 1, bsel ^ 1);
        const bool active = (MODE == 0) || (64 * t + 63 >= wlo && 64 * t <= whi);
        if (active) {
            const SAT_LAS unsigned char* kb = shm + L_K + bsel * KSLOT + hi * 1024 + r32 * 16;
            f32x16 p0 = f32x16{}, p1 = f32x16{};
#pragma unroll
            for (int d0 = 0; d0 < ND0; ++d0) {
                const bf16x8 b0 = *reinterpret_cast<const SAT_LAS bf16x8*>(kb + d0 * 2048);
                const bf16x8 b1 = *reinterpret_cast<const SAT_LAS bf16x8*>(kb + d0 * 2048 + 512);
                p0 = __builtin_amdgcn_mfma_f32_32x32x16_bf16(b0, qr[d0], p0, 0, 0, 0); p1 = __builtin_amdgcn_mfma_f32_32x32x16_bf16(b1, qr[d0], p1, 0, 0, 0); }
            if (MODE == 1) {
                const int kbase = 64 * t + 4 * hi - qrow;
#pragma unroll
                for (int r = 0; r < 16; ++r) { const int rel = kbase + (r & 3) + 8 * (r >> 2); const int d0_ = rel < 0 ? -rel : rel; const int rel1 = rel + 32; const int d1_ = rel1 < 0 ? -rel1 : rel1;
                    p0[r] = d0_ <= 128 ? p0[r] - slope2 * (float)d0_ : -INFINITY; p1[r] = d1_ <= 128 ? p1[r] - slope2 * (float)d1_ : -INFINITY; } }
            const float rm = rowmax(p0, p1);
            const float mnew = __builtin_fmaxf(mhat, rm); const float alpha = __builtin_amdgcn_exp2f(mhat - mnew); mhat = mnew;
            float psum = 0.f;
#pragma unroll
            for (int r = 0; r < 16; ++r) { p0[r] = __builtin_amdgcn_exp2f(p0[r] - mnew); p1[r] = __builtin_amdgcn_exp2f(p1[r] - mnew); psum += p0[r] + p1[r]; }
            l_reg = l_reg * alpha + psum;
            if (hi == 0) wsf[r32] = alpha;
            asm volatile("s_waitcnt lgkmcnt(0)" ::: "memory");
#pragma unroll
            for (int r = 0; r < 16; ++r) { const float f = wsf[crow(r, hi)]; o[0][r] *= f; o[1][r] *= f; }
            u32x4 pw0, pw1, pw2, pw3;
#define SAT_PKW(P, B) cvtpk_s(P[B], P[B + 1])
            pw0 = (u32x4){SAT_PKW(p0, 0), SAT_PKW(p0, 2), SAT_PKW(p0, 4), SAT_PKW(p0, 6)}; pw1 = (u32x4){SAT_PKW(p0, 8), SAT_PKW(p0, 10), SAT_PKW(p0, 12), SAT_PKW(p0, 14)};
            pw2 = (u32x4){SAT_PKW(p1, 0), SAT_PKW(p1, 2), SAT_PKW(p1, 4), SAT_PKW(p1, 6)}; pw3 = (u32x4){SAT_PKW(p1, 8), SAT_PKW(p1, 10), SAT_PKW(p1, 12), SAT_PKW(p1, 14)};
#undef SAT_PKW
            asm volatile("s_waitcnt lgkmcnt(0)" ::: "memory"); __builtin_amdgcn_sched_barrier(0);
            pv(o, vb0 + bsel * VSLOT, __builtin_bit_cast(bf16x8, pw0), __builtin_bit_cast(bf16x8, pw1), __builtin_bit_cast(bf16x8, pw2), __builtin_bit_cast(bf16x8, pw3));
        }
        SAT_WAIT_BAR();
        bsel ^= 1;
    }
    { auto rr = __builtin_amdgcn_permlane32_swap(__float_as_uint(l_reg), __float_as_uint(l_reg), false, false); l_reg = __uint_as_float(rr[0]) + __uint_as_float(rr[1]); }
    if (hi == 0) wsf[32 + r32] = l_reg; asm volatile("s_waitcnt lgkmcnt(0)" ::: "memory");
    float rli[16];
#pragma unroll
    for (int r = 0; r < 16; ++r) rli[r] = __builtin_amdgcn_rcpf(wsf[32 + crow(r, hi)]);
    bf16_t* Ow = Op + (size_t)(q0 + wid * 32) * opitch;
    { SAT_LAS bf16_t* stg = (SAT_LAS bf16_t*)(shm + L_OST) + wid * 2048;
#pragma unroll
      for (int r = 0; r < 16; ++r) { const int orow = crow(r, hi);
#pragma unroll
          for (int d0 = 0; d0 < 2; ++d0) stg[orow * 64 + d0 * 32 + r32] = (bf16_t)(cvtpk_s(o[d0][r] * rli[r], 0.f) & 0xffffu); }
      asm volatile("s_waitcnt lgkmcnt(0)" ::: "memory");
#pragma unroll
      for (int i = 0; i < 4; ++i) { const int row = i * 8 + (lane >> 3), ch = lane & 7; const u32x4 v = *(const SAT_LAS u32x4*)(stg + row * 64 + ch * 8); *(u32x4*)(Ow + (size_t)row * opitch + ch * 8) = v; } }
    asm volatile("s_waitcnt lgkmcnt(0)\n\ts_barrier" ::: "memory");
#undef SAT_DMA
}
}
namespace tat {
using bf16=__hip_bfloat16;
using bf16x8=__attribute__((ext_vector_type(8)))short;
using s16x4=__attribute__((ext_vector_type(4)))short;
using f32x16=__attribute__((ext_vector_type(16)))float;
using u32x4=__attribute__((ext_vector_type(4)))unsigned;
constexpr int SEQ=8192,D=64;
constexpr int NW=8,QBLK=32,QB=QBLK*NW,KVBLK=64,NQB=SEQ/QB;
__device__ __forceinline__ int crow(int r,int hi){return (r&3)+8*(r>>2)+4*hi;}
#define SBAR() __builtin_amdgcn_sched_barrier(0)
__device__ __forceinline__ void cmask(f32x16&p0,f32x16&p1,int jb,int qrel,int hi){
  const float NEG=-INFINITY; int kb=64*jb+4*hi;
  #pragma unroll
  for(int r=0;r<16;++r){int kv=kb+(r&3)+8*(r>>2); if(kv>qrel)p0[r]=NEG; if(kv+32>qrel)p1[r]=NEG;}
}

constexpr int NSLOT=3, SLOTB=8192;
constexpr int LDS_K=0, LDS_V=NSLOT*SLOTB, LDS_WS=2*NSLOT*SLOTB, LDS_OST=LDS_WS+NW*64*4, LDS_BYTES=LDS_OST+NW*4096;
constexpr float C2=0.125f*1.4426950408889634f;
__device__ __forceinline__ void glds16(const void*gsrc,unsigned lds_dst){unsigned keep;
  asm volatile("s_mov_b32 %0, m0\n\ts_mov_b32 m0, %2\n\ts_nop 0\n\tglobal_load_lds_dwordx4 %1, off\n\ts_mov_b32 m0, %0":"=&s"(keep):"v"(gsrc),"s"(lds_dst):"memory");}
__device__ __forceinline__ void glds16s(const void*sbase,unsigned voff,unsigned lds_dst){unsigned keep;
  asm volatile("s_mov_b32 %0, m0\n\ts_mov_b32 m0, %3\n\ts_nop 0\n\tglobal_load_lds_dwordx4 %1, %2\n\ts_mov_b32 m0, %0":"=&s"(keep):"v"(voff),"s"(sbase),"s"(lds_dst):"memory");}
__device__ __forceinline__ float max3f(float a,float b,float c){float r;asm("v_max3_f32 %0, %1, %2, %3":"=v"(r):"v"(a),"v"(b),"v"(c));return r;}
__device__ __forceinline__ float max2f(float a,float b){float r;asm("v_max_f32_e32 %0, %1, %2":"=v"(r):"v"(a),"v"(b));return r;}
__device__ __forceinline__ float fadd_s(float a,float b){float r;asm("v_add_f32_e32 %0, %1, %2":"=v"(r):"v"(a),"v"(b));return r;}
__device__ __forceinline__ float fsub_s(float a,float b){float r;asm("v_sub_f32_e32 %0, %1, %2":"=v"(r):"v"(a),"v"(b));return r;}
typedef float f32x2_t __attribute__((ext_vector_type(2))); typedef __bf16 bf16x2_t __attribute__((ext_vector_type(2)));
__device__ __forceinline__ unsigned cvtpk_s(float lo,float hi){f32x2_t v={lo,hi};bf16x2_t b=__builtin_convertvector(v,bf16x2_t);return __builtin_bit_cast(unsigned,b);}
#define WAIT_BAR(N) asm volatile("s_waitcnt vmcnt(" #N ") lgkmcnt(0)\n\ts_barrier":::"memory")

typedef __attribute__((address_space(3))) const char* lds_cptr;
template<int CTRL> __device__ __forceinline__ float dppf(float v){const int i=__builtin_bit_cast(int,v);return __builtin_bit_cast(float,__builtin_amdgcn_update_dpp(i,i,CTRL,0xF,0xF,false));}
__device__ __forceinline__ void qkt(f32x16&p0,f32x16&p1,lds_cptr Kslot,const bf16x8*qr,const f32x16&negm,int r32,int hi){
  const lds_cptr kb=Kslot+hi*1024+r32*16;
  #pragma unroll
  for(int d0=0;d0<4;++d0){
    const bf16x8 b0=*(const __attribute__((address_space(3))) bf16x8*)(kb+d0*2048);
    const bf16x8 b1=*(const __attribute__((address_space(3))) bf16x8*)(kb+d0*2048+512);
    if(d0==0){p0=__builtin_amdgcn_mfma_f32_32x32x16_bf16(b0,qr[0],negm,0,0,0);p1=__builtin_amdgcn_mfma_f32_32x32x16_bf16(b1,qr[0],negm,0,0,0);}
    else{p0=__builtin_amdgcn_mfma_f32_32x32x16_bf16(b0,qr[d0],p0,0,0,0);p1=__builtin_amdgcn_mfma_f32_32x32x16_bf16(b1,qr[d0],p1,0,0,0);}}
}
typedef short v4i16_t __attribute__((ext_vector_type(4)));
__device__ __forceinline__ void kload8(bf16x8*kf,lds_cptr kp){
  kf[0]=*(const __attribute__((address_space(3))) bf16x8*)(kp);      kf[1]=*(const __attribute__((address_space(3))) bf16x8*)(kp+512);
  kf[2]=*(const __attribute__((address_space(3))) bf16x8*)(kp+2048); kf[3]=*(const __attribute__((address_space(3))) bf16x8*)(kp+2560);
  kf[4]=*(const __attribute__((address_space(3))) bf16x8*)(kp+4096); kf[5]=*(const __attribute__((address_space(3))) bf16x8*)(kp+4608);
  kf[6]=*(const __attribute__((address_space(3))) bf16x8*)(kp+6144); kf[7]=*(const __attribute__((address_space(3))) bf16x8*)(kp+6656);
}
__device__ __forceinline__ void kload2(bf16x8*kf,lds_cptr kp,int j){ kf[2*j]=*(const __attribute__((address_space(3))) bf16x8*)(kp+j*2048); kf[2*j+1]=*(const __attribute__((address_space(3))) bf16x8*)(kp+j*2048+512); }
__device__ __forceinline__ s16x4 vtr(lds_cptr p){ return __builtin_bit_cast(s16x4,__builtin_amdgcn_ds_read_tr16_b64_v4i16((__attribute__((address_space(3))) v4i16_t*)p)); }
__device__ __forceinline__ float rowmax(const f32x16&p0,const f32x16&p1){
  float a=max3f(p0[0],p0[1],p1[0]),b=max3f(p0[2],p0[3],p1[1]);a=max3f(a,p1[2],p1[3]);
  #pragma unroll
  for(int r=4;r<16;r+=4){a=max3f(a,p0[r],p0[r+1]);b=max3f(b,p0[r+2],p0[r+3]);a=max3f(a,p1[r],p1[r+1]);b=max3f(b,p1[r+2],p1[r+3]);}
  const float m=max2f(a,b);
  auto rr=__builtin_amdgcn_permlane32_swap(__float_as_uint(m),__float_as_uint(m),false,false);
  return max2f(__uint_as_float(rr[0]),__uint_as_float(rr[1]));
}
__device__ __forceinline__ void pv(f32x16*o,int vb,bf16x8 pa0,bf16x8 pa1,bf16x8 pa2,bf16x8 pa3){
  #pragma unroll
  for(int d0=0;d0<2;++d0){s16x4 lo[4],hi[4];
    #pragma unroll
    for(int ks=0;ks<4;++ks){
      asm volatile("ds_read_b64_tr_b16 %0,%1 offset:%c2":"=&v"(lo[ks]):"v"(vb),"i"(d0*4096+ks*1024):"memory");
      asm volatile("ds_read_b64_tr_b16 %0,%1 offset:%c2":"=&v"(hi[ks]):"v"(vb),"i"(d0*4096+ks*1024+512):"memory");}
    asm volatile("s_waitcnt lgkmcnt(0)":::"memory");SBAR();
    #define PK(k) (bf16x8){lo[k][0],lo[k][1],lo[k][2],lo[k][3],hi[k][0],hi[k][1],hi[k][2],hi[k][3]}
    o[d0]=__builtin_amdgcn_mfma_f32_32x32x16_bf16(pa0,PK(0),o[d0],0,0,0);
    o[d0]=__builtin_amdgcn_mfma_f32_32x32x16_bf16(pa1,PK(1),o[d0],0,0,0);
    o[d0]=__builtin_amdgcn_mfma_f32_32x32x16_bf16(pa2,PK(2),o[d0],0,0,0);
    o[d0]=__builtin_amdgcn_mfma_f32_32x32x16_bf16(pa3,PK(3),o[d0],0,0,0);
    #undef PK
  }
}

typedef unsigned u32x2_t __attribute__((ext_vector_type(2)));
__device__ __forceinline__ unsigned pk4f8(float a,float b,float c,float d){int w=0;w=__builtin_amdgcn_cvt_pk_fp8_f32(a,b,w,false);w=__builtin_amdgcn_cvt_pk_fp8_f32(c,d,w,true);return (unsigned)w;}
__device__ __forceinline__ float clampf8(float x){return __builtin_fminf(__builtin_fmaxf(x,-448.f),448.f);}
template<int OSC> __device__ __forceinline__ void store8_f8(unsigned char*p,const u32x4&v){ float f[8];
  #pragma unroll
  for(int k=0;k<4;++k){f[2*k]=clampf8(__builtin_bit_cast(float,v[k]<<16)*(float)OSC);f[2*k+1]=clampf8(__builtin_bit_cast(float,v[k]&0xffff0000u)*(float)OSC);}
  *(u32x2_t*)p=(u32x2_t){pk4f8(f[0],f[1],f[2],f[3]),pk4f8(f[4],f[5],f[6],f[7])}; }
#ifndef ATTN_STORE16
#define ATTN_STORE16(p,v) (*(u32x4*)(p)=(v))
#endif
template<int THRL,int QP,int KP,int VP,int OP,int OSC,class Side> __device__ __forceinline__ void unit(const bf16*Qp,const bf16*__restrict__ Kp,const bf16*__restrict__ Vp,unsigned char*Op  ,float*ssq  ,int q0,__attribute__((address_space(3))) char*shm,const Side&side){
  int tid_=threadIdx.x; asm volatile("":"+v"(tid_));
  const int tid=tid_,lane=tid&63,r32=lane&31,hi=lane>>5; const int wid=__builtin_amdgcn_readfirstlane(tid>>6);
  const bf16*Qw=Qp+(long)(q0+wid*QBLK)*QP;
  const bf16*Kh=Kp,*Vh=Vp;
  const unsigned lds0=(unsigned)(uintptr_t)shm;
  __attribute__((address_space(3))) float*wsf=(__attribute__((address_space(3))) float*)(shm+LDS_WS)+wid*64;
  const unsigned koff=(unsigned)(lane*KP+wid*8)*2u;
  const unsigned voff=(unsigned)((16*(wid&3)+(lane>>2))*VP+(wid>>2)*32+(lane&3)*8)*2u;
  const unsigned kdst=lds0+LDS_K+wid*1024, vdst=lds0+LDS_V+wid*1024;
  #define DMA_K(t,slot) glds16s((const char*)Kh+(long)(t)*(KVBLK*KP*2),koff,(unsigned)__builtin_amdgcn_readfirstlane(kdst+(slot)))
  #define DMA_V(t,slot) glds16s((const char*)Vh+(long)(t)*(KVBLK*VP*2),voff,(unsigned)__builtin_amdgcn_readfirstlane(vdst+(slot)))
  const int vb0=(int)(lds0+LDS_V)+((lane>>4)&1)*32+(lane&3)*8+(4*hi+((lane&15)>>2))*64;
  const lds_cptr Kbase=(lds_cptr)shm+LDS_K; bf16x8 kf[8];
  const lds_cptr shm3=(lds_cptr)shm; const lds_cptr kp0=shm3+LDS_K+hi*1024+r32*16; const lds_cptr vp0=shm3+LDS_V+((lane>>4)&1)*32+(lane&3)*8+(4*hi+((lane&15)>>2))*64;
  constexpr int NT=SEQ/KVBLK;
  DMA_K(0,0);DMA_V(0,0);DMA_K(1,SLOTB);
  bf16x8 qr[4];
  #pragma unroll
  for(int d0=0;d0<4;++d0)qr[d0]=*reinterpret_cast<const bf16x8*>(&Qw[(long)r32*QP+d0*16+hi*8]);
  float mhat=0.f,l_reg=0.f;f32x16 o[2];o[0]=f32x16{};o[1]=f32x16{};f32x16 negm=f32x16{};asm volatile("":"+v"(negm));
  #define CMASK(P0,P1,t) do{}while(0)
  bool resc=false;
  #define START(P0,P1) do{ const float rm=rowmax(P0,P1); resc=false; \
    { const float dl=rm; mhat=fadd_s(mhat,dl); \
      _Pragma("unroll") for(int r=0;r<16;++r){P0[r]=fsub_s(P0[r],dl);P1[r]=fsub_s(P1[r],dl);} \
      _Pragma("unroll") for(int r=0;r<16;++r)negm[r]=-mhat; asm volatile("":"+v"(negm)); } \
    _Pragma("unroll") for(int r=0;r<16;++r)P0[r]=__builtin_amdgcn_exp2f(P0[r]); }while(0)
  #define RESC() do{ if(resc){ asm volatile("s_waitcnt lgkmcnt(0)":::"memory"); \
      _Pragma("unroll") for(int d_=0;d_<2;++d_) _Pragma("unroll") for(int r=0;r<16;++r)o[d_][r]*=wsf[crow(r,hi)]; } }while(0)
  f32x16 pA0,pA1,pB0,pB1;
  int sl_prev=0,sl_cur=0,sl_next=SLOTB;
  #define ROT() do{sl_prev=sl_cur;sl_cur=sl_next;sl_next=(sl_next==(NSLOT-1)*SLOTB)?0:sl_next+SLOTB;}while(0)
  DMA_K(2,2*SLOTB);
  side();
  WAIT_BAR(3);
  qkt(pA0,pA1,Kbase,qr,negm,r32,hi);asm volatile("s_nop 15\n\ts_nop 7":"+v"(pA0),"+v"(pA1));CMASK(pA0,pA1,0);
  START(pA0,pA1);
  _Pragma("unroll") for(int r=0;r<16;++r)pA1[r]=__builtin_amdgcn_exp2f(pA1[r]);
  WAIT_BAR(0);
  DMA_K(3,0);DMA_V(1,SLOTB);
  ROT();
  kload8(kf,kp0+sl_cur);
  WAIT_BAR(2);
  s16x4 vlo[8],vhi[8]; u32x4 pw0,pw1,pw2,pw3;
  #define PKW(P,B) cvtpk_s(P[B],P[B+1])
  #define PAF(k) __builtin_bit_cast(bf16x8,pw##k)
  #define VFR(i) (bf16x8){vlo[i][0],vlo[i][1],vlo[i][2],vlo[i][3],vhi[i][0],vhi[i][1],vhi[i][2],vhi[i][3]}
  #define PIN(x) asm volatile("":"+v"(x))
  #define MX3(a,b,c) __builtin_fmaxf(__builtin_fmaxf((a),(b)),(c))
  #define GAPA(MF,A0,A1,A2,A3,W0,W1,PW) do{ MF; sacc+=A0; sacc+=A1; sacc+=A2; sacc+=A3; PIN(sacc); W0; W1; PIN(PW); SBAR(); }while(0)
  #define EX(v) __builtin_amdgcn_exp2f(v)
  #define GAPB(MF,X,B) do{ MF; X[B]=EX(X[B]); X[B+1]=EX(X[B+1]); X[B+2]=EX(X[B+2]); X[B+3]=EX(X[B+3]); PIN(X); SBAR(); }while(0)
  #define VRD(i) do{ vlo[i]=vtr(vp_+(((i)>>2)*4096+((i)&3)*1024)); vhi[i]=vtr(vp_+(((i)>>2)*4096+((i)&3)*1024+512)); }while(0)
  #define KRD(G,j) do{ if(G){ kload2(kf,kp0+sl_next,j); SBAR(); } }while(0)
  #define STEP(C0,C1,P0,P1,t,GK,GV,GL) do{ SBAR(); \
    const lds_cptr vp_=vp0+sl_prev; \
    VRD(0); SBAR(); float sacc=(P0[0]+P0[1]); \
    GAPA(C0=__builtin_amdgcn_mfma_f32_32x32x16_bf16(kf[0],qr[0],negm,0,0,0), P0[2],P0[3],P0[4],P0[5],     pw0[0]=PKW(P0,0), pw0[1]=PKW(P0,2), pw0); \
    VRD(4); SBAR(); GAPA(C1=__builtin_amdgcn_mfma_f32_32x32x16_bf16(kf[1],qr[0],negm,0,0,0), P0[6],P0[7],P0[8],P0[9],     pw0[2]=PKW(P0,4), pw0[3]=PKW(P0,6), pw0); \
    VRD(1); SBAR(); GAPA(C0=__builtin_amdgcn_mfma_f32_32x32x16_bf16(kf[2],qr[1],C0,0,0,0),   P0[10],P0[11],P0[12],P0[13], pw1[0]=PKW(P0,8), pw1[1]=PKW(P0,10), pw1); \
    VRD(5); SBAR(); GAPA(C1=__builtin_amdgcn_mfma_f32_32x32x16_bf16(kf[3],qr[1],C1,0,0,0),   P0[14],P0[15],P1[0],P1[1],   pw1[2]=PKW(P0,12),pw1[3]=PKW(P0,14), pw1); \
    VRD(2); SBAR(); GAPA(C0=__builtin_amdgcn_mfma_f32_32x32x16_bf16(kf[4],qr[2],C0,0,0,0),   P1[2],P1[3],P1[4],P1[5],     pw2[0]=PKW(P1,0), pw2[1]=PKW(P1,2), pw2); \
    VRD(6); SBAR(); GAPA(C1=__builtin_amdgcn_mfma_f32_32x32x16_bf16(kf[5],qr[2],C1,0,0,0),   P1[6],P1[7],P1[8],P1[9],     pw2[2]=PKW(P1,4), pw2[3]=PKW(P1,6), pw2); \
    VRD(3); SBAR(); GAPA(C0=__builtin_amdgcn_mfma_f32_32x32x16_bf16(kf[6],qr[3],C0,0,0,0),   P1[10],P1[11],P1[12],P1[13], pw3[0]=PKW(P1,8), pw3[1]=PKW(P1,10), pw3); \
    VRD(7); SBAR(); GAPA(C1=__builtin_amdgcn_mfma_f32_32x32x16_bf16(kf[7],qr[3],C1,0,0,0),   P1[14],P1[15],0.f,0.f,       pw3[2]=PKW(P1,12),pw3[3]=PKW(P1,14), pw3); \
    l_reg+=sacc; \
    if(GK){DMA_K((t)+3,sl_cur);} if(GV){DMA_V((t)+1,sl_next);} \
    CMASK(C0,C1,t); \
    { float a=MX3(C0[0],C0[1],C1[0]),b=MX3(C0[2],C0[3],C1[1]); a=MX3(a,C1[2],C1[3]); \
      _Pragma("unroll") for(int r=4;r<16;r+=4){a=MX3(a,C0[r],C0[r+1]);b=MX3(b,C0[r+2],C0[r+3]);a=MX3(a,C1[r],C1[r+1]);b=MX3(b,C1[r+2],C1[r+3]);} \
      float rm=__builtin_fmaxf(a,b); { auto rr=__builtin_amdgcn_permlane32_swap(__float_as_uint(rm),__float_as_uint(rm),false,false); rm=__builtin_fmaxf(__uint_as_float(rr[0]),__uint_as_float(rr[1])); } \
      resc=false; \
      if(__builtin_expect(__any(rm>(float)THRL),0)){ const float dl=__builtin_fmaxf(rm,0.f); mhat+=dl; \
        _Pragma("unroll") for(int r=0;r<16;++r){C0[r]-=dl;C1[r]-=dl;} \
        _Pragma("unroll") for(int r=0;r<16;++r)negm[r]=-mhat; asm volatile("":"+v"(negm)); \
        const float f=__builtin_amdgcn_exp2f(-dl); l_reg*=f; if(hi==0)wsf[r32]=f; resc=true; } } \
    SBAR(); \
    GAPB(o[0]=__builtin_amdgcn_mfma_f32_32x32x16_bf16(PAF(0),VFR(0),o[0],0,0,0), C0,0); \
    GAPB(o[1]=__builtin_amdgcn_mfma_f32_32x32x16_bf16(PAF(0),VFR(4),o[1],0,0,0), C0,4); \
    KRD(GL,0); GAPB(o[0]=__builtin_amdgcn_mfma_f32_32x32x16_bf16(PAF(1),VFR(1),o[0],0,0,0), C0,8); \
    KRD(GL,1); GAPB(o[1]=__builtin_amdgcn_mfma_f32_32x32x16_bf16(PAF(1),VFR(5),o[1],0,0,0), C0,12); \
    KRD(GL,2); GAPB(o[0]=__builtin_amdgcn_mfma_f32_32x32x16_bf16(PAF(2),VFR(2),o[0],0,0,0), C1,0); \
    KRD(GL,3); GAPB(o[1]=__builtin_amdgcn_mfma_f32_32x32x16_bf16(PAF(2),VFR(6),o[1],0,0,0), C1,4); \
    GAPB(o[0]=__builtin_amdgcn_mfma_f32_32x32x16_bf16(PAF(3),VFR(3),o[0],0,0,0), C1,8); \
    GAPB(o[1]=__builtin_amdgcn_mfma_f32_32x32x16_bf16(PAF(3),VFR(7),o[1],0,0,0), C1,12); \
    }while(0)
  int t=1;
  #undef CMASK
  #define CMASK(P0,P1,t) do{}while(0)
  for(;t+5<NT;t+=2){
    STEP(pB0,pB1,pA0,pA1,t,true,true,true);     WAIT_BAR(2); RESC(); ROT();
    STEP(pA0,pA1,pB0,pB1,t+1,true,true,true);   WAIT_BAR(2); RESC(); ROT();
  }
  #undef CMASK
  #define CMASK(P0,P1,t) do{}while(0)
  #define ENDW(tt) do{ if((tt)+3<NT){WAIT_BAR(2);} else if((tt)+2<NT){WAIT_BAR(1);} else {WAIT_BAR(0);} }while(0)
  for(;t+1<NT;t+=2){
    STEP(pB0,pB1,pA0,pA1,t,(t+3<NT),(t+1<NT),(t+1<NT));       ENDW(t);   RESC(); ROT();
    STEP(pA0,pA1,pB0,pB1,t+1,(t+4<NT),(t+2<NT),(t+2<NT));     ENDW(t+1); RESC(); ROT();
  }
  STEP(pB0,pB1,pA0,pA1,NT-1,false,false,false); RESC();
  { float sacc=pB0[0]+pB0[1]; _Pragma("unroll") for(int r=2;r<16;++r)sacc+=pB0[r]; _Pragma("unroll") for(int r=0;r<16;++r)sacc+=pB1[r]; l_reg+=sacc;
    pw0=(u32x4){PKW(pB0,0),PKW(pB0,2),PKW(pB0,4),PKW(pB0,6)};pw1=(u32x4){PKW(pB0,8),PKW(pB0,10),PKW(pB0,12),PKW(pB0,14)};pw2=(u32x4){PKW(pB1,0),PKW(pB1,2),PKW(pB1,4),PKW(pB1,6)};pw3=(u32x4){PKW(pB1,8),PKW(pB1,10),PKW(pB1,12),PKW(pB1,14)};
    SBAR(); pv(o,vb0+sl_cur,PAF(0),PAF(1),PAF(2),PAF(3)); }
  #undef PKW
  #undef PAF
  #undef VFR
  #undef PIN
  #undef MX3
  #undef GAPA
  #undef GAPB
  #undef EX
  #undef VRD
  #undef KRD
  #undef STEP
  #undef ENDW
  {auto rr=__builtin_amdgcn_permlane32_swap(__float_as_uint(l_reg),__float_as_uint(l_reg),false,false);l_reg=__uint_as_float(rr[0])+__uint_as_float(rr[1]);}
  if(hi==0)wsf[32+r32]=l_reg;asm volatile("s_waitcnt lgkmcnt(0)":::"memory");
  float rli[16];
  #pragma unroll
  for(int r=0;r<16;++r)rli[r]=__builtin_amdgcn_rcpf(wsf[32+crow(r,hi)]);
  unsigned char*Ow=Op+(long)(q0+wid*QBLK)*OP; float*ssqw=ssq+(long)(q0+wid*QBLK)*16;
  { __attribute__((address_space(3))) unsigned short*stg=(__attribute__((address_space(3))) unsigned short*)(shm+LDS_OST)+wid*2048;
    #pragma unroll
    for(int r=0;r<16;++r){const int orow=crow(r,hi);
      #pragma unroll
      for(int d0=0;d0<2;++d0)stg[orow*64+d0*32+r32]=(unsigned short)(cvtpk_s(o[d0][r]*rli[r],0.f)&0xffffu);}
    asm volatile("s_waitcnt lgkmcnt(0)":::"memory");
    #pragma unroll
    for(int i=0;i<4;++i){const int row=i*8+(lane>>3),ch=lane&7; const u32x4 v=*(const __attribute__((address_space(3))) u32x4*)(stg+row*64+ch*8); store8_f8<OSC>(Ow+(long)row*OP+ch*8,v);
      float q_=0.f;
      #pragma unroll
      for(int k_=0;k_<4;++k_){const float lo_=__builtin_bit_cast(float,v[k_]<<16),hi_=__builtin_bit_cast(float,v[k_]&0xffff0000u); q_+=lo_*lo_+hi_*hi_;}
      q_+=dppf<0xB1>(q_); q_+=dppf<0x4E>(q_); q_+=dppf<0x141>(q_);
      if(ch==0) ssqw[(long)row*16]=q_; } }
  asm volatile("s_waitcnt lgkmcnt(0)\n\ts_barrier":::"memory");
  #undef DMA_K
  #undef DMA_V
  #undef CMASK
  #undef START
  #undef RESC
  #undef ROT
}

template<int THRL,int QP,int KP,int VP,int OP,int OSC> __device__ __forceinline__ void unitB(const bf16*Qp,const bf16*__restrict__ Kp,const bf16*__restrict__ Vp,unsigned char*Op  ,float*ssq  ,int q0,int t_lo,int NT,float slope2,float sink2,__attribute__((address_space(3))) char*shm){
  int tid_=threadIdx.x; asm volatile("":"+v"(tid_));
  const int tid=tid_,lane=tid&63,r32=lane&31,hi=lane>>5; const int wid=__builtin_amdgcn_readfirstlane(tid>>6);
  const bf16*Qw=Qp+(long)(q0+wid*QBLK)*QP;
  const bf16*Kh=Kp,*Vh=Vp;
  const unsigned lds0=(unsigned)(uintptr_t)shm;
  __attribute__((address_space(3))) float*wsf=(__attribute__((address_space(3))) float*)(shm+LDS_WS)+wid*64;
  const unsigned koff=(unsigned)(lane*KP+wid*8)*2u;
  const unsigned voff=(unsigned)((16*(wid&3)+(lane>>2))*VP+(wid>>2)*32+(lane&3)*8)*2u;
  const unsigned kdst=lds0+LDS_K+wid*1024, vdst=lds0+LDS_V+wid*1024;
  #define DMA_K(t,slot) glds16s((const char*)Kh+(long)(t_lo+(t))*(KVBLK*KP*2),koff,(unsigned)__builtin_amdgcn_readfirstlane(kdst+(slot)))
  #define DMA_V(t,slot) glds16s((const char*)Vh+(long)(t_lo+(t))*(KVBLK*VP*2),voff,(unsigned)__builtin_amdgcn_readfirstlane(vdst+(slot)))
  const int vb0=(int)(lds0+LDS_V)+((lane>>4)&1)*32+(lane&3)*8+(4*hi+((lane&15)>>2))*64;
  const lds_cptr Kbase=(lds_cptr)shm+LDS_K; bf16x8 kf[8];
  const lds_cptr shm3=(lds_cptr)shm; const lds_cptr kp0=shm3+LDS_K+hi*1024+r32*16; const lds_cptr vp0=shm3+LDS_V+((lane>>4)&1)*32+(lane&3)*8+(4*hi+((lane&15)>>2))*64;
  const int qrow=q0+wid*QBLK+r32;
  DMA_K(0,0);DMA_V(0,0);DMA_K(1,SLOTB);
  bf16x8 qr[4];
  #pragma unroll
  for(int d0=0;d0<4;++d0)qr[d0]=*reinterpret_cast<const bf16x8*>(&Qw[(long)r32*QP+d0*16+hi*8]);
  float mhat=0.f,l_reg=0.f;f32x16 o[2];o[0]=f32x16{};o[1]=f32x16{};f32x16 negm=f32x16{};asm volatile("":"+v"(negm));
  #define CMASK(P0,P1,t) do{ const float bl_=(float)(64*(t_lo+(t))+4*hi-qrow); _Pragma("unroll") for(int r=0;r<16;++r){ const float e0_=bl_+(float)((r&3)+8*(r>>2)), e1_=e0_+32.f; const float a0_=__builtin_fabsf(e0_), a1_=__builtin_fabsf(e1_); \
      P0[r]=(a0_<=128.f)?(P0[r]-slope2*a0_):-INFINITY; P1[r]=(a1_<=128.f)?(P1[r]-slope2*a1_):-INFINITY; } }while(0)
  bool resc=false;
  #define START(P0,P1) do{ const float rm=rowmax(P0,P1); resc=false; \
    { const float dl=__builtin_fmaxf(rm,-64.f); mhat=fadd_s(mhat,dl); \
      _Pragma("unroll") for(int r=0;r<16;++r){P0[r]=fsub_s(P0[r],dl);P1[r]=fsub_s(P1[r],dl);} \
      _Pragma("unroll") for(int r=0;r<16;++r)negm[r]=-mhat; asm volatile("":"+v"(negm)); } \
    _Pragma("unroll") for(int r=0;r<16;++r)P0[r]=__builtin_amdgcn_exp2f(P0[r]); }while(0)
  #define RESC() do{ if(resc){ asm volatile("s_waitcnt lgkmcnt(0)":::"memory"); \
      _Pragma("unroll") for(int d_=0;d_<2;++d_) _Pragma("unroll") for(int r=0;r<16;++r)o[d_][r]*=wsf[crow(r,hi)]; } }while(0)
  f32x16 pA0,pA1,pB0,pB1;
  int sl_prev=0,sl_cur=0,sl_next=SLOTB;
  #define ROT() do{sl_prev=sl_cur;sl_cur=sl_next;sl_next=(sl_next==(NSLOT-1)*SLOTB)?0:sl_next+SLOTB;}while(0)
  DMA_K(2,2*SLOTB);
  WAIT_BAR(3);
  qkt(pA0,pA1,Kbase,qr,negm,r32,hi);asm volatile("s_nop 15\n\ts_nop 7":"+v"(pA0),"+v"(pA1));CMASK(pA0,pA1,0);
  START(pA0,pA1);
  _Pragma("unroll") for(int r=0;r<16;++r)pA1[r]=__builtin_amdgcn_exp2f(pA1[r]);
  WAIT_BAR(0);
  DMA_K(3,0);DMA_V(1,SLOTB);
  ROT();
  kload8(kf,kp0+sl_cur);
  WAIT_BAR(2);
  s16x4 vlo[8],vhi[8]; u32x4 pw0,pw1,pw2,pw3;
  #define PKW(P,B) cvtpk_s(P[B],P[B+1])
  #define PAF(k) __builtin_bit_cast(bf16x8,pw##k)
  #define VFR(i) (bf16x8){vlo[i][0],vlo[i][1],vlo[i][2],vlo[i][3],vhi[i][0],vhi[i][1],vhi[i][2],vhi[i][3]}
  #define PIN(x) asm volatile("":"+v"(x))
  #define MX3(a,b,c) __builtin_fmaxf(__builtin_fmaxf((a),(b)),(c))
  #define GAPA(MF,A0,A1,A2,A3,W0,W1,PW) do{ MF; sacc+=A0; sacc+=A1; sacc+=A2; sacc+=A3; PIN(sacc); W0; W1; PIN(PW); SBAR(); }while(0)
  #define EX(v) __builtin_amdgcn_exp2f(v)
  #define GAPB(MF,X,B) do{ MF; X[B]=EX(X[B]); X[B+1]=EX(X[B+1]); X[B+2]=EX(X[B+2]); X[B+3]=EX(X[B+3]); PIN(X); SBAR(); }while(0)
  #define VRD(i) do{ vlo[i]=vtr(vp_+(((i)>>2)*4096+((i)&3)*1024)); vhi[i]=vtr(vp_+(((i)>>2)*4096+((i)&3)*1024+512)); }while(0)
  #define KRD(G,j) do{ if(G){ kload2(kf,kp0+sl_next,j); SBAR(); } }while(0)
  #define STEP(C0,C1,P0,P1,t,GK,GV,GL) do{ SBAR(); \
    const lds_cptr vp_=vp0+sl_prev; \
    VRD(0); SBAR(); float sacc=(P0[0]+P0[1]); \
    GAPA(C0=__builtin_amdgcn_mfma_f32_32x32x16_bf16(kf[0],qr[0],negm,0,0,0), P0[2],P0[3],P0[4],P0[5],     pw0[0]=PKW(P0,0), pw0[1]=PKW(P0,2), pw0); \
    VRD(4); SBAR(); GAPA(C1=__builtin_amdgcn_mfma_f32_32x32x16_bf16(kf[1],qr[0],negm,0,0,0), P0[6],P0[7],P0[8],P0[9],     pw0[2]=PKW(P0,4), pw0[3]=PKW(P0,6), pw0); \
    VRD(1); SBAR(); GAPA(C0=__builtin_amdgcn_mfma_f32_32x32x16_bf16(kf[2],qr[1],C0,0,0,0),   P0[10],P0[11],P0[12],P0[13], pw1[0]=PKW(P0,8), pw1[1]=PKW(P0,10), pw1); \
    VRD(5); SBAR(); GAPA(C1=__builtin_amdgcn_mfma_f32_32x32x16_bf16(kf[3],qr[1],C1,0,0,0),   P0[14],P0[15],P1[0],P1[1],   pw1[2]=PKW(P0,12),pw1[3]=PKW(P0,14), pw1); \
    VRD(2); SBAR(); GAPA(C0=__builtin_amdgcn_mfma_f32_32x32x16_bf16(kf[4],qr[2],C0,0,0,0),   P1[2],P1[3],P1[4],P1[5],     pw2[0]=PKW(P1,0), pw2[1]=PKW(P1,2), pw2); \
    VRD(6); SBAR(); GAPA(C1=__builtin_amdgcn_mfma_f32_32x32x16_bf16(kf[5],qr[2],C1,0,0,0),   P1[6],P1[7],P1[8],P1[9],     pw2[2]=PKW(P1,4), pw2[3]=PKW(P1,6), pw2); \
    VRD(3); SBAR(); GAPA(C0=__builtin_amdgcn_mfma_f32_32x32x16_bf16(kf[6],qr[3],C0,0,0,0),   P1[10],P1[11],P1[12],P1[13], pw3[0]=PKW(P1,8), pw3[1]=PKW(P1,10), pw3); \
    VRD(7); SBAR(); GAPA(C1=__builtin_amdgcn_mfma_f32_32x32x16_bf16(kf[7],qr[3],C1,0,0,0),   P1[14],P1[15],0.f,0.f,       pw3[2]=PKW(P1,12),pw3[3]=PKW(P1,14), pw3); \
    l_reg+=sacc; \
    if(GK){DMA_K((t)+3,sl_cur);} if(GV){DMA_V((t)+1,sl_next);} \
    CMASK(C0,C1,t); \
    { float a=MX3(C0[0],C0[1],C1[0]),b=MX3(C0[2],C0[3],C1[1]); a=MX3(a,C1[2],C1[3]); \
      _Pragma("unroll") for(int r=4;r<16;r+=4){a=MX3(a,C0[r],C0[r+1]);b=MX3(b,C0[r+2],C0[r+3]);a=MX3(a,C1[r],C1[r+1]);b=MX3(b,C1[r+2],C1[r+3]);} \
      float rm=__builtin_fmaxf(a,b); { auto rr=__builtin_amdgcn_permlane32_swap(__float_as_uint(rm),__float_as_uint(rm),false,false); rm=__builtin_fmaxf(__uint_as_float(rr[0]),__uint_as_float(rr[1])); } \
      resc=false; \
      if(__builtin_expect(__any(rm>(float)THRL),0)){ const float dl=__builtin_fmaxf(rm,0.f); mhat+=dl; \
        _Pragma("unroll") for(int r=0;r<16;++r){C0[r]-=dl;C1[r]-=dl;} \
        _Pragma("unroll") for(int r=0;r<16;++r)negm[r]=-mhat; asm volatile("":"+v"(negm)); \
        const float f=__builtin_amdgcn_exp2f(-dl); l_reg*=f; if(hi==0)wsf[r32]=f; resc=true; } } \
    SBAR(); \
    GAPB(o[0]=__builtin_amdgcn_mfma_f32_32x32x16_bf16(PAF(0),VFR(0),o[0],0,0,0), C0,0); \
    GAPB(o[1]=__builtin_amdgcn_mfma_f32_32x32x16_bf16(PAF(0),VFR(4),o[1],0,0,0), C0,4); \
    KRD(GL,0); GAPB(o[0]=__builtin_amdgcn_mfma_f32_32x32x16_bf16(PAF(1),VFR(1),o[0],0,0,0), C0,8); \
    KRD(GL,1); GAPB(o[1]=__builtin_amdgcn_mfma_f32_32x32x16_bf16(PAF(1),VFR(5),o[1],0,0,0), C0,12); \
    KRD(GL,2); GAPB(o[0]=__builtin_amdgcn_mfma_f32_32x32x16_bf16(PAF(2),VFR(2),o[0],0,0,0), C1,0); \
    KRD(GL,3); GAPB(o[1]=__builtin_amdgcn_mfma_f32_32x32x16_bf16(PAF(2),VFR(6),o[1],0,0,0), C1,4); \
    GAPB(o[0]=__builtin_amdgcn_mfma_f32_32x32x16_bf16(PAF(3),VFR(3),o[0],0,0,0), C1,8); \
    GAPB(o[1]=__builtin_amdgcn_mfma_f32_32x32x16_bf16(PAF(3),VFR(7),o[1],0,0,0), C1,12); \
    }while(0)
  int t=1;
  #undef CMASK
  #define CMASK(P0,P1,t) do{ const float bl_=(float)(64*(t_lo+(t))+4*hi-qrow); _Pragma("unroll") for(int r=0;r<16;++r){ const float e0_=bl_+(float)((r&3)+8*(r>>2)), e1_=e0_+32.f; const float a0_=__builtin_fabsf(e0_), a1_=__builtin_fabsf(e1_); \
      P0[r]=(a0_<=128.f)?(P0[r]-slope2*a0_):-INFINITY; P1[r]=(a1_<=128.f)?(P1[r]-slope2*a1_):-INFINITY; } }while(0)
  for(;t+5<NT;t+=2){
    STEP(pB0,pB1,pA0,pA1,t,true,true,true);     WAIT_BAR(2); RESC(); ROT();
    STEP(pA0,pA1,pB0,pB1,t+1,true,true,true);   WAIT_BAR(2); RESC(); ROT();
  }
  #undef CMASK
  #define CMASK(P0,P1,t) do{ const float bl_=(float)(64*(t_lo+(t))+4*hi-qrow); _Pragma("unroll") for(int r=0;r<16;++r){ const float e0_=bl_+(float)((r&3)+8*(r>>2)), e1_=e0_+32.f; const float a0_=__builtin_fabsf(e0_), a1_=__builtin_fabsf(e1_); \
      P0[r]=(a0_<=128.f)?(P0[r]-slope2*a0_):-INFINITY; P1[r]=(a1_<=128.f)?(P1[r]-slope2*a1_):-INFINITY; } }while(0)
  #define ENDW(tt) do{ if((tt)+3<NT){WAIT_BAR(2);} else if((tt)+2<NT){WAIT_BAR(1);} else {WAIT_BAR(0);} }while(0)
  for(;t+1<NT;t+=2){
    STEP(pB0,pB1,pA0,pA1,t,(t+3<NT),(t+1<NT),(t+1<NT));       ENDW(t);   RESC(); ROT();
    STEP(pA0,pA1,pB0,pB1,t+1,(t+4<NT),(t+2<NT),(t+2<NT));     ENDW(t+1); RESC(); ROT();
  }
  STEP(pB0,pB1,pA0,pA1,NT-1,false,false,false); RESC();
  { float sacc=pB0[0]+pB0[1]; _Pragma("unroll") for(int r=2;r<16;++r)sacc+=pB0[r]; _Pragma("unroll") for(int r=0;r<16;++r)sacc+=pB1[r]; l_reg+=sacc;
    pw0=(u32x4){PKW(pB0,0),PKW(pB0,2),PKW(pB0,4),PKW(pB0,6)};pw1=(u32x4){PKW(pB0,8),PKW(pB0,10),PKW(pB0,12),PKW(pB0,14)};pw2=(u32x4){PKW(pB1,0),PKW(pB1,2),PKW(pB1,4),PKW(pB1,6)};pw3=(u32x4){PKW(pB1,8),PKW(pB1,10),PKW(pB1,12),PKW(pB1,14)};
    SBAR(); pv(o,vb0+sl_cur,PAF(0),PAF(1),PAF(2),PAF(3)); }
  #undef PKW
  #undef PAF
  #undef VFR
  #undef PIN
  #undef MX3
  #undef GAPA
  #undef GAPB
  #undef EX
  #undef VRD
  #undef KRD
  #undef STEP
  #undef ENDW
  {auto rr=__builtin_amdgcn_permlane32_swap(__float_as_uint(l_reg),__float_as_uint(l_reg),false,false);l_reg=__uint_as_float(rr[0])+__uint_as_float(rr[1]);}
  l_reg+=__builtin_amdgcn_exp2f(sink2-mhat);
  if(hi==0)wsf[32+r32]=l_reg;asm volatile("s_waitcnt lgkmcnt(0)":::"memory");
  float rli[16];
  #pragma unroll
  for(int r=0;r<16;++r)rli[r]=__builtin_amdgcn_rcpf(wsf[32+crow(r,hi)]);
  unsigned char*Ow=Op+(long)(q0+wid*QBLK)*OP; float*ssqw=ssq+(long)(q0+wid*QBLK)*16;
  { __attribute__((address_space(3))) unsigned short*stg=(__attribute__((address_space(3))) unsigned short*)(shm+LDS_OST)+wid*2048;
    #pragma unroll
    for(int r=0;r<16;++r){const int orow=crow(r,hi);
      #pragma unroll
      for(int d0=0;d0<2;++d0)stg[orow*64+d0*32+r32]=(unsigned short)(cvtpk_s(o[d0][r]*rli[r],0.f)&0xffffu);}
    asm volatile("s_waitcnt lgkmcnt(0)":::"memory");
    #pragma unroll
    for(int i=0;i<4;++i){const int row=i*8+(lane>>3),ch=lane&7; const u32x4 v=*(const __attribute__((address_space(3))) u32x4*)(stg+row*64+ch*8); store8_f8<OSC>(Ow+(long)row*OP+ch*8,v);
      float q_=0.f;
      #pragma unroll
      for(int k_=0;k_<4;++k_){const float lo_=__builtin_bit_cast(float,v[k_]<<16),hi_=__builtin_bit_cast(float,v[k_]&0xffff0000u); q_+=lo_*lo_+hi_*hi_;}
      q_+=dppf<0xB1>(q_); q_+=dppf<0x4E>(q_); q_+=dppf<0x141>(q_);
      if(ch==0) ssqw[(long)row*16]=q_; } }
  asm volatile("s_waitcnt lgkmcnt(0)\n\ts_barrier":::"memory");
  #undef DMA_K
  #undef DMA_V
  #undef CMASK
  #undef START
  #undef RESC
  #undef ROT
}


__device__ __forceinline__ void qkt96(f32x16&p0,f32x16&p1,lds_cptr Kslot,const bf16x8*qr,const f32x16&negm,int r32,int hi){
  const lds_cptr kb=Kslot+hi*1024+r32*16;
  #pragma unroll
  for(int d0=0;d0<6;++d0){
    const bf16x8 b0=*(const __attribute__((address_space(3))) bf16x8*)(kb+d0*2048);
    const bf16x8 b1=*(const __attribute__((address_space(3))) bf16x8*)(kb+d0*2048+512);
    if(d0==0){p0=__builtin_amdgcn_mfma_f32_32x32x16_bf16(b0,qr[0],negm,0,0,0);p1=__builtin_amdgcn_mfma_f32_32x32x16_bf16(b1,qr[0],negm,0,0,0);}
    else{p0=__builtin_amdgcn_mfma_f32_32x32x16_bf16(b0,qr[d0],p0,0,0,0);p1=__builtin_amdgcn_mfma_f32_32x32x16_bf16(b1,qr[d0],p1,0,0,0);}}
}
__device__ __forceinline__ void kload12(bf16x8*kf,lds_cptr kp){
  #pragma unroll
  for(int j=0;j<6;++j){ kf[2*j]=*(const __attribute__((address_space(3))) bf16x8*)(kp+j*2048); kf[2*j+1]=*(const __attribute__((address_space(3))) bf16x8*)(kp+j*2048+512); }
}
template<int THRL,int QP,int KP,int VP,int OP,int OSC,class Side> __device__ __forceinline__ void unit96(const bf16*Qp,const bf16*__restrict__ Kp,const bf16*__restrict__ Vp,unsigned char*Op  ,float*ssq  ,int q0,__attribute__((address_space(3))) char*shm,const Side&side){
  int tid_=threadIdx.x; asm volatile("":"+v"(tid_));
  const int tid=tid_,lane=tid&63,r32=lane&31,hi=lane>>5; const int wid=__builtin_amdgcn_readfirstlane(tid>>6);
  const bf16*Qw=Qp+(long)(q0+wid*QBLK)*QP;
  const bf16*Kh=Kp,*Vh=Vp;
  constexpr int KSL=12288, L_K=0, L_V=3*KSL, L_WS=L_V+3*SLOTB, L_OST=L_WS+NW*64*4;
  const bool kx=wid<4;
  const unsigned lds0=(unsigned)(uintptr_t)shm;
  __attribute__((address_space(3))) float*wsf=(__attribute__((address_space(3))) float*)(shm+L_WS)+wid*64;
  const unsigned koff=(unsigned)(lane*KP+wid*8)*2u;
  const unsigned voff=(unsigned)((16*(wid&3)+(lane>>2))*VP+(wid>>2)*32+(lane&3)*8)*2u;
  const unsigned kdst=lds0+L_K+wid*1024, vdst=lds0+L_V+wid*1024;
  #define DMA_K(t,slot) do{ glds16s((const char*)Kh+(long)(t)*(KVBLK*KP*2),koff,(unsigned)__builtin_amdgcn_readfirstlane(kdst+(slot))); if(kx)glds16s((const char*)Kh+(long)(t)*(KVBLK*KP*2)+128,koff,(unsigned)__builtin_amdgcn_readfirstlane(kdst+(slot)+8192)); }while(0)
  #define DMA_V(t,slot) glds16s((const char*)Vh+(long)(t)*(KVBLK*VP*2),voff,(unsigned)__builtin_amdgcn_readfirstlane(vdst+(slot)))
  const int vb0=(int)(lds0+L_V)+((lane>>4)&1)*32+(lane&3)*8+(4*hi+((lane&15)>>2))*64;
  const lds_cptr Kbase=(lds_cptr)shm+L_K; bf16x8 kf[12];
  const lds_cptr shm3=(lds_cptr)shm; const lds_cptr kp0=shm3+L_K+hi*1024+r32*16; const lds_cptr vp0=shm3+L_V+((lane>>4)&1)*32+(lane&3)*8+(4*hi+((lane&15)>>2))*64;
  constexpr int NT=SEQ/KVBLK;
  DMA_K(0,0);DMA_V(0,0);DMA_K(1,KSL);
  bf16x8 qr[6];
  #pragma unroll
  for(int d0=0;d0<6;++d0)qr[d0]=*reinterpret_cast<const bf16x8*>(&Qw[(long)r32*QP+d0*16+hi*8]);
  float mhat=0.f,l_reg=0.f;f32x16 o[2];o[0]=f32x16{};o[1]=f32x16{};f32x16 negm=f32x16{};asm volatile("":"+v"(negm));
  #define CMASK(P0,P1,t) do{}while(0)
  bool resc=false;
  #define START(P0,P1) do{ const float rm=rowmax(P0,P1); resc=false; \
    { const float dl=rm; mhat=fadd_s(mhat,dl); \
      _Pragma("unroll") for(int r=0;r<16;++r){P0[r]=fsub_s(P0[r],dl);P1[r]=fsub_s(P1[r],dl);} \
      _Pragma("unroll") for(int r=0;r<16;++r)negm[r]=-mhat; asm volatile("":"+v"(negm)); } \
    _Pragma("unroll") for(int r=0;r<16;++r)P0[r]=__builtin_amdgcn_exp2f(P0[r]); }while(0)
  #define RESC() do{ if(resc){ asm volatile("s_waitcnt lgkmcnt(0)":::"memory"); \
      _Pragma("unroll") for(int d_=0;d_<2;++d_) _Pragma("unroll") for(int r=0;r<16;++r)o[d_][r]*=wsf[crow(r,hi)]; } }while(0)
  f32x16 pA0,pA1,pB0,pB1;
  int sl_prev=0,sl_cur=0,sl_next=SLOTB;
  int ks_cur=0,ks_next=KSL;
  #define ROT() do{sl_prev=sl_cur;sl_cur=sl_next;sl_next=(sl_next==(NSLOT-1)*SLOTB)?0:sl_next+SLOTB; ks_cur=ks_next;ks_next=(ks_next==(NSLOT-1)*KSL)?0:ks_next+KSL;}while(0)
  #define WB_KV() do{ if(kx){WAIT_BAR(3);}else{WAIT_BAR(2);} }while(0)
  DMA_K(2,2*KSL);
  side();
  WAIT_BAR(3);
  qkt96(pA0,pA1,Kbase,qr,negm,r32,hi);asm volatile("s_nop 15\n\ts_nop 7":"+v"(pA0),"+v"(pA1));CMASK(pA0,pA1,0);
  START(pA0,pA1);
  _Pragma("unroll") for(int r=0;r<16;++r)pA1[r]=__builtin_amdgcn_exp2f(pA1[r]);
  WAIT_BAR(0);
  DMA_K(3,0);DMA_V(1,SLOTB);
  ROT();
  kload12(kf,kp0+ks_cur);
  WB_KV();
  s16x4 vlo[8],vhi[8]; u32x4 pw0,pw1,pw2,pw3;
  #define PKW(P,B) cvtpk_s(P[B],P[B+1])
  #define PAF(k) __builtin_bit_cast(bf16x8,pw##k)
  #define VFR(i) (bf16x8){vlo[i][0],vlo[i][1],vlo[i][2],vlo[i][3],vhi[i][0],vhi[i][1],vhi[i][2],vhi[i][3]}
  #define PIN(x) asm volatile("":"+v"(x))
  #define MX3(a,b,c) __builtin_fmaxf(__builtin_fmaxf((a),(b)),(c))
  #define GAPA(MF,A0,A1,A2,A3,W0,W1,PW) do{ MF; sacc+=A0; sacc+=A1; sacc+=A2; sacc+=A3; PIN(sacc); W0; W1; PIN(PW); SBAR(); }while(0)
  #define EX(v) __builtin_amdgcn_exp2f(v)
  #define GAPB(MF,X,B) do{ MF; X[B]=EX(X[B]); X[B+1]=EX(X[B+1]); X[B+2]=EX(X[B+2]); X[B+3]=EX(X[B+3]); PIN(X); SBAR(); }while(0)
  #define VRD(i) do{ vlo[i]=vtr(vp_+(((i)>>2)*4096+((i)&3)*1024)); vhi[i]=vtr(vp_+(((i)>>2)*4096+((i)&3)*1024+512)); }while(0)
  #define KRD(G,j) do{ if(G){ kload2(kf,kp0+ks_next,j); SBAR(); } }while(0)
  #define STEP(C0,C1,P0,P1,t,GK,GV,GL) do{ SBAR(); \
    const lds_cptr vp_=vp0+sl_prev; \
    VRD(0); SBAR(); float sacc=(P0[0]+P0[1]); \
    GAPA(C0=__builtin_amdgcn_mfma_f32_32x32x16_bf16(kf[0],qr[0],negm,0,0,0), P0[2],P0[3],P0[4],P0[5],     pw0[0]=PKW(P0,0), pw0[1]=PKW(P0,2), pw0); \
    VRD(1); SBAR(); GAPA(C1=__builtin_amdgcn_mfma_f32_32x32x16_bf16(kf[1],qr[0],negm,0,0,0), P0[6],P0[7],P0[8],P0[9],     pw0[2]=PKW(P0,4), pw0[3]=PKW(P0,6), pw0); \
    VRD(2); SBAR(); GAPA(C0=__builtin_amdgcn_mfma_f32_32x32x16_bf16(kf[2],qr[1],C0,0,0,0),   P0[10],P0[11],P0[12],P0[13], pw1[0]=PKW(P0,8), pw1[1]=PKW(P0,10), pw1); \
    VRD(3); SBAR(); GAPA(C1=__builtin_amdgcn_mfma_f32_32x32x16_bf16(kf[3],qr[1],C1,0,0,0),   P0[14],P0[15],P1[0],P1[1],   pw1[2]=PKW(P0,12),pw1[3]=PKW(P0,14), pw1); \
    GAPA(C0=__builtin_amdgcn_mfma_f32_32x32x16_bf16(kf[4],qr[2],C0,0,0,0),   P1[2],P1[3],P1[4],P1[5],     pw2[0]=PKW(P1,0), pw2[1]=PKW(P1,2), pw2); \
    GAPA(C1=__builtin_amdgcn_mfma_f32_32x32x16_bf16(kf[5],qr[2],C1,0,0,0),   P1[6],P1[7],P1[8],P1[9],     pw2[2]=PKW(P1,4), pw2[3]=PKW(P1,6), pw2); \
    GAPA(C0=__builtin_amdgcn_mfma_f32_32x32x16_bf16(kf[6],qr[3],C0,0,0,0),   P1[10],P1[11],P1[12],P1[13], pw3[0]=PKW(P1,8), pw3[1]=PKW(P1,10), pw3); \
    GAPA(C1=__builtin_amdgcn_mfma_f32_32x32x16_bf16(kf[7],qr[3],C1,0,0,0),   P1[14],P1[15],0.f,0.f,       pw3[2]=PKW(P1,12),pw3[3]=PKW(P1,14), pw3); \
    VRD(4); SBAR(); C0=__builtin_amdgcn_mfma_f32_32x32x16_bf16(kf[8],qr[4],C0,0,0,0);  SBAR(); \
    VRD(5); SBAR(); C1=__builtin_amdgcn_mfma_f32_32x32x16_bf16(kf[9],qr[4],C1,0,0,0);  SBAR(); \
    VRD(6); SBAR(); C0=__builtin_amdgcn_mfma_f32_32x32x16_bf16(kf[10],qr[5],C0,0,0,0); SBAR(); \
    VRD(7); SBAR(); C1=__builtin_amdgcn_mfma_f32_32x32x16_bf16(kf[11],qr[5],C1,0,0,0); SBAR(); \
    l_reg+=sacc; \
    if(GK){DMA_K((t)+3,ks_cur);} if(GV){DMA_V((t)+1,sl_next);} \
    CMASK(C0,C1,t); \
    { float a=MX3(C0[0],C0[1],C1[0]),b=MX3(C0[2],C0[3],C1[1]); a=MX3(a,C1[2],C1[3]); \
      _Pragma("unroll") for(int r=4;r<16;r+=4){a=MX3(a,C0[r],C0[r+1]);b=MX3(b,C0[r+2],C0[r+3]);a=MX3(a,C1[r],C1[r+1]);b=MX3(b,C1[r+2],C1[r+3]);} \
      float rm=__builtin_fmaxf(a,b); { auto rr=__builtin_amdgcn_permlane32_swap(__float_as_uint(rm),__float_as_uint(rm),false,false); rm=__builtin_fmaxf(__uint_as_float(rr[0]),__uint_as_float(rr[1])); } \
      resc=false; \
      if(__builtin_expect(__any(rm>(float)THRL),0)){ const float dl=__builtin_fmaxf(rm,0.f); mhat+=dl; \
        _Pragma("unroll") for(int r=0;r<16;++r){C0[r]-=dl;C1[r]-=dl;} \
        _Pragma("unroll") for(int r=0;r<16;++r)negm[r]=-mhat; asm volatile("":"+v"(negm)); \
        const float f=__builtin_amdgcn_exp2f(-dl); l_reg*=f; if(hi==0)wsf[r32]=f; resc=true; } } \
    SBAR(); \
    GAPB(o[0]=__builtin_amdgcn_mfma_f32_32x32x16_bf16(PAF(0),VFR(0),o[0],0,0,0), C0,0); \
    GAPB(o[1]=__builtin_amdgcn_mfma_f32_32x32x16_bf16(PAF(0),VFR(4),o[1],0,0,0), C0,4); \
    KRD(GL,0); GAPB(o[0]=__builtin_amdgcn_mfma_f32_32x32x16_bf16(PAF(1),VFR(1),o[0],0,0,0), C0,8); \
    KRD(GL,1); GAPB(o[1]=__builtin_amdgcn_mfma_f32_32x32x16_bf16(PAF(1),VFR(5),o[1],0,0,0), C0,12); \
    KRD(GL,2); GAPB(o[0]=__builtin_amdgcn_mfma_f32_32x32x16_bf16(PAF(2),VFR(2),o[0],0,0,0), C1,0); \
    KRD(GL,3); GAPB(o[1]=__builtin_amdgcn_mfma_f32_32x32x16_bf16(PAF(2),VFR(6),o[1],0,0,0), C1,4); \
    KRD(GL,4); GAPB(o[0]=__builtin_amdgcn_mfma_f32_32x32x16_bf16(PAF(3),VFR(3),o[0],0,0,0), C1,8); \
    KRD(GL,5); GAPB(o[1]=__builtin_amdgcn_mfma_f32_32x32x16_bf16(PAF(3),VFR(7),o[1],0,0,0), C1,12); \
    }while(0)
  int t=1;
  #undef CMASK
  #define CMASK(P0,P1,t) do{}while(0)
  for(;t+5<NT;t+=2){
    STEP(pB0,pB1,pA0,pA1,t,true,true,true);     WB_KV(); RESC(); ROT();
    STEP(pA0,pA1,pB0,pB1,t+1,true,true,true);   WB_KV(); RESC(); ROT();
  }
  #undef CMASK
  #define CMASK(P0,P1,t) do{}while(0)
  #define ENDW(tt) do{ if((tt)+3<NT){WB_KV();} else if((tt)+2<NT){WAIT_BAR(1);} else {WAIT_BAR(0);} }while(0)
  for(;t+1<NT;t+=2){
    STEP(pB0,pB1,pA0,pA1,t,(t+3<NT),(t+1<NT),(t+1<NT));       ENDW(t);   RESC(); ROT();
    STEP(pA0,pA1,pB0,pB1,t+1,(t+4<NT),(t+2<NT),(t+2<NT));     ENDW(t+1); RESC(); ROT();
  }
  STEP(pB0,pB1,pA0,pA1,NT-1,false,false,false); RESC();
  { float sacc=pB0[0]+pB0[1]; _Pragma("unroll") for(int r=2;r<16;++r)sacc+=pB0[r]; _Pragma("unroll") for(int r=0;r<16;++r)sacc+=pB1[r]; l_reg+=sacc;
    pw0=(u32x4){PKW(pB0,0),PKW(pB0,2),PKW(pB0,4),PKW(pB0,6)};pw1=(u32x4){PKW(pB0,8),PKW(pB0,10),PKW(pB0,12),PKW(pB0,14)};pw2=(u32x4){PKW(pB1,0),PKW(pB1,2),PKW(pB1,4),PKW(pB1,6)};pw3=(u32x4){PKW(pB1,8),PKW(pB1,10),PKW(pB1,12),PKW(pB1,14)};
    SBAR(); pv(o,vb0+sl_cur,PAF(0),PAF(1),PAF(2),PAF(3)); }
  #undef PKW
  #undef PAF
  #undef VFR
  #undef PIN
  #undef MX3
  #undef GAPA
  #undef GAPB
  #undef EX
  #undef VRD
  #undef KRD
  #undef STEP
  #undef ENDW
  {auto rr=__builtin_amdgcn_permlane32_swap(__float_as_uint(l_reg),__float_as_uint(l_reg),false,false);l_reg=__uint_as_float(rr[0])+__uint_as_float(rr[1]);}
  if(hi==0)wsf[32+r32]=l_reg;asm volatile("s_waitcnt lgkmcnt(0)":::"memory");
  float rli[16];
  #pragma unroll
  for(int r=0;r<16;++r)rli[r]=__builtin_amdgcn_rcpf(wsf[32+crow(r,hi)]);
  unsigned char*Ow=Op+(long)(q0+wid*QBLK)*OP; float*ssqw=ssq+(long)(q0+wid*QBLK)*16;
  { __attribute__((address_space(3))) unsigned short*stg=(__attribute__((address_space(3))) unsigned short*)(shm+L_OST)+wid*2048;
    #pragma unroll
    for(int r=0;r<16;++r){const int orow=crow(r,hi);
      #pragma unroll
      for(int d0=0;d0<2;++d0)stg[orow*64+d0*32+r32]=(unsigned short)(cvtpk_s(o[d0][r]*rli[r],0.f)&0xffffu);}
    asm volatile("s_waitcnt lgkmcnt(0)":::"memory");
    #pragma unroll
    for(int i=0;i<4;++i){const int row=i*8+(lane>>3),ch=lane&7; const u32x4 v=*(const __attribute__((address_space(3))) u32x4*)(stg+row*64+ch*8); store8_f8<OSC>(Ow+(long)row*OP+ch*8,v);
      float q_=0.f;
      #pragma unroll
      for(int k_=0;k_<4;++k_){const float lo_=__builtin_bit_cast(float,v[k_]<<16),hi_=__builtin_bit_cast(float,v[k_]&0xffff0000u); q_+=lo_*lo_+hi_*hi_;}
      q_+=dppf<0xB1>(q_); q_+=dppf<0x4E>(q_); q_+=dppf<0x141>(q_);
      if(ch==0) ssqw[(long)row*16]=q_; } }
  asm volatile("s_waitcnt lgkmcnt(0)\n\ts_barrier":::"memory");
  #undef DMA_K
  #undef DMA_V
  #undef CMASK
  #undef START
  #undef RESC
  #undef ROT
  #undef WB_KV
}

#undef SBAR
#undef WAIT_BAR
}
constexpr int D = 1024, NBATCH = 8, SEQ = 8192, M = NBATCH * SEQ, DEPTH = 2;
constexpr int IN_W = 1696, IN_WP = 1792;
constexpr int NE = 256, NEX = 257, TOPK = 8;
constexpr int LCAP = 65536;
constexpr float EPS = 1e-6f;
constexpr float LOG2E = 1.4426950408889634f;
constexpr float C2A = 0.125f * LOG2E;
constexpr float C2C = 0.10206207261596575f * LOG2E;
constexpr int NWAVES = 8, NTHREADS = 512;

constexpr size_t MiB = 1u << 20;
constexpr size_t WS_CTL = 0, CTL_ZERO_BYTES = 1 * MiB;
constexpr size_t WS_MODV = 1 * MiB;
constexpr size_t WS_TABC = 2 * MiB, WS_TABS = 2 * MiB + 512 * 1024;
constexpr size_t WS_WC = 3 * MiB;
constexpr size_t WS_WR = 5 * MiB;
constexpr size_t WS_WIN = 6 * MiB;
constexpr size_t WS_WOUT = 13 * MiB;
constexpr size_t WS_TOPW = 18 * MiB;
constexpr size_t WS_W13 = 20 * MiB;
constexpr size_t WS_W2 = 277 * MiB;
constexpr size_t WS_LIST = 406 * MiB;
constexpr size_t WS_XN = 470 * MiB;
constexpr size_t WS_ACT = 598 * MiB;
constexpr size_t WS_PROJ = WS_ACT;
constexpr size_t WS_QA = WS_ACT + 224 * MiB;
constexpr size_t WS_KA = WS_QA + 48 * MiB;
constexpr size_t WS_VA = WS_KA + 16 * MiB;
constexpr size_t WS_QB = WS_VA + 16 * MiB;
constexpr size_t WS_KB = WS_QB + 48 * MiB;
constexpr size_t WS_VB = WS_KB + 16 * MiB;
constexpr size_t WS_CQK = WS_VB + 16 * MiB;
constexpr size_t WS_QC = WS_CQK + 48 * MiB;
constexpr size_t WS_KC = WS_QC + 48 * MiB;
constexpr size_t WS_VC = WS_KC + 48 * MiB;
constexpr size_t WS_MIX = WS_VC + 32 * MiB;
constexpr size_t WS_ATT_END = WS_MIX + 128 * MiB;
constexpr size_t WS_H = WS_ACT;
constexpr size_t WS_SSQ = 1728 * MiB;
constexpr size_t WS_XB = 1600 * MiB;
constexpr size_t WS_U2F = 1536 * MiB;
constexpr size_t WS_LOGITS = WS_ACT + 320 * MiB;
constexpr size_t WS_Y = WS_ACT + 384 * MiB;
constexpr size_t WS_END = WS_Y + 512 * MiB;
static_assert(WS_ATT_END <= WS_U2F && WS_END <= WS_U2F && WS_U2F + 64 * MiB <= WS_XB && WS_XB + 128 * MiB <= 2048 * MiB, "d_ws map");
constexpr int CW_BAR = 4096;
constexpr int CW_GCNT = 16384;

constexpr int RING_BYTES = 131072;
constexpr int LDSCTL_OFF = RING_BYTES, MISC_OFF = LDSCTL_OFF + 320;
constexpr int TAB_OFF = LDSCTL_OFF + 1024;
constexpr int LDS_BYTES = 147456;

#define GAS __attribute__((address_space(1)))
#define LAS __attribute__((address_space(3)))
typedef unsigned short bf16;
typedef unsigned v4u __attribute__((ext_vector_type(4)));
typedef unsigned v2u __attribute__((ext_vector_type(2)));
typedef float f32x4 __attribute__((ext_vector_type(4)));
typedef GAS unsigned gu32;
#define RLX_AGENT __ATOMIC_RELAXED, __HIP_MEMORY_SCOPE_AGENT
#define LDS_WAIT() asm volatile("s_waitcnt lgkmcnt(0)" ::: "memory")
#define VM_WAIT() asm volatile("s_waitcnt vmcnt(0)" ::: "memory")
__device__ __forceinline__ unsigned f2bf(float f) { unsigned u = __builtin_bit_cast(unsigned, f); return (u + 0x7fffu + ((u >> 16) & 1u)) >> 16; }
__device__ __forceinline__ unsigned pk2(float lo, float hi) { return f2bf(lo) | (f2bf(hi) << 16); }
__device__ __forceinline__ float bflo(unsigned w) { return __builtin_bit_cast(float, w << 16); }
__device__ __forceinline__ float bfhi(unsigned w) { return __builtin_bit_cast(float, w & 0xffff0000u); }
template <int K> __device__ __forceinline__ float sx(float v) { return __builtin_bit_cast(float, __builtin_amdgcn_ds_swizzle(__builtin_bit_cast(int, v), 0x1F | (K << 10))); }
template <int K> __device__ __forceinline__ int sxi(int v) { return __builtin_amdgcn_ds_swizzle(v, 0x1F | (K << 10)); }
template <int CTRL> __device__ __forceinline__ float dx(float v) { const int i = __builtin_bit_cast(int, v); return __builtin_bit_cast(float, __builtin_amdgcn_update_dpp(i, i, CTRL, 0xF, 0xF, false)); }
template <int CTRL> __device__ __forceinline__ int dxi(int v) { return __builtin_amdgcn_update_dpp(v, v, CTRL, 0xF, 0xF, false); }
__device__ __forceinline__ float red8(float v) { v += dx<0xB1>(v); v += dx<0x4E>(v); v += dx<0x141>(v); return v; }
__device__ __forceinline__ float red16(float v) { v = red8(v); v += dx<0x140>(v); return v; }
__device__ __forceinline__ float red32(float v) { v = red16(v); v += sx<16>(v); return v; }
__device__ __forceinline__ float wave_sum(float v) {
    v = red32(v);
    auto rr = __builtin_amdgcn_permlane32_swap(__float_as_uint(v), __float_as_uint(v), false, false);
    return __uint_as_float(rr[0]) + __uint_as_float(rr[1]);
}
__device__ __forceinline__ float fast_sigmoid(float x) { return __builtin_amdgcn_rcpf(1.f + __builtin_amdgcn_exp2f(-x * LOG2E)); }

#define XB_TMO      128
#define XB_XCNT(j)  (256  + 64 * (j))
#define XB_XSUB(j)  (1280 + 64 * (j))
#define XB_XGEN(j)  (2304 + 64 * (j))
#define XB_TOP      3328
#define XB_TOPGEN   3392
#define XCD_BAR_WORDS 3456
#define XB_SPIN_CAP (1u << 18)
__device__ __forceinline__ unsigned xb_ld(unsigned* p)              { return __hip_atomic_load(p, __ATOMIC_RELAXED, __HIP_MEMORY_SCOPE_AGENT); }
__device__ __forceinline__ unsigned xb_add(unsigned* p, unsigned v) { return __hip_atomic_fetch_add(p, v, __ATOMIC_RELAXED, __HIP_MEMORY_SCOPE_AGENT); }
__device__ __forceinline__ unsigned xb_xcc_id() { return (unsigned)__builtin_amdgcn_s_getreg((3 << 11) | 20) & 0xFu; }
#define XB_SPIN(cond, bar) do { unsigned _sp = 0; while (cond) { __builtin_amdgcn_s_sleep(1); \
    if ((++_sp & 255u) == 0u) { if (xb_ld(&(bar)[XB_TMO])) break; if (_sp > XB_SPIN_CAP) { atomicAdd(&(bar)[XB_TMO], 1u); break; } } } } while (0)
struct XcdBarrier { unsigned* bar; unsigned x; volatile LAS unsigned* st; };
__device__ __forceinline__ XcdBarrier xcd_barrier_post(unsigned* bar, volatile LAS unsigned* st) {
    XcdBarrier b; b.bar = bar; b.x = xb_xcc_id(); b.st = st;
    if (threadIdx.x == 0) (void)xb_add(&bar[XB_XCNT(b.x)], 1u);
    return b;
}
__device__ __forceinline__ void xcd_barrier_complete(unsigned* bar, unsigned x, unsigned& nloc, unsigned& nx) {
    const unsigned G = gridDim.x * gridDim.y * gridDim.z;
    unsigned sum, cnt, mine, sp = 0u;
    for (;;) {
        sum = 0u; cnt = 0u; mine = 0u;
#pragma unroll
        for (unsigned j = 0; j < 16; ++j) { const unsigned c = xb_ld(&bar[XB_XCNT(j)]); sum += c; cnt += (c > 0u) ? 1u : 0u; mine = (j == x) ? c : mine; }
        if (sum == G) break;
        __builtin_amdgcn_s_sleep(1);
        if ((++sp & 255u) == 0u) { if (xb_ld(&bar[XB_TMO])) break; if (sp > XB_SPIN_CAP) { atomicAdd(&bar[XB_TMO], 1u); break; } }
    }
    nloc = mine > 0u ? mine : 1u; nx = cnt > 0u ? cnt : 1u;
}
__device__ __forceinline__ void xcd_barrier(const XcdBarrier& b) {
    asm volatile("s_waitcnt vmcnt(0)" ::: "memory");
    __syncthreads();
    if (threadIdx.x == 0) {
        unsigned* bar = b.bar;
        __builtin_amdgcn_s_waitcnt(0);
        unsigned nloc = b.st[0], nx = b.st[1];
        if (nloc == 0u) { xcd_barrier_complete(bar, b.x, nloc, nx); b.st[0] = nloc; b.st[1] = nx; }
        const unsigned old = xb_add(&bar[XB_XSUB(b.x)], 1u);
        const unsigned gen = old / nloc;
        if (old + 1u == (gen + 1u) * nloc) {
            __builtin_amdgcn_fence(__ATOMIC_RELEASE, "agent");
            asm volatile("s_waitcnt vmcnt(0)" ::: "memory");
            const unsigned og = xb_add(&bar[XB_TOP], 1u);
            const unsigned tg = og / nx;
            if (og + 1u == (tg + 1u) * nx) xb_add(&bar[XB_TOPGEN], 1u);
            else XB_SPIN(xb_ld(&bar[XB_TOPGEN]) == tg, bar);
            __builtin_amdgcn_fence(__ATOMIC_ACQUIRE, "agent");
            xb_add(&bar[XB_XGEN(b.x)], 1u);
            asm volatile("s_waitcnt vmcnt(0)" ::: "memory");
        } else {
            XB_SPIN(xb_ld(&bar[XB_XGEN(b.x)]) == gen, bar);
            __builtin_amdgcn_fence(__ATOMIC_ACQUIRE, "agent");
            asm volatile("s_waitcnt vmcnt(0)" ::: "memory");
        }
    }
    __syncthreads();
}
constexpr size_t WS_DRY0 = 1792ull << 20, WS_DRY1 = 1920ull << 20;
#define DRY(p) (NREP(p) == 2 && rep_ == 0)
#ifndef REP_MASK
#define REP_MASK 0
#endif
#define NREP(p) ((((REP_MASK) >> (p)) & 1) ? 2 : 1)
enum InIdx { I_X = 0, I_C, I_MODW, I_MODB, I_N1G, I_N2G, I_WIN, I_AQG, I_AKG, I_BSINK, I_CQG, I_CKVG, I_WUQ, I_WUK, I_WUV, I_ONG, I_WOUT, I_RW, I_RB, I_EW1, I_EW3, I_EW2, I_SW1, I_SW3, I_SW2, I_FG, N_IN };
struct Args { const float* in[N_IN]; float* out; unsigned char* ws; int ph_lo, ph_hi; };
constexpr int PH_PER_LAYER = 13, N_PHASES = 1 + PH_PER_LAYER * DEPTH;

typedef __attribute__((address_space(4))) const Args* KArgs;
__device__ __forceinline__ KArgs kargs() { KArgs p = (KArgs)__builtin_amdgcn_kernarg_segment_ptr(); asm volatile("" : "+s"(p)); return p; }
struct Ctx {
    LAS unsigned char* lds; unsigned char* ws;
    int tid, lane, wave, G, vcu, gw, NGW;
};

__device__ __forceinline__ void tr_item(const float* W, int N, bf16* WT, int ldk, int koff, int drow0, LAS float* scr, int k0, int n0, int lane, const float* ks = nullptr  ) {
    float tv[32];
#pragma unroll
    for (int i = 0; i < 32; ++i) { const int kk = 2 * i + (lane >> 5); tv[i] = __builtin_nontemporal_load(W + (size_t)(k0 + kk) * N + n0 + (lane & 31)); }
#pragma unroll
    for (int i = 0; i < 32; ++i) { const int kk = 2 * i + (lane >> 5); scr[kk * 33 + (lane & 31)] = tv[i] * (ks ? ks[k0 + kk] : 1.f); }
    LDS_WAIT(); asm volatile("" ::: "memory");
    const int c = lane & 7;
#pragma unroll
    for (int j = 0; j < 4; ++j) { const int n = (lane >> 3) + 8 * j; const LAS float* s = scr + (8 * c) * 33 + n;
        v4u o; o.x = pk2(s[0 * 33], s[1 * 33]); o.y = pk2(s[2 * 33], s[3 * 33]); o.z = pk2(s[4 * 33], s[5 * 33]); o.w = pk2(s[6 * 33], s[7 * 33]);
        *(GAS v4u*)(WT + (size_t)(drow0 + n) * ldk + koff + k0 + 8 * c) = o; }
    LDS_WAIT(); asm volatile("" ::: "memory");
}
__device__ __forceinline__ unsigned pk4_fp8(float a, float b, float c, float d) { int w = 0; w = __builtin_amdgcn_cvt_pk_fp8_f32(a, b, w, false); w = __builtin_amdgcn_cvt_pk_fp8_f32(c, d, w, true); return (unsigned)w; }
__device__ __forceinline__ void tr_load(const float* W, int N, int k0, int n0, int lane, float (&tv)[32]) {
#pragma unroll
    for (int i = 0; i < 32; ++i) { const int kk = 2 * i + (lane >> 5); tv[i] = __builtin_nontemporal_load(W + (size_t)(k0 + kk) * N + n0 + (lane & 31)); }
}
__device__ __forceinline__ void tr_store_f8(const float (&tv)[32], unsigned char* WT, int ldk, int drow0, float sc, LAS float* scr, int k0, int lane, const float* ks = nullptr  ) {
#pragma unroll
    for (int i = 0; i < 32; ++i) { const int kk = 2 * i + (lane >> 5); scr[kk * 33 + (lane & 31)] = tv[i] * (ks ? ks[k0 + kk] : 1.f); }
    LDS_WAIT(); asm volatile("" ::: "memory");
    const int c = lane & 7;
#pragma unroll
    for (int j = 0; j < 4; ++j) { const int n = (lane >> 3) + 8 * j; const LAS float* s = scr + (8 * c) * 33 + n;
        v2u o; o.x = pk4_fp8(s[0 * 33] * sc, s[1 * 33] * sc, s[2 * 33] * sc, s[3 * 33] * sc); o.y = pk4_fp8(s[4 * 33] * sc, s[5 * 33] * sc, s[6 * 33] * sc, s[7 * 33] * sc);
        *(GAS v2u*)(WT + (size_t)(drow0 + n) * ldk + k0 + 8 * c) = o; }
    LDS_WAIT(); asm volatile("" ::: "memory");
}
__device__ __forceinline__ void tr_item_f8(const float* W, int N, unsigned char* WT, int ldk, int drow0, float sc, LAS float* scr, int k0, int n0, int lane, const float* ks = nullptr) {
    float tv[32]; tr_load(W, N, k0, n0, lane, tv); tr_store_f8(tv, WT, ldk, drow0, sc, scr, k0, lane, ks);
}
constexpr float SC_W13 = 64.f, SC_W2 = 32.f, SC_H = 8.f;
constexpr int SC_MIXA = 256, SC_MIXB = 32, SC_MIXC = 256; constexpr float SC_WO = 64.f;
struct ExpItem { const float* src; unsigned char* dst; int N, ldk, drow0, k0, n0; float sc; };
__device__ __forceinline__ ExpItem expert_item(const KArgs ap, unsigned char* ws, int l, int it) {
    ExpItem x; const int e = it / 384, r = it % 384, which = r >> 7, q = r & 127;
    if (which < 2) {
        const float* ew = which == 0 ? ap->in[I_EW1] : ap->in[I_EW3]; const float* sw = which == 0 ? ap->in[I_SW1] : ap->in[I_SW3];
        x.src = (e < NE) ? ew + (size_t)(l * NE + e) * 262144 : sw + (size_t)l * 262144;
        const int kb = q >> 3, nb = q & 7;
        x.dst = ws + WS_W13 + (size_t)e * 524288; x.N = 256; x.ldk = 1024; x.drow0 = (nb >> 2) * 256 + (nb & 3) * 32 + which * 128; x.k0 = kb * 64; x.n0 = nb * 32; x.sc = SC_W13;
    } else {
        x.src = (e < NE) ? ap->in[I_EW2] + (size_t)(l * NE + e) * 262144 : ap->in[I_SW2] + (size_t)l * 262144;
        const int kb = q >> 5, nb = q & 31;
        x.dst = ws + WS_W2 + (size_t)e * 262144; x.N = 1024; x.ldk = 256; x.drow0 = nb * 32; x.k0 = kb * 64; x.n0 = nb * 32; x.sc = SC_W2;
    }
    return x;
}
__device__ __forceinline__ void convert_experts(const Ctx& c, int l) {
    LAS float* scr = (LAS float*)(c.lds + c.wave * 16384);
    const KArgs ap = kargs();
    constexpr int NIT = NEX * 384;
    for (int it = c.gw; it < NIT; it += 2 * c.NGW) {
        const ExpItem a0 = expert_item(ap, c.ws, l, it); const bool two = it + c.NGW < NIT; const ExpItem a1 = expert_item(ap, c.ws, l, two ? it + c.NGW : it);
        float t0[32], t1[32];
        tr_load(a0.src, a0.N, a0.k0, a0.n0, c.lane, t0); tr_load(a1.src, a1.N, a1.k0, a1.n0, c.lane, t1);
        tr_store_f8(t0, a0.dst, a0.ldk, a0.drow0, a0.sc, scr, a0.k0, c.lane);
        if (two) tr_store_f8(t1, a1.dst, a1.ldk, a1.drow0, a1.sc, scr, a1.k0, c.lane);
    }
}
__device__ __forceinline__ void tr_store_f8_half(const float (&tv)[32], int half, unsigned char* WT, int ldk, int drow0, float sc, LAS float* scr, int k0, int lane) {
#pragma unroll
    for (int i = 0; i < 16; ++i) { const int kk = 2 * i + (lane >> 5); scr[kk * 33 + (lane & 31)] = tv[16 * half + i]; }
    LDS_WAIT(); asm volatile("" ::: "memory");
    const int c = lane & 3;
#pragma unroll
    for (int j = 0; j < 2; ++j) { const int n = (lane >> 2) + 16 * j; const LAS float* s = scr + (8 * c) * 33 + n;
        v2u o; o.x = pk4_fp8(s[0 * 33] * sc, s[1 * 33] * sc, s[2 * 33] * sc, s[3 * 33] * sc); o.y = pk4_fp8(s[4 * 33] * sc, s[5 * 33] * sc, s[6 * 33] * sc, s[7 * 33] * sc);
        *(GAS v2u*)(WT + (size_t)(drow0 + n) * ldk + k0 + 32 * half + 8 * c) = o; }
    LDS_WAIT(); asm volatile("" ::: "memory");
}
struct ExpItem2 { const float* src; unsigned char* dst; int N, ldk; float sc; };
__device__ __forceinline__ ExpItem2 expert_item2(const KArgs ap, unsigned char* ws, int l, int it) {
    ExpItem2 x; const int e = it / 192, r = it % 192, which = r >> 6, q = r & 63;
    if (which < 2) {
        const float* ew = which == 0 ? ap->in[I_EW1] : ap->in[I_EW3]; const float* sw = which == 0 ? ap->in[I_SW1] : ap->in[I_SW3];
        const float* base = (e < NE) ? ew + (size_t)(l * NE + e) * 262144 : sw + (size_t)l * 262144;
        const int k0 = (q >> 3) * 128, n0 = (q & 7) * 32;
        x.N = 256; x.ldk = 1024; x.sc = SC_W13; x.src = base + (size_t)k0 * 256 + n0;
        x.dst = ws + WS_W13 + (size_t)e * 524288 + (size_t)((n0 >> 7) * 256 + which * 128 + (n0 & 127)) * 1024 + k0;
    } else {
        const float* base = (e < NE) ? ap->in[I_EW2] + (size_t)(l * NE + e) * 262144 : ap->in[I_SW2] + (size_t)l * 262144;
        const int k0 = (q >> 5) * 128, n0 = (q & 31) * 32;
        x.N = 1024; x.ldk = 256; x.sc = SC_W2; x.src = base + (size_t)k0 * 1024 + n0;
        x.dst = ws + WS_W2 + (size_t)e * 262144 + (size_t)n0 * 256 + k0;
    }
    return x;
}
__device__ __forceinline__ void cvt_item_load(const ExpItem2& a, int lane, f32x4 (&v)[4][4]) {
    const float* p = a.src + (size_t)(16 * (lane >> 3)) * a.N + 4 * (lane & 7);
#pragma unroll
    for (int s_ = 0; s_ < 4; ++s_)
#pragma unroll
        for (int i = 0; i < 4; ++i) v[s_][i] = __builtin_nontemporal_load((const GAS f32x4*)(p + (size_t)(4 * s_ + i) * a.N));
}
__device__ __forceinline__ void cvt_item_store(const ExpItem2& a, int lane, const f32x4 (&v)[4][4]) {
    unsigned char* d = a.dst + (size_t)(4 * (lane & 7)) * a.ldk + 16 * (lane >> 3); const float sc = a.sc;
#pragma unroll
    for (int j = 0; j < 4; ++j) { v4u o;
        o.x = pk4_fp8(v[0][0][j] * sc, v[0][1][j] * sc, v[0][2][j] * sc, v[0][3][j] * sc); o.y = pk4_fp8(v[1][0][j] * sc, v[1][1][j] * sc, v[1][2][j] * sc, v[1][3][j] * sc);
        o.z = pk4_fp8(v[2][0][j] * sc, v[2][1][j] * sc, v[2][2][j] * sc, v[2][3][j] * sc); o.w = pk4_fp8(v[3][0][j] * sc, v[3][1][j] * sc, v[3][2][j] * sc, v[3][3][j] * sc);
        *(GAS v4u*)(d + (size_t)j * a.ldk) = o; }
}
__device__ __forceinline__ void convert_experts_part(const Ctx& c, int l, int part, int nparts) {
    const KArgs ap = kargs();
    constexpr int NIT = NEX * 192;
    const int K = (NIT - c.gw + 2 * c.NGW - 1) / (2 * c.NGW); const int k_lo = (int)((long)part * K / nparts), k_hi = (int)((long)(part + 1) * K / nparts);
    for (int k = k_lo; k < k_hi; ++k) { const int it = c.gw + k * 2 * c.NGW;
        const bool two = it + c.NGW < NIT;
        const ExpItem2 a0 = expert_item2(ap, c.ws, l, it), a1 = expert_item2(ap, c.ws, l, two ? it + c.NGW : it);
        f32x4 v0[4][4], v1[4][4];
        cvt_item_load(a0, c.lane, v0); cvt_item_load(a1, c.lane, v1);
        cvt_item_store(a0, c.lane, v0); if (two) cvt_item_store(a1, c.lane, v1);
    }
    VM_WAIT();
}
__device__ __forceinline__ void zero_rect(const Ctx& c, bf16* base, int ld, int r0, int nr, int c0, int nc) {
    const int cpr = nc / 8, total = nr * cpr;
    for (int i = c.gw * 64 + c.lane; i < total; i += c.NGW * 64) { const int r = i / cpr, cc = i % cpr; *(GAS v4u*)(base + (size_t)(r0 + r) * ld + c0 + cc * 8) = (v4u){0u, 0u, 0u, 0u}; }
}
__device__ __forceinline__ void prologue(const Ctx& c) {
    const KArgs ap = kargs(); const auto& a = *ap;
    for (int item = blockIdx.x; item < DEPTH * 128; item += c.G) {
        const int l = item / 128, grp = item % 128;
        LAS float* cact = (LAS float*)c.lds; LAS float* part = cact + 8192;
        for (int i = c.tid; i < 8192; i += NTHREADS) { const float v = a.in[I_C][i]; cact[i] = v * fast_sigmoid(v); }
        __syncthreads();
        const int col = grp * 48 + (c.lane < 48 ? c.lane : 47); const float* W = a.in[I_MODW] + (size_t)l * 1024 * 6144 + col;
        float acc[8];
#pragma unroll
        for (int b = 0; b < 8; ++b) acc[b] = 0.f;
#pragma unroll 16
        for (int d = c.wave * 128; d < c.wave * 128 + 128; ++d) { const float w = __builtin_nontemporal_load(W + (size_t)d * 6144);
#pragma unroll
            for (int b = 0; b < 8; ++b) acc[b] += cact[b * 1024 + d] * w; }
#pragma unroll
        for (int b = 0; b < 8; ++b) part[(c.wave * 8 + b) * 64 + c.lane] = acc[b];
        __syncthreads();
        { const int b = c.wave; float s = a.in[I_MODB][l * 6144 + col];
#pragma unroll
          for (int w = 0; w < 8; ++w) s += part[(w * 8 + b) * 64 + c.lane];
          if (c.lane < 48) ((float*)(c.ws + WS_MODV))[(size_t)(l * 8 + b) * 6144 + col] = s; }
        __syncthreads();
    }
    { float* TC = (float*)(c.ws + WS_TABC); float* TS = (float*)(c.ws + WS_TABS);
      for (int idx = c.gw * 64 + c.lane; idx < 8192 * 16; idx += c.NGW * 64) { const int p = idx >> 4, j = idx & 15;
          const double inv = exp2(-(double)j * (13.287712379549449 / 16.0)); double rev = (double)p * inv * 0.15915494309189535; rev -= rint(rev);
          TC[idx] = __builtin_amdgcn_cosf((float)rev); TS[idx] = __builtin_amdgcn_sinf((float)rev); } }
    __syncthreads();
    { LAS float* scr = (LAS float*)(c.lds + c.wave * 16384);
      constexpr int I0 = 16 * 53, I1 = I0 + 16 * 32, I2 = I1 + 16 * 8, I3 = I2 + 4 * 12, I4 = I3 + 2 * 8, I5 = I4 + 2 * 8;
      for (int it = c.gw; it < DEPTH * I5; it += c.NGW) {
          const int l = it / I5; int r = it % I5;
          if (r < I0) { tr_item(a.in[I_WIN] + (size_t)l * 1024 * IN_W, IN_W, (bf16*)(c.ws + WS_WIN) + (size_t)l * IN_WP * 1024, 1024, 0, (r % 53) * 32, scr, (r / 53) * 64, (r % 53) * 32, c.lane); continue; } r -= I0;
          if (r < 16 * 32) { tr_item_f8(a.in[I_WOUT] + (size_t)l * 1024 * 1024, 1024, c.ws + WS_WOUT + (size_t)l * 1024 * 1024, 1024, (r & 31) * 32, SC_WO, scr, (r >> 5) * 64, (r & 31) * 32, c.lane, a.in[I_ONG] + l * 1024); continue; } r -= 16 * 32;
          if (r < 16 * 8) { tr_item(a.in[I_RW] + (size_t)l * 1024 * 256, 256, (bf16*)(c.ws + WS_WR) + (size_t)l * 256 * 1024, 1024, 0, (r & 7) * 32, scr, (r >> 3) * 64, (r & 7) * 32, c.lane); continue; } r -= 16 * 8;
          bf16* WC = (bf16*)(c.ws + WS_WC) + (size_t)l * 1024 * 384;
          if (r < 48) { tr_item(a.in[I_WUQ] + (size_t)l * 256 * 384, 384, WC, 384, 0, (r % 12) * 32, scr, (r / 12) * 64, (r % 12) * 32, c.lane); continue; } r -= 48;
          if (r < 16) { tr_item(a.in[I_WUK] + (size_t)l * 128 * 256, 256, WC, 384, 256, 384 + (r & 7) * 32, scr, (r >> 3) * 64, (r & 7) * 32, c.lane); continue; } r -= 16;
          tr_item(a.in[I_WUV] + (size_t)l * 128 * 256, 256, WC, 384, 256, 640 + (r & 7) * 32, scr, (r >> 3) * 64, (r & 7) * 32, c.lane);
      }
      for (int l = 0; l < DEPTH; ++l) {
          zero_rect(c, (bf16*)(c.ws + WS_WIN) + (size_t)l * IN_WP * 1024, 1024, IN_W, IN_WP - IN_W, 0, 1024);
          bf16* WC = (bf16*)(c.ws + WS_WC) + (size_t)l * 1024 * 384;
          zero_rect(c, WC, 384, 0, 384, 256, 128); zero_rect(c, WC, 384, 384, 512, 0, 256); zero_rect(c, WC, 384, 896, 128, 0, 384);
      } }
}

template <bool SRC_F32>
__device__ __forceinline__ void norm_mod_rows(const Ctx& c, const void* X, bf16* Y, unsigned char* Y8  , const float* g, const float* modv  , int i_shift, int i_scale) {
    constexpr int NRF = 4;
    for (int m0 = c.gw; m0 < M; m0 += NRF * c.NGW) {
        f32x4 v[NRF][4]; float s[NRF];
#pragma unroll
        for (int u = 0; u < NRF; ++u) { const int m = m0 + u * c.NGW; const size_t ro = (size_t)(m < M ? m : m0) * D;
            if constexpr (SRC_F32) { const GAS f32x4* xr = (const GAS f32x4*)((const float*)X + ro) + c.lane;
#pragma unroll
                for (int j = 0; j < 4; ++j) v[u][j] = __builtin_nontemporal_load(xr + 64 * j); }
            else { const GAS v2u* xr = (const GAS v2u*)((const bf16*)X + ro) + c.lane;
#pragma unroll
                for (int j = 0; j < 4; ++j) { const v2u w = xr[64 * j]; v[u][j] = (f32x4){bflo(w.x), bfhi(w.x), bflo(w.y), bfhi(w.y)}; } } }
#pragma unroll
        for (int u = 0; u < NRF; ++u) { float q = 0.f;
#pragma unroll
            for (int j = 0; j < 4; ++j) q += (v[u][j].x * v[u][j].x + v[u][j].y * v[u][j].y) + (v[u][j].z * v[u][j].z + v[u][j].w * v[u][j].w);
            s[u] = q; }
#pragma unroll
        for (int u = 0; u < NRF; ++u) { const int m = m0 + u * c.NGW; if (m >= M) break;
            const int b = m >> 13; const float rstd = 1.f / sqrtf(wave_sum(s[u]) * (1.f / D) + EPS);
            const f32x4* gp = (const f32x4*)g + c.lane; const f32x4* scp = (const f32x4*)(modv + (size_t)(b * 6 + i_scale) * 1024) + c.lane; const f32x4* shp = (const f32x4*)(modv + (size_t)(b * 6 + i_shift) * 1024) + c.lane;
            GAS v2u* o8 = (GAS v2u*)(Y + (size_t)m * D) + c.lane;
#pragma unroll
            for (int j = 0; j < 4; ++j) { const f32x4 gg = gp[64 * j], sc = scp[64 * j], sh = shp[64 * j]; const f32x4 y = v[u][j] * rstd * gg * (sc + 1.f) + sh;
                o8[64 * j] = (v2u){pk2(y.x, y.y), pk2(y.z, y.w)};
                if (Y8) *((GAS unsigned*)(Y8 + (size_t)m * D) + c.lane + 64 * j) = pk4_fp8(y.x, y.y, y.z, y.w); } }
    }
}
__device__ __forceinline__ void unpack8(const v4u w, float (&v)[8]) { v[0] = bflo(w.x); v[1] = bfhi(w.x); v[2] = bflo(w.y); v[3] = bfhi(w.y); v[4] = bflo(w.z); v[5] = bfhi(w.z); v[6] = bflo(w.w); v[7] = bfhi(w.w); }
__device__ __forceinline__ v4u pack8(const float (&v)[8]) { return (v4u){pk2(v[0], v[1]), pk2(v[2], v[3]), pk2(v[4], v[5]), pk2(v[6], v[7])}; }
__device__ __forceinline__ float sumsq8(const float (&v)[8]) { float s = 0.f;
#pragma unroll
    for (int i = 0; i < 8; ++i) s += v[i] * v[i]; return s; }
__device__ __forceinline__ void norm2_rows(const Ctx& c, const bf16* X, bf16* Y, unsigned char* Y8, const float* g, const float* modv, int i_shift, int i_scale, int first, int stride, int limit) {
    const int lane = c.lane;
    for (int m0 = first; m0 < limit; m0 += 4 * stride) {
        v4u w0[4], w1[4];
#pragma unroll
        for (int u = 0; u < 4; ++u) { const int m = (m0 + u * stride) < limit ? (m0 + u * stride) : m0; const bf16* row = X + (size_t)m * D; w0[u] = *(const GAS v4u*)(row + 8 * lane); w1[u] = *(const GAS v4u*)(row + 512 + 8 * lane); }
#pragma unroll
        for (int u = 0; u < 4; ++u) { const int m = m0 + u * stride; if (m >= limit) break;
            const int b = m >> 13; float v0[8], v1[8]; unpack8(w0[u], v0); unpack8(w1[u], v1);
            const float rstd = 1.f / sqrtf(wave_sum(sumsq8(v0) + sumsq8(v1)) * (1.f / D) + EPS);
            const float* scp = modv + (size_t)(b * 6 + i_scale) * 1024; const float* shp = modv + (size_t)(b * 6 + i_shift) * 1024;
#pragma unroll
            for (int h = 0; h < 2; ++h) { const int e0 = h * 512 + 8 * lane; float (&v)[8] = h == 0 ? v0 : v1;
                const f32x4 ga = *(const f32x4*)(g + e0), gb = *(const f32x4*)(g + e0 + 4), sa = *(const f32x4*)(scp + e0), sb = *(const f32x4*)(scp + e0 + 4), ha = *(const f32x4*)(shp + e0), hb = *(const f32x4*)(shp + e0 + 4);
                float y[8];
                y[0] = v[0] * rstd * ga.x * (1.f + sa.x) + ha.x; y[1] = v[1] * rstd * ga.y * (1.f + sa.y) + ha.y; y[2] = v[2] * rstd * ga.z * (1.f + sa.z) + ha.z; y[3] = v[3] * rstd * ga.w * (1.f + sa.w) + ha.w;
                y[4] = v[4] * rstd * gb.x * (1.f + sb.x) + hb.x; y[5] = v[5] * rstd * gb.y * (1.f + sb.y) + hb.y; y[6] = v[6] * rstd * gb.z * (1.f + sb.z) + hb.z; y[7] = v[7] * rstd * gb.w * (1.f + sb.w) + hb.w;
                *(GAS v4u*)(Y + (size_t)m * D + e0) = pack8(y);
                *(GAS v2u*)(Y8 + (size_t)m * D + e0) = (v2u){pk4_fp8(y[0], y[1], y[2], y[3]), pk4_fp8(y[4], y[5], y[6], y[7])}; } }
    }
}
__device__ __forceinline__ void rope8(float (&y)[8], int r8, int pos, const float* TC, const float* TS) {
    float py[8];
#pragma unroll
    for (int i = 0; i < 8; ++i) py[i] = dx<0x4E>(y[i]);
    const int j0 = (r8 & 1) * 8; const f32x4* cp = (const f32x4*)(TC + pos * 16 + j0); const f32x4* sp = (const f32x4*)(TS + pos * 16 + j0);
    const f32x4 c0 = cp[0], c1 = cp[1], s0 = sp[0], s1 = sp[1];
    const float cs[8] = {c0.x, c0.y, c0.z, c0.w, c1.x, c1.y, c1.z, c1.w}, sn[8] = {s0.x, s0.y, s0.z, s0.w, s1.x, s1.y, s1.z, s1.w};
    const bool first = r8 < 2;
#pragma unroll
    for (int i = 0; i < 8; ++i) y[i] = first ? (y[i] * cs[i] - py[i] * sn[i]) : (py[i] * sn[i] + y[i] * cs[i]);
}
struct QkvDst { bf16 *QA, *KA, *VA, *QB, *KB, *VB, *CQK, *KC; const float *TC, *TS, *aqg, *akg, *cqg, *ckvg; };
__device__ __forceinline__ void qkv_row(const QkvDst& d, int t, int lane, const v4u w0, const v4u w2, const v4u w3) {
    const int pos = t & (SEQ - 1), prow = pos >> 6, pcol = pos & 63;
    { float v[8]; unpack8(w0, v);
      const float ss = red8(sumsq8(v));
      const float rstd = 1.f / sqrtf(ss * (1.f / 64.f) + EPS);
      const int head = lane >> 3, d0 = (lane & 7) * 8; const float* gg = (head < 6 ? d.aqg : d.akg) + d0;
#pragma unroll
      for (int i = 0; i < 8; ++i) v[i] = v[i] * rstd * gg[i];
      rope8(v, (lane & 3), (d0 < 32) ? prow : pcol, d.TC, d.TS);
      if (head < 6) {
#pragma unroll
          for (int i = 0; i < 8; ++i) v[i] *= C2A;
          *(GAS v4u*)(d.QA + (size_t)t * 384 + head * 64 + d0) = pack8(v);
      } else *(GAS v4u*)(d.KA + (size_t)t * 128 + (head - 6) * 64 + d0) = pack8(v); }
    { const int e0 = 1024 + 8 * lane; float v[8]; unpack8(w2, v);
      const float ss = red32(sumsq8(v));
      if (e0 >= 1280) { const float rstd = 1.f / sqrtf(ss * (1.f / 256.f) + EPS); const float* gg = d.cqg + (e0 - 1280);
#pragma unroll
          for (int i = 0; i < 8; ++i) v[i] = v[i] * rstd * gg[i];
          *(GAS v4u*)(d.CQK + (size_t)t * 384 + (e0 - 1280)) = pack8(v); } }
    { const int e0 = 1536 + 8 * lane; float v[8]; unpack8(w3, v);
      const float ss = red16(sumsq8(v));
      float y[8];
#pragma unroll
      for (int i = 0; i < 8; ++i) y[i] = v[i];
      rope8(y, (lane & 3), pos, d.TC, d.TS);
      if (lane < 16) { const float rstd = 1.f / sqrtf(ss * (1.f / 128.f) + EPS); const float* gg = d.ckvg + (e0 - 1536);
#pragma unroll
          for (int i = 0; i < 8; ++i) v[i] = v[i] * rstd * gg[i];
          *(GAS v4u*)(d.CQK + (size_t)t * 384 + 256 + (e0 - 1536)) = pack8(v); }
      else if (lane < 20) { const v4u o = pack8(y); const int r = (lane - 16) * 8;
#pragma unroll
          for (int h = 0; h < 4; ++h) *(GAS v4u*)(d.KC + (size_t)t * 384 + h * 96 + 64 + r) = o; } }
}
__device__ __forceinline__ void qkv_prep_rows(const Ctx& c, int l) {
    const KArgs ap = kargs(); unsigned char* ws = c.ws;
    const bf16* PROJ = (const bf16*)(ws + WS_PROJ);
    QkvDst d{(bf16*)(ws + WS_QA), (bf16*)(ws + WS_KA), (bf16*)(ws + WS_VA), (bf16*)(ws + WS_QB), (bf16*)(ws + WS_KB), (bf16*)(ws + WS_VB), (bf16*)(ws + WS_CQK), (bf16*)(ws + WS_KC),
             (const float*)(ws + WS_TABC), (const float*)(ws + WS_TABS), ap->in[I_AQG] + l * 64, ap->in[I_AKG] + l * 64, ap->in[I_CQG] + l * 256, ap->in[I_CKVG] + l * 128};
    const int lane = c.lane;
    for (int t0 = c.gw; t0 < M; t0 += 8 * c.NGW) {
        v4u w[8][3];
#pragma unroll
        for (int u = 0; u < 8; ++u) { const int t = (t0 + u * c.NGW) < M ? (t0 + u * c.NGW) : t0; const bf16* pr = PROJ + (size_t)t * IN_WP;
            w[u][0] = __builtin_nontemporal_load((const GAS v4u*)(pr + 8 * lane));
            w[u][1] = (v4u){0u, 0u, 0u, 0u}; if (lane >= 32) w[u][1] = __builtin_nontemporal_load((const GAS v4u*)(pr + 1024 + 8 * lane));
            w[u][2] = (v4u){0u, 0u, 0u, 0u}; if (lane < 20) w[u][2] = __builtin_nontemporal_load((const GAS v4u*)(pr + 1536 + 8 * lane)); }
#pragma unroll
        for (int u = 0; u < 8; ++u) if (t0 + u * c.NGW < M) qkv_row(d, t0 + u * c.NGW, lane, w[u][0], w[u][1], w[u][2]);
    }
}
__device__ __forceinline__ void mixnorm_rows(const Ctx& c, int l, bool dry = false) {
    bf16* MIX = (bf16*)(c.ws + WS_MIX); bf16* MIXO = dry ? (bf16*)(c.ws + WS_DRY0) : MIX; const float* g = kargs()->in[I_ONG] + l * 1024; const int lane = c.lane;
    const float* g0 = g + 8 * lane; const float* g1 = g + 512 + 8 * lane;
    float gg0[8], gg1[8];
#pragma unroll
    for (int i = 0; i < 8; ++i) { gg0[i] = g0[i]; gg1[i] = g1[i]; }
    for (int t0 = c.gw; t0 < M; t0 += 4 * c.NGW) {
        v4u w0[4], w1[4];
#pragma unroll
        for (int u = 0; u < 4; ++u) { const int t = (t0 + u * c.NGW) < M ? (t0 + u * c.NGW) : t0; const bf16* row = MIX + (size_t)t * 1024; w0[u] = __builtin_nontemporal_load((const GAS v4u*)(row + 8 * lane)); w1[u] = __builtin_nontemporal_load((const GAS v4u*)(row + 512 + 8 * lane)); }
#pragma unroll
        for (int u = 0; u < 4; ++u) { const int t = t0 + u * c.NGW; if (t >= M) break;
            bf16* row = MIXO + (size_t)t * 1024;
            float v0[8], v1[8]; unpack8(w0[u], v0); unpack8(w1[u], v1);
            const float q0 = sumsq8(v0), q1 = sumsq8(v1);
            const float sA = wave_sum(lane < 48 ? q0 : 0.f), sB = wave_sum((lane >= 48 ? q0 : 0.f) + (lane < 32 ? q1 : 0.f)), sC = wave_sum(lane >= 32 ? q1 : 0.f);
            const float rA = 1.f / sqrtf(sA * (1.f / 384.f) + EPS), rB = 1.f / sqrtf(sB * (1.f / 384.f) + EPS), rC = 1.f / sqrtf(sC * (1.f / 256.f) + EPS);
            const float r0 = lane < 48 ? rA : rB, r1 = lane < 32 ? rB : rC;
#pragma unroll
            for (int i = 0; i < 8; ++i) { v0[i] = v0[i] * r0 * gg0[i]; v1[i] = v1[i] * r1 * gg1[i]; }
            *(GAS v4u*)(row + 8 * lane) = pack8(v0); *(GAS v4u*)(row + 512 + 8 * lane) = pack8(v1); }
    }
}
__device__ __forceinline__ void combine_rows(const Ctx& c, int l, bool dry = false) {
    const unsigned char* Y8 = (const unsigned char*)(c.ws + WS_Y); bf16* YS = (bf16*)(c.ws + WS_XN); float* OUT = kargs()->out; bf16* XB = (bf16*)(c.ws + WS_XB);
    const float* modv = (const float*)(c.ws + WS_MODV) + (size_t)l * 8 * 6144; const int lane = c.lane;
    const bool lastl = (l + 1 == DEPTH);
    const float* gn = lastl ? kargs()->in[I_FG] : kargs()->in[I_N1G] + (l + 1) * 1024;
    const float* modn = (const float*)(c.ws + WS_MODV) + (size_t)(lastl ? l : l + 1) * 8 * 6144;
    const int cA = (lane >> 4) * 256 + ((lane >> 2) & 3) * 32 + (lane & 3) * 8;
    for (int t = c.gw; t < M; t += c.NGW) {
        const int b = t >> 13;
        float acc[16], ys[16];
#pragma unroll
        for (int i = 0; i < 16; ++i) acc[i] = 0.f;
        { const bf16* yp = YS + (size_t)t * 1024 + cA; float a0[8], a1[8]; unpack8(__builtin_nontemporal_load((const GAS v4u*)yp), a0); unpack8(__builtin_nontemporal_load((const GAS v4u*)(yp + 128)), a1);
#pragma unroll
          for (int i = 0; i < 8; ++i) { ys[i] = a0[i]; ys[8 + i] = a1[i]; } }
#pragma unroll
        for (int k = 0; k < 8; ++k) { const v4u w = __builtin_nontemporal_load((const GAS v4u*)(Y8 + ((size_t)t * 8 + k) * 1024 + 16 * lane));
            const unsigned ww[4] = {w.x, w.y, w.z, w.w};
#pragma unroll
            for (int q = 0; q < 4; ++q) { const auto lo = __builtin_amdgcn_cvt_pk_f32_fp8((int)ww[q], false), hi = __builtin_amdgcn_cvt_pk_f32_fp8((int)ww[q], true);
                acc[4 * q + 0] += lo[0]; acc[4 * q + 1] += lo[1]; acc[4 * q + 2] += hi[0]; acc[4 * q + 3] += hi[1]; } }
        const float* g2 = modv + (size_t)(b * 6 + 5) * 1024;
        bf16* xb = XB + (size_t)t * 1024 + cA; bf16* xbo = dry ? (bf16*)(c.ws + WS_DRY0) + (size_t)t * 1024 + cA : xb; float* xr = OUT + (size_t)t * 1024; float ss = 0.f;
        float xv[16];
        { float a0[8], a1[8]; unpack8(__builtin_nontemporal_load((const GAS v4u*)xb), a0); unpack8(__builtin_nontemporal_load((const GAS v4u*)(xb + 128)), a1);
#pragma unroll
          for (int i = 0; i < 8; ++i) { xv[i] = a0[i]; xv[8 + i] = a1[i]; } }
#define COL(q) (cA + ((q) >> 1) * 128 + ((q) & 1) * 4)
#pragma unroll
        for (int q = 0; q < 4; ++q) { const f32x4 ga = *(const f32x4*)(g2 + COL(q));
            acc[4 * q + 0] = xv[4 * q + 0] + ga.x * (acc[4 * q + 0] * 0.0625f + ys[4 * q + 0]); acc[4 * q + 1] = xv[4 * q + 1] + ga.y * (acc[4 * q + 1] * 0.0625f + ys[4 * q + 1]);
            acc[4 * q + 2] = xv[4 * q + 2] + ga.z * (acc[4 * q + 2] * 0.0625f + ys[4 * q + 2]); acc[4 * q + 3] = xv[4 * q + 3] + ga.w * (acc[4 * q + 3] * 0.0625f + ys[4 * q + 3]);
            ss += (acc[4 * q] * acc[4 * q] + acc[4 * q + 1] * acc[4 * q + 1]) + (acc[4 * q + 2] * acc[4 * q + 2] + acc[4 * q + 3] * acc[4 * q + 3]); }
        const float rstd = 1.f / sqrtf(wave_sum(ss) * (1.f / D) + EPS);
        if (lastl) {
#pragma unroll
            for (int q = 0; q < 4; ++q) { const f32x4 na = *(const f32x4*)(gn + COL(q));
                *(GAS f32x4*)(xr + COL(q)) = (f32x4){acc[4 * q] * rstd * na.x, acc[4 * q + 1] * rstd * na.y, acc[4 * q + 2] * rstd * na.z, acc[4 * q + 3] * rstd * na.w}; }
        } else {
            const float* scp = modn + (size_t)(b * 6 + 1) * 1024; const float* shp = modn + (size_t)(b * 6 + 0) * 1024;
            float y[16];
#pragma unroll
            for (int q = 0; q < 4; ++q) { const f32x4 na = *(const f32x4*)(gn + COL(q)), sa = *(const f32x4*)(scp + COL(q)), ha = *(const f32x4*)(shp + COL(q));
                y[4 * q] = acc[4 * q] * rstd * na.x * (1.f + sa.x) + ha.x; y[4 * q + 1] = acc[4 * q + 1] * rstd * na.y * (1.f + sa.y) + ha.y;
                y[4 * q + 2] = acc[4 * q + 2] * rstd * na.z * (1.f + sa.z) + ha.z; y[4 * q + 3] = acc[4 * q + 3] * rstd * na.w * (1.f + sa.w) + ha.w; }
            *(GAS v4u*)xbo = (v4u){pk2(acc[0], acc[1]), pk2(acc[2], acc[3]), pk2(acc[4], acc[5]), pk2(acc[6], acc[7])};
            *(GAS v4u*)(xbo + 128) = (v4u){pk2(acc[8], acc[9]), pk2(acc[10], acc[11]), pk2(acc[12], acc[13]), pk2(acc[14], acc[15])};
            bf16* yo = (dry ? (bf16*)(c.ws + WS_DRY1) : YS) + (size_t)t * 1024 + cA;
            *(GAS v4u*)yo = (v4u){pk2(y[0], y[1]), pk2(y[2], y[3]), pk2(y[4], y[5]), pk2(y[6], y[7])};
            *(GAS v4u*)(yo + 128) = (v4u){pk2(y[8], y[9]), pk2(y[10], y[11]), pk2(y[12], y[13]), pk2(y[14], y[15])};
        }
#undef COL
    }
}

__device__ __forceinline__ void select_phase(const Ctx& c, int l, bool dry = false, const pg8::StaticOrder* S = nullptr  ) {
    LAS int* lcnt = (LAS int*)c.lds; LAS int* lbase = lcnt + 256; LAS int* sel_e = lbase + 256; LAS int* sel_p = sel_e + 2048; LAS int* sel_w = sel_p + 2048;
    const float* LOG = (const float*)(c.ws + WS_LOGITS); const float* rb = kargs()->in[I_RB] + l * NE; int* LIST = (int*)(c.ws + (dry ? WS_Y : WS_LIST));
    unsigned* gcnt = (unsigned*)(c.ws + WS_CTL) + CW_GCNT + l * 512 + (dry ? 1024 : 0);
    const int lane = c.lane;
    for (int it_ = 0;; ++it_) { int chunk; if (S) { pg8::Unit su; if (!S->next(it_, su)) break; chunk = su.pm; } else { chunk = (int)blockIdx.x + it_ * c.G; if (chunk >= M / 256) break; }
        if (c.tid < 256) lcnt[c.tid] = 0;
        __syncthreads();
        const f32x4 rbv = *(const f32x4*)(rb + 4 * lane);
        f32x4 lgn[2];
#pragma unroll
        for (int u = 0; u < 2; ++u) lgn[u] = __builtin_nontemporal_load((const GAS f32x4*)(LOG + (size_t)(chunk * 256 + c.wave * 32 + u) * 256 + 4 * lane));
        for (int tt = 0; tt < 32; tt += 2) {
            float s[2][4], cv[2][4], myw[2], ssum[2]; int mye[2];
            f32x4 lgc[2] = {lgn[0], lgn[1]};
            if (tt + 2 < 32) {
#pragma unroll
                for (int u = 0; u < 2; ++u) lgn[u] = __builtin_nontemporal_load((const GAS f32x4*)(LOG + (size_t)(chunk * 256 + c.wave * 32 + tt + 2 + u) * 256 + 4 * lane)); }
#pragma unroll
            for (int u = 0; u < 2; ++u) {
                const f32x4 lg = lgc[u];
                s[u][0] = fast_sigmoid(lg.x); s[u][1] = fast_sigmoid(lg.y); s[u][2] = fast_sigmoid(lg.z); s[u][3] = fast_sigmoid(lg.w);
                cv[u][0] = s[u][0] + rbv.x; cv[u][1] = s[u][1] + rbv.y; cv[u][2] = s[u][2] + rbv.z; cv[u][3] = s[u][3] + rbv.w; myw[u] = 0.f; ssum[u] = 0.f; mye[u] = 0; }
            float m1[2], m2[2];
#pragma unroll
            for (int u = 0; u < 2; ++u) { const float a = fmaxf(cv[u][0], cv[u][1]), b = fminf(cv[u][0], cv[u][1]), cc = fmaxf(cv[u][2], cv[u][3]), d = fminf(cv[u][2], cv[u][3]); m1[u] = fmaxf(a, cc); m2[u] = fmaxf(fminf(a, cc), fmaxf(b, d)); }
#define TOP2_STEP(K) { _Pragma("unroll") for (int u = 0; u < 2; ++u) { const float o1 = dx<K>(m1[u]), o2 = dx<K>(m2[u]); const float n1 = fmaxf(m1[u], o1), n2 = fmaxf(fminf(m1[u], o1), fmaxf(m2[u], o2)); m1[u] = n1; m2[u] = n2; } }
            TOP2_STEP(0xB1) TOP2_STEP(0x4E) TOP2_STEP(0x141)
#undef TOP2_STEP
            unsigned key[2][4];
#pragma unroll
            for (int u = 0; u < 2; ++u) { const float gs = m1[u] + m2[u]; const int grp = lane >> 3; int rank = 0;
#pragma unroll
                for (int gp = 0; gp < 8; ++gp) { const float sg = __builtin_bit_cast(float, __builtin_amdgcn_readlane(__builtin_bit_cast(int, gs), gp * 8)); rank += (int)((sg > gs) | ((sg == gs) & (gp < grp))); }
                const bool drop = rank >= 4;
#pragma unroll
                for (int jj = 0; jj < 4; ++jj) { const unsigned b = __builtin_bit_cast(unsigned, cv[u][jj]); const unsigned ok = (b & 0x80000000u) ? ~b : (b | 0x80000000u);
                    key[u][jj] = drop ? 0u : ((ok & 0xFFFFFF00u) | (unsigned)(255 - (4 * lane + jj))); } }
#pragma unroll
            for (int k = 0; k < 8; ++k) {
                unsigned bk[2];
#pragma unroll
                for (int u = 0; u < 2; ++u) { const unsigned a = key[u][0] > key[u][1] ? key[u][0] : key[u][1], b = key[u][2] > key[u][3] ? key[u][2] : key[u][3]; bk[u] = a > b ? a : b; }
#define KMAX_STEP(K) { _Pragma("unroll") for (int u = 0; u < 2; ++u) { const unsigned o = (unsigned)dxi<K>((int)bk[u]); bk[u] = o > bk[u] ? o : bk[u]; } }
                KMAX_STEP(0xB1) KMAX_STEP(0x4E) KMAX_STEP(0x141) KMAX_STEP(0x140)
#undef KMAX_STEP
#pragma unroll
                for (int u = 0; u < 2; ++u) { const unsigned o = (unsigned)sxi<16>((int)bk[u]); bk[u] = o > bk[u] ? o : bk[u]; }
#pragma unroll
                for (int u = 0; u < 2; ++u) {
                    { auto rk = __builtin_amdgcn_permlane32_swap(bk[u], bk[u], false, false); bk[u] = rk[0] > rk[1] ? rk[0] : rk[1]; }
                    const unsigned best = (unsigned)__builtin_amdgcn_readfirstlane((int)bk[u]);
                    const int g = 255 - (int)(best & 0xFFu);
                    const int owner = g >> 2, slot = g & 3; float sc;
                    { const bool own = lane == owner; const float ssel = slot == 0 ? s[u][0] : slot == 1 ? s[u][1] : slot == 2 ? s[u][2] : s[u][3]; sc = own ? ssel : 0.f;
#pragma unroll
                      for (int jj = 0; jj < 4; ++jj) key[u][jj] = (key[u][jj] == best) ? 0u : key[u][jj]; }
                    sc = __builtin_bit_cast(float, __builtin_amdgcn_readlane(__builtin_bit_cast(int, sc), owner)); ssum[u] += sc;
                    { const bool me = lane == k; mye[u] = me ? g : mye[u]; myw[u] = me ? sc : myw[u]; } }
            }
#pragma unroll
            for (int u = 0; u < 2; ++u) { const int tl = c.wave * 32 + tt + u;
                if (lane < 8) { sel_w[tl * 8 + lane] = (int)(myw[u] / ssum[u] * 8191.f + 0.5f); const int p = __hip_atomic_fetch_add(&lcnt[mye[u]], 1, __ATOMIC_RELAXED, __HIP_MEMORY_SCOPE_WORKGROUP); sel_e[tl * 8 + lane] = mye[u]; sel_p[tl * 8 + lane] = p; } }
        }
        __syncthreads();
        if (c.tid < 256) lbase[c.tid] = (int)__hip_atomic_fetch_add(gcnt + c.tid, (unsigned)lcnt[c.tid], RLX_AGENT);
        __syncthreads();
        for (int i = c.tid; i < 2048; i += NTHREADS) { const int e = sel_e[i]; LIST[(size_t)e * LCAP + lbase[e] + sel_p[i]] = ((chunk * 2048 + i) << 13) | sel_w[i]; }
        __syncthreads();
    }
}

__device__ __forceinline__ void build_moe_tables(const Ctx& c, int l) {
    LAS int* cum = (LAS int*)(c.lds + TAB_OFF); LAS int* cnt = cum + 260;
    unsigned* gcnt = (unsigned*)(c.ws + WS_CTL) + CW_GCNT + l * 512;
    if (c.wave == 0) {
        int n[4], nb = 0;
#pragma unroll
        for (int i = 0; i < 4; ++i) { n[i] = (int)__hip_atomic_load(gcnt + 4 * c.lane + i, RLX_AGENT); cnt[4 * c.lane + i] = n[i]; nb += (n[i] + 255) >> 8; }
        int inc = nb;
#pragma unroll
        for (int off = 1; off < 64; off <<= 1) { const int o = __builtin_amdgcn_ds_bpermute((c.lane - off) << 2, inc); if (c.lane >= off) inc += o; }
        int run = inc - nb;
#pragma unroll
        for (int i = 0; i < 4; ++i) { cum[4 * c.lane + i] = run; run += (n[i] + 255) >> 8; }
        if (c.lane == 63) { cum[256] = run; cum[257] = run + M / 256; cnt[256] = M; }
    }
    __syncthreads();
}
constexpr int ULIST_OFF = LDSCTL_OFF + 4096, ULIST_MAX = 128;
constexpr int ETAB_OFF = LDSCTL_OFF + 8192;
template <bool SHARE> struct MoeOrderT {
    static constexpr bool SHARE_A = SHARE;
    const LAS int* cum; const LAS int* cnt; const LAS int* ulist; const int* LIST; int G, c, NT, total, nblk, nlist; unsigned etab; bool use_tab;
    __device__ __forceinline__ bool locate(int i, int& blkidx, int& pnl) const {
        if constexpr (SHARE) { blkidx = (i >> 2) * G + c; pnl = i & 3; return blkidx < nblk; }
        else { const long L = (long)i * G + c; if (L >= total) return false; blkidx = (int)(L / NT); pnl = (int)(L % NT); return true; }
    }
    __device__ __forceinline__ void search(int blkidx, int pnl, pg8::Unit& u) const {
        int lo = 0, hi = 257;
#pragma unroll 1
        while (hi - lo > 1) { const int mid = (lo + hi) >> 1; const int cm = cum[mid]; if (cm <= blkidx) lo = mid; else hi = mid; }
        u.e = lo; u.blk = blkidx - cum[lo]; u.pm = blkidx; u.pn = lo * NT + pnl; const int left = cnt[lo] - u.blk * 256; u.rows = left < 256 ? left : 256;
    }
    __device__ __forceinline__ void init(const Ctx& cx, int NT_, bool use_tab_) {
        cum = (const LAS int*)(cx.lds + TAB_OFF); cnt = cum + 260; LIST = (const int*)(cx.ws + WS_LIST); G = cx.G; c = cx.vcu; NT = NT_; nblk = __builtin_amdgcn_readfirstlane(cum[257]); total = nblk * NT_;
        ulist = (const LAS int*)(cx.lds + ULIST_OFF); etab = (unsigned)(uintptr_t)(cx.lds + ETAB_OFF); use_tab = use_tab_;
        int mine;
        if constexpr (SHARE) mine = nblk > c ? ((nblk - c + G - 1) / G) * 4 : 0; else mine = total > c ? (total - c + G - 1) / G : 0;
        nlist = mine < ULIST_MAX ? mine : ULIST_MAX;
        if (cx.tid < nlist) { pg8::Unit u; int bi, pl; locate(cx.tid, bi, pl); search(bi, pl, u); LAS int* w = (LAS int*)(cx.lds + ULIST_OFF) + cx.tid * 8; w[0] = u.e; w[1] = u.blk; w[2] = u.pm; w[3] = u.pn; w[4] = u.rows; }
        __syncthreads();
    }
    __device__ __forceinline__ bool next(int i, pg8::Unit& u) const {
        int bi, pl; if (!locate(i, bi, pl)) return false;
        if (i < nlist) { const LAS int* w = ulist + i * 8; u.e = __builtin_amdgcn_readfirstlane(w[0]); u.blk = __builtin_amdgcn_readfirstlane(w[1]); u.pm = __builtin_amdgcn_readfirstlane(w[2]); u.pn = __builtin_amdgcn_readfirstlane(w[3]); u.rows = __builtin_amdgcn_readfirstlane(w[4]); }
        else { search(bi, pl, u); u.e = __builtin_amdgcn_readfirstlane(u.e); u.blk = __builtin_amdgcn_readfirstlane(u.blk); u.pm = __builtin_amdgcn_readfirstlane(u.pm); u.pn = __builtin_amdgcn_readfirstlane(u.pn); u.rows = __builtin_amdgcn_readfirstlane(u.rows); }
        if constexpr (SHARE) u.slot = ((i >> 2) % 3) | ((i & 3) ? 0 : 256); else u.slot = i % 3;
        return true;
    }
    __device__ __forceinline__ void a_ready(const pg8::Unit& u) const {
        if (use_tab && u.e != NE && (!SHARE || (u.slot & 256))) { int t_ = threadIdx.x; asm volatile("" : "+v"(t_));
            if (__builtin_amdgcn_readfirstlane(t_ >> 6) == 0) sat::glds16(LIST + (size_t)u.e * LCAP + u.blk * 256 + (t_ & 63) * 4, (unsigned)__builtin_amdgcn_readfirstlane((int)(etab + (u.slot & 255) * 1024))); }
    }
    __device__ __forceinline__ void done(const pg8::Unit&) const {}
    __device__ __forceinline__ void offsets_raw(const pg8::Unit& u, unsigned (&raw)[2][2], int R0, int R1) const {
#pragma unroll
        for (int h = 0; h < 2; ++h) { const int r0 = h * 128 + R0, r1 = h * 128 + R1;
            if (u.e == NE) { raw[h][0] = (unsigned)(u.blk * 256 + r0) << 16; raw[h][1] = (unsigned)(u.blk * 256 + r1) << 16; }
            else { const int* lp = LIST + (size_t)u.e * LCAP + u.blk * 256; raw[h][0] = r0 < u.rows ? (unsigned)lp[r0] : 0u; raw[h][1] = r1 < u.rows ? (unsigned)lp[r1] : 0u; } }
    }
    __device__ __forceinline__ void offsets_fin(const unsigned (&raw)[2][2], unsigned (&v)[2][2], int C0, int C1) const {
#pragma unroll
        for (int h = 0; h < 2; ++h) { v[h][0] = (raw[h][0] >> 16) * 1024u + (unsigned)(C0 * 2); v[h][1] = (raw[h][1] >> 16) * 1024u + (unsigned)(C1 * 2); }
    }
    __device__ __forceinline__ void offsets(const pg8::Unit& u, unsigned (&v)[2][2], int R0, int C0, int R1, int C1) const {
#pragma unroll
        for (int h = 0; h < 2; ++h) {
            const int r0 = h * 128 + R0, r1 = h * 128 + R1;
            int t0, t1;
            if (u.e == NE) { t0 = u.blk * 256 + r0; t1 = u.blk * 256 + r1; }
            else { const int* lp = LIST + (size_t)u.e * LCAP + u.blk * 256; t0 = r0 < u.rows ? (int)((unsigned)lp[r0] >> 16) : 0; t1 = r1 < u.rows ? (int)((unsigned)lp[r1] >> 16) : 0; }
            v[h][0] = (unsigned)(t0 * 1024 + C0 * 2); v[h][1] = (unsigned)(t1 * 1024 + C1 * 2);
        }
    }
};
using MoeOrder = MoeOrderT<false>;
struct EpiE1 {
    static constexpr bool PERM = true, KSCALE = false;
    unsigned char* H;
    __device__ __forceinline__ void operator()(const pg8::f32x4 (&acc)[2][2][4][2], const pg8::Unit& u, int wr, int wc, int fr_, int fq_) const {
        int t_ = threadIdx.x; asm volatile("" : "+v"(t_)); const int fr = t_ & 15, fq = (t_ >> 4) & 3; (void)fr_; (void)fq_;
        const int pnl = u.pn & 1; const int col0 = pnl * 128 + wc * 32 + 8 * fq;
        constexpr float KX = -LOG2E / SC_W13, CI = SC_W13 * SC_W13 / SC_H;
#pragma unroll
        for (int ai = 0; ai < 2; ++ai)
#pragma unroll
            for (int m = 0; m < 4; ++m) { const int r = ai * 128 + wr * 64 + m * 16 + fr;
                const pg8::f32x4 a0 = acc[ai][0][m][0], a1 = acc[ai][0][m][1], b0 = acc[ai][1][m][0], b1 = acc[ai][1][m][1];
                const pg8::f32x4 x0 = a0 * KX, x1 = a1 * KX, t0 = a0 * b0, t1 = a1 * b1;
                pg8::f32x4 e0, e1;
#pragma unroll
                for (int i = 0; i < 4; ++i) { e0[i] = __builtin_amdgcn_exp2f(x0[i]); e1[i] = __builtin_amdgcn_exp2f(x1[i]); }
                const pg8::f32x4 d0 = e0 * CI + CI, d1 = e1 * CI + CI;
                pg8::f32x4 r0, r1;
#pragma unroll
                for (int i = 0; i < 4; ++i) { r0[i] = __builtin_amdgcn_rcpf(d0[i]); r1[i] = __builtin_amdgcn_rcpf(d1[i]); }
                const pg8::f32x4 h0 = t0 * r0, h1 = t1 * r1;
                *(GAS v2u*)(H + ((size_t)u.pm * 256 + r) * 256 + col0) = (v2u){pk4_fp8(h0[0], h0[1], h0[2], h0[3]), pk4_fp8(h1[0], h1[1], h1[2], h1[3])}; }
    }
};
struct EpiE2 {
    static constexpr bool PERM = true, KSCALE = false;
    unsigned char* Y8; bf16* YS; const LAS int* etab;
    __device__ __forceinline__ void operator()(const pg8::f32x4 (&acc)[2][2][4][2], const pg8::Unit& u, int wr, int wc, int fr_, int fq_) const {
        int t_ = threadIdx.x; asm volatile("" : "+v"(t_)); const int fr = t_ & 15, fq = (t_ >> 4) & 3; (void)fr_; (void)fq_;
        const int pnl = u.pn & 3; const int col0 = pnl * 256 + wc * 32 + 8 * fq;
#pragma unroll
        for (int ai = 0; ai < 2; ++ai)
#pragma unroll
            for (int m = 0; m < 4; ++m) { const int r = ai * 128 + wr * 64 + m * 16 + fr;
                if (r < u.rows) {
                    if (u.e == NE) { bf16* dst = YS + ((size_t)u.blk * 256 + r) * 1024;
#pragma unroll
                        for (int bj = 0; bj < 2; ++bj) { const pg8::f32x4 v0 = acc[ai][bj][m][0] * (1.f / (SC_W2 * SC_H)), v1 = acc[ai][bj][m][1] * (1.f / (SC_W2 * SC_H));
                            *(GAS v4u*)(dst + col0 + bj * 128) = (v4u){pg8::cvt_pk_bf16(v0[0], v0[1]), pg8::cvt_pk_bf16(v0[2], v0[3]), pg8::cvt_pk_bf16(v1[0], v1[1]), pg8::cvt_pk_bf16(v1[2], v1[3])}; }
                    } else { const unsigned ent = (unsigned)etab[(u.slot & 255) * 256 + r]; unsigned char* dst = Y8 + (size_t)(ent >> 13) * 1024; const float w = (float)(ent & 8191u) * (16.f * 2.5f / 8191.f / (SC_W2 * SC_H));
                        unsigned q[4];
#pragma unroll
                        for (int bj = 0; bj < 2; ++bj) { const pg8::f32x4 v0 = acc[ai][bj][m][0] * w, v1 = acc[ai][bj][m][1] * w;
                            int w0 = 0, w1 = 0; w0 = __builtin_amdgcn_cvt_pk_fp8_f32(v0[0], v0[1], w0, false); w0 = __builtin_amdgcn_cvt_pk_fp8_f32(v0[2], v0[3], w0, true);
                            w1 = __builtin_amdgcn_cvt_pk_fp8_f32(v1[0], v1[1], w1, false); w1 = __builtin_amdgcn_cvt_pk_fp8_f32(v1[2], v1[3], w1, true);
                            q[2 * bj] = (unsigned)w0; q[2 * bj + 1] = (unsigned)w1; }
                        __builtin_nontemporal_store((v4u){q[0], q[1], q[2], q[3]}, (GAS v4u*)(dst + pnl * 256 + wc * 64 + fq * 16));
                    }
                } }
    }
};
struct EpiInProj {
    static constexpr bool PERM = true, KSCALE = false;
    bf16 *PROJ, *VA, *QB, *KB, *VB;
    __device__ __forceinline__ void operator()(const pg8::f32x4 (&acc)[2][2][4][2], const pg8::Unit& u, int wr, int wc, int fr_, int fq_) const {
        int t_ = threadIdx.x; asm volatile("" : "+v"(t_)); const int fr = t_ & 15, fq = (t_ >> 4) & 3; (void)fr_; (void)fq_;
        const int row0 = u.pm * 256 + wr * 64 + fr;
#pragma unroll
        for (int bj = 0; bj < 2; ++bj) {
            const int cg = u.pn * 256 + bj * 128 + wc * 32;
            bf16* base; int pitch, cc; float sc = 1.f;
            if (cg < 512 || cg >= 1280) { base = PROJ; pitch = IN_WP; cc = cg; }
            else if (cg < 640) { base = VA; pitch = 128; cc = cg - 512; }
            else if (cg < 1024) { base = QB; pitch = 384; cc = cg - 640; sc = C2A; }
            else if (cg < 1152) { base = KB; pitch = 128; cc = cg - 1024; }
            else { base = VB; pitch = 128; cc = cg - 1152; }
#pragma unroll
            for (int ai = 0; ai < 2; ++ai)
#pragma unroll
                for (int m = 0; m < 4; ++m) { const pg8::f32x4 v0 = acc[ai][bj][m][0] * sc, v1 = acc[ai][bj][m][1] * sc;
                    *(GAS v4u*)(base + (size_t)(row0 + ai * 128 + m * 16) * pitch + cc + 8 * fq) = (v4u){pg8::cvt_pk_bf16(v0[0], v0[1]), pg8::cvt_pk_bf16(v0[2], v0[3]), pg8::cvt_pk_bf16(v1[0], v1[1]), pg8::cvt_pk_bf16(v1[2], v1[3])}; }
        }
    }
};
struct EpiCup {
    static constexpr bool PERM = false, KSCALE = false;
    bf16* QC; bf16* KC; bf16* VC; const float* TC; const float* TS;
    __device__ __forceinline__ void operator()(const pg8::f32x4 (&acc)[2][2][4][2], const pg8::Unit& u, int wr, int wc, int fr_, int fq_) const {
        int t_ = threadIdx.x; asm volatile("" : "+v"(t_)); const int fr = t_ & 15, fq = (t_ >> 4) & 3; (void)fr_; (void)fq_;
#pragma unroll
        for (int bj = 0; bj < 2; ++bj) {
            const int cg = u.pn * 256 + bj * 128 + wc * 32;
            if (cg >= 896) continue;
            const bool rope = cg < 384 && (cg % 96) == 64;
#pragma unroll
            for (int ai = 0; ai < 2; ++ai) {
                pg8::f32x4 cs[4], sn[4];
                if (rope) {
#pragma unroll
                    for (int m = 0; m < 4; ++m) { const int pos = (u.pm * 256 + ai * 128 + wr * 64 + m * 16 + fr) & (SEQ - 1); cs[m] = *(const pg8::f32x4*)(TC + pos * 16 + 4 * fq); sn[m] = *(const pg8::f32x4*)(TS + pos * 16 + 4 * fq); } }
#pragma unroll
                for (int m = 0; m < 4; ++m) { const int row = u.pm * 256 + ai * 128 + wr * 64 + m * 16 + fr;
                    pg8::f32x4 v0 = acc[ai][bj][m][0], v1 = acc[ai][bj][m][1];
                    bf16* dst;
                    if (cg < 384) {
                        if (rope) { const pg8::f32x4 x1 = v0, x2 = v1; v0 = x1 * cs[m] - x2 * sn[m]; v1 = x1 * sn[m] + x2 * cs[m]; }
                        v0 = v0 * C2C; v1 = v1 * C2C; dst = QC + (size_t)row * 384 + cg;
                    } else if (cg < 640) { const int j = cg - 384; dst = KC + (size_t)row * 384 + (j >> 6) * 96 + (j & 63); }
                    else dst = VC + (size_t)row * 256 + (cg - 640);
                    *(GAS v2u*)(dst + 4 * fq) = (v2u){pg8::cvt_pk_bf16(v0[0], v0[1]), pg8::cvt_pk_bf16(v0[2], v0[3])};
                    *(GAS v2u*)(dst + 16 + 4 * fq) = (v2u){pg8::cvt_pk_bf16(v1[0], v1[1]), pg8::cvt_pk_bf16(v1[2], v1[3])}; }
            }
        }
    }
};
constexpr int RS_OFF = LDSCTL_OFF + 4096;
template <bool SRC_F32> struct EpiOutT {
    static constexpr bool PERM = true, KSCALE = true; static constexpr int KS_MID = 3, KS_TOP = 6;
    const void* Xs; bf16* Xd; const float* modv; const LAS float* rs;
    __device__ __forceinline__ void kscale(pg8::f32x4 (&acc)[2][2][4][2], const pg8::Unit& u, int which, int wr) const {
        int t_ = threadIdx.x; asm volatile("" : "+v"(t_)); const int fr = t_ & 15;
#pragma unroll
        for (int ai = 0; ai < 2; ++ai)
#pragma unroll
            for (int m = 0; m < 4; ++m) { const float f = rs[(u.slot * 256 + ai * 128 + wr * 64 + m * 16 + fr) * 3 + which];
#pragma unroll
                for (int bj = 0; bj < 2; ++bj)
#pragma unroll
                    for (int n = 0; n < 2; ++n) acc[ai][bj][m][n] = acc[ai][bj][m][n] * f; }
    }
    __device__ __forceinline__ void operator()(const pg8::f32x4 (&acc)[2][2][4][2], const pg8::Unit& u, int wr, int wc, int fr_, int fq_) const {
        int t_ = threadIdx.x; asm volatile("" : "+v"(t_)); const int fr = t_ & 15, fq = (t_ >> 4) & 3; (void)fr_; (void)fq_;
        const int row0 = u.pm * 256 + wr * 64 + fr, col0 = u.pn * 256 + wc * 32 + 8 * fq; const int b = (u.pm * 256) >> 13;
        const float* g1 = modv + (size_t)(b * 6 + 2) * 1024 + col0;
        pg8::f32x4 gv[2][2];
#pragma unroll
        for (int bj = 0; bj < 2; ++bj)
#pragma unroll
            for (int n = 0; n < 2; ++n) gv[bj][n] = *(const pg8::f32x4*)(g1 + bj * 128 + n * 4);
#pragma unroll
        for (int am = 0; am < 4; ++am) {
            const int ai = am >> 1, mb = (am & 1) * 2;
            pg8::f32x4 x0[2][2], x1[2][2];
#pragma unroll
            for (int mm = 0; mm < 2; ++mm) { const int m = mb + mm; const size_t off = (size_t)(row0 + ai * 128 + m * 16) * 1024 + col0;
#pragma unroll
                for (int bj = 0; bj < 2; ++bj) {
                    if constexpr (SRC_F32) { const float* xp = (const float*)Xs + off + bj * 128; x0[mm][bj] = __builtin_nontemporal_load((const GAS pg8::f32x4*)xp); x1[mm][bj] = __builtin_nontemporal_load((const GAS pg8::f32x4*)(xp + 4)); }
                    else { const v4u w = *(const GAS v4u*)((const bf16*)Xs + off + bj * 128); x0[mm][bj] = (pg8::f32x4){bflo(w.x), bfhi(w.x), bflo(w.y), bfhi(w.y)}; x1[mm][bj] = (pg8::f32x4){bflo(w.z), bfhi(w.z), bflo(w.w), bfhi(w.w)}; } } }
#pragma unroll
            for (int mm = 0; mm < 2; ++mm) { const int m = mb + mm; const size_t off = (size_t)(row0 + ai * 128 + m * 16) * 1024 + col0;
                const float f3 = rs[(u.slot * 256 + ai * 128 + wr * 64 + m * 16 + fr) * 3 + 2];
#pragma unroll
                for (int bj = 0; bj < 2; ++bj) {
                    const pg8::f32x4 y0 = x0[mm][bj] + gv[bj][0] * (acc[ai][bj][m][0] * f3), y1 = x1[mm][bj] + gv[bj][1] * (acc[ai][bj][m][1] * f3);
                    *(GAS v4u*)(Xd + off + bj * 128) = (v4u){pg8::cvt_pk_bf16(y0[0], y0[1]), pg8::cvt_pk_bf16(y0[2], y0[3]), pg8::cvt_pk_bf16(y1[0], y1[1]), pg8::cvt_pk_bf16(y1[2], y1[3])}; } }
        }
    }
};

__device__ __forceinline__ void attention_phase(const Ctx& c, int l) {
    unsigned char* ws = c.ws;
    const bf16 *QA = (const bf16*)(ws + WS_QA), *KA = (const bf16*)(ws + WS_KA), *VA = (const bf16*)(ws + WS_VA), *QB = (const bf16*)(ws + WS_QB), *KB = (const bf16*)(ws + WS_KB), *VB = (const bf16*)(ws + WS_VB);
    const bf16 *QC = (const bf16*)(ws + WS_QC), *KC = (const bf16*)(ws + WS_KC), *VC = (const bf16*)(ws + WS_VC); unsigned char* MIX8 = ws + WS_MIX;
    const float* sink = kargs()->in[I_BSINK] + l * 6; float* SSQ = (float*)(c.ws + WS_SSQ);
    for (int rep_ = 0; rep_ < NREP(16); ++rep_)
    for (int L = c.vcu; L < NBATCH * 6 * 32; L += c.G) {
        const int qb = L & 31, ph = L >> 5, idx = (ph & 7) * 6 + (ph >> 3), b = idx / 6, hq = idx % 6, kvh = hq / 3; const size_t rb = (size_t)b * SEQ;
        tat::unit<8, 384, 128, 128, 1024, SC_MIXA>((const tat::bf16*)(QA + rb * 384 + hq * 64), (const tat::bf16*)(KA + rb * 128 + kvh * 64), (const tat::bf16*)(VA + rb * 128 + kvh * 64), MIX8 + rb * 1024 + hq * 64, SSQ + rb * 16 + hq, qb * 256, (LAS char*)c.lds,
            [&]() { if (rep_ == 0) { const int nA = (NBATCH * 6 * 32 - c.vcu + c.G - 1) / c.G, nC = (NBATCH * 4 * 32 - c.vcu + c.G - 1) / c.G; convert_experts_part(c, l, (L - c.vcu) / c.G, nA + nC); } });
    }
    for (int rep_ = 0; rep_ < NREP(17); ++rep_)
    for (int L = c.vcu; L < NBATCH * 4 * 32; L += c.G) {
        const int qb = L & 31, ph = L >> 5, idx = (ph & 7) * 4 + (ph >> 3), b = idx >> 2, h = idx & 3; const size_t rb = (size_t)b * SEQ;
        tat::unit96<8, 384, 384, 256, 1024, SC_MIXC>((const tat::bf16*)(QC + rb * 384 + h * 96), (const tat::bf16*)(KC + rb * 384 + h * 96), (const tat::bf16*)(VC + rb * 256 + h * 64), MIX8 + rb * 1024 + 768 + h * 64, SSQ + rb * 16 + 12 + h, qb * 256, (LAS char*)c.lds,
            [&]() { if (rep_ == 0) { const int nA = (NBATCH * 6 * 32 - c.vcu + c.G - 1) / c.G, nC = (NBATCH * 4 * 32 - c.vcu + c.G - 1) / c.G; convert_experts_part(c, l, nA + (L - c.vcu) / c.G, nA + nC); } });
    }
    for (int rep_ = 0; rep_ < NREP(18); ++rep_)
    for (int L = c.vcu; L < NBATCH * 6 * 32; L += c.G) {
        const int qb = L & 31, ph = L >> 5, idx = (ph & 7) * 6 + (ph >> 3), b = idx / 6, hq = idx % 6, kvh = hq / 3; const size_t rb = (size_t)b * SEQ;
        const int t_lo = (4 * qb - 2) < 0 ? 0 : 4 * qb - 2, t_hi = (4 * qb + 6) > SEQ / 64 ? SEQ / 64 : 4 * qb + 6;
        const float slope2 = exp2f(-8.f * (float)(hq + 1) / 6.f) * LOG2E, sink2 = sink[hq] * LOG2E;
        tat::unitB<8, 384, 128, 128, 1024, SC_MIXB>((const tat::bf16*)(QB + rb * 384 + hq * 64), (const tat::bf16*)(KB + rb * 128 + kvh * 64), (const tat::bf16*)(VB + rb * 128 + kvh * 64), MIX8 + rb * 1024 + 384 + hq * 64, SSQ + rb * 16 + 6 + hq, qb * 256, t_lo, t_hi - t_lo, slope2, sink2, (LAS char*)c.lds);
    }
}

__global__ void __launch_bounds__(NTHREADS, 2) mega_fwd(Args args) {
    extern __shared__ __attribute__((aligned(16))) unsigned char lds_raw[];
    Ctx c;
#define NEWCTX() do { int t_ = threadIdx.x; asm volatile("" : "+v"(t_)); c.lds = (LAS unsigned char*)lds_raw; c.ws = kargs()->ws; c.tid = t_; c.lane = t_ & 63; c.wave = __builtin_amdgcn_readfirstlane(t_ >> 6); \
        c.G = gridDim.x; { const int bx = blockIdx.x; c.vcu = (c.G % 8 == 0) ? (bx % 8) * (c.G / 8) + bx / 8 : bx; } c.gw = c.vcu * NWAVES + c.wave; c.NGW = c.G * NWAVES; } while (0)
    NEWCTX();
    unsigned char* ws = c.ws;
    for (int u = c.tid; u < (LDS_BYTES - LDSCTL_OFF) / 4; u += NTHREADS) ((LAS unsigned*)(c.lds + LDSCTL_OFF))[u] = 0u;
    __syncthreads();
    const int lo = kargs()->ph_lo, hi = kargs()->ph_hi;
    const bool multi = (hi - lo) > 1;
    XcdBarrier bar; bar.bar = (unsigned*)(ws + WS_CTL) + CW_BAR; bar.x = 0; bar.st = nullptr;
    if (multi) bar = xcd_barrier_post((unsigned*)(ws + WS_CTL) + CW_BAR, (volatile LAS unsigned*)(c.lds + MISC_OFF) + 8);
#ifndef PH_MASK
#define PH_MASK 0x7fff
#endif
#define HAS(p) (((PH_MASK) >> (p)) & 1)

#define IN(k) (lo <= (k) && (k) < hi)
#define SEAM(k) do { if (IN(k) && IN((k) + 1)) { XcdBarrier b2_ = bar; asm volatile("" : "+s"(b2_.bar)); xcd_barrier(b2_); } } while (0)

    if (HAS(13) && IN(0)) for (int rep_ = 0; rep_ < NREP(13); ++rep_) { NEWCTX(); prologue(c); __syncthreads(); } SEAM(0);

    for (int l = 0; l < DEPTH; ++l) {
        const int P = 1 + PH_PER_LAYER * l;
#define MODV_L ((const float*)(c.ws + WS_MODV) + (size_t)l * 8 * 6144)
        if (l == 0) {
        if (HAS(0) && IN(P + 0)) for (int rep_ = 0; rep_ < NREP(0); ++rep_) { NEWCTX(); norm_mod_rows<true>(c, kargs()->in[I_X], (bf16*)(c.ws + WS_XN), nullptr, kargs()->in[I_N1G], MODV_L, 0, 1); }
        SEAM(P + 0); }
        if (HAS(1) && IN(P + 1)) for (int rep_ = 0; rep_ < NREP(1); ++rep_) { NEWCTX(); pg8::Gemm g{(const bf16*)(c.ws + WS_XN), (const bf16*)(c.ws + WS_WIN) + (size_t)l * IN_WP * 1024, M, IN_WP, 1024}; pg8::StaticOrder S; S.init(M, IN_WP, c.G, (int)blockIdx.x);
            EpiInProj E{(bf16*)(c.ws + WS_PROJ), (bf16*)(c.ws + WS_VA), (bf16*)(c.ws + WS_QB), (bf16*)(c.ws + WS_KB), (bf16*)(c.ws + WS_VB)}; pg8::gemm_phase<EpiInProj, pg8::StaticOrder, true, false>(c.lds, g, S, E); }
        SEAM(P + 1);
        if (HAS(2) && IN(P + 2)) for (int rep_ = 0; rep_ < NREP(2); ++rep_) { NEWCTX(); qkv_prep_rows(c, l); }
        SEAM(P + 2);
        if (HAS(3) && IN(P + 3)) for (int rep_ = 0; rep_ < NREP(3); ++rep_) { NEWCTX(); pg8::Gemm g{(const bf16*)(c.ws + WS_CQK), (const bf16*)(c.ws + WS_WC) + (size_t)l * 1024 * 384, M, 1024, 384}; pg8::StaticOrder S; S.init(M, 1024, c.G, (int)blockIdx.x);
            EpiCup E{(bf16*)(c.ws + WS_QC), (bf16*)(c.ws + WS_KC), (bf16*)(c.ws + WS_VC), (const float*)(c.ws + WS_TABC), (const float*)(c.ws + WS_TABS)}; pg8::gemm_phase<EpiCup, pg8::StaticOrder, true, false>(c.lds, g, S, E); }
        SEAM(P + 3);
        if (HAS(4) && IN(P + 4)) for (int rep_ = 0; rep_ < NREP(4); ++rep_) { NEWCTX(); attention_phase(c, l); }
        SEAM(P + 4);
        if (HAS(6) && IN(P + 6)) { NEWCTX(); pg8::Gemm g{(const bf16*)(c.ws + WS_MIX), (const bf16*)(c.ws + WS_WOUT + (size_t)l * 1024 * 1024), M, 1024, 1024};     pg8::StaticOrder S; S.init(M, 1024, c.G, (int)blockIdx.x);
            { LAS float* rs = (LAS float*)(c.lds + RS_OFF); const float* SSQ = (const float*)(c.ws + WS_SSQ); pg8::Unit u;
              for (int i = 0; i < 4 && S.next(i, u); ++i) if (c.tid < 256) { const f32x4* sp = (const f32x4*)(SSQ + (size_t)(u.pm * 256 + c.tid) * 16); const f32x4 a0 = sp[0], a1 = sp[1], a2 = sp[2], a3 = sp[3];
                  const float sA = (a0.x + a0.y) + (a0.z + a0.w) + (a1.x + a1.y), sB = (a1.z + a1.w) + (a2.x + a2.y) + (a2.z + a2.w), sC = (a3.x + a3.y) + (a3.z + a3.w);
                  const float rA = 1.f / sqrtf(sA * (1.f / 384.f) + EPS), rB = 1.f / sqrtf(sB * (1.f / 384.f) + EPS), rC = 1.f / sqrtf(sC * (1.f / 256.f) + EPS);
                  LAS float* w = rs + (i * 256 + c.tid) * 3; w[0] = rA / rB * ((float)SC_MIXB / (float)SC_MIXA); w[1] = rB / rC * ((float)SC_MIXC / (float)SC_MIXB); w[2] = rC * (1.f / (SC_WO * (float)SC_MIXC)); }
              __syncthreads(); }
            if (l == 0) { EpiOutT<true> E{kargs()->in[I_X], (bf16*)(c.ws + WS_XB), MODV_L, (const LAS float*)(c.lds + RS_OFF)}; pg8::gemm_phase<EpiOutT<true>, pg8::StaticOrder, true, false, true>(c.lds, g, S, E); }
            else { EpiOutT<false> E{c.ws + WS_XB, (bf16*)(c.ws + WS_XB), MODV_L, (const LAS float*)(c.lds + RS_OFF)}; pg8::gemm_phase<EpiOutT<false>, pg8::StaticOrder, true, false, true>(c.lds, g, S, E); } }
        SEAM(P + 6);
        if (HAS(7) && IN(P + 7)) { NEWCTX(); pg8::StaticOrder S; S.init(M, 256, c.G, (int)blockIdx.x);
            { pg8::Unit tu; for (int i = 0; S.next(i, tu); ++i) norm2_rows(c, (const bf16*)(c.ws + WS_XB), (bf16*)(c.ws + WS_XN), c.ws + WS_U2F, kargs()->in[I_N2G] + l * 1024, MODV_L, 3, 4, tu.pm * 256 + c.wave, NWAVES, tu.pm * 256 + 256); }
            VM_WAIT(); __syncthreads();
            { pg8::Gemm g{(const bf16*)(c.ws + WS_XN), (const bf16*)(c.ws + WS_WR) + (size_t)l * 256 * 1024, M, 256, 1024}; pg8::EpiF32 E{(float*)(c.ws + WS_LOGITS), 256}; pg8::gemm_phase<pg8::EpiF32, pg8::StaticOrder, true, false>(c.lds, g, S, E); }
            NEWCTX(); select_phase(c, l, false, &S); }
        SEAM(P + 9);
        if (HAS(10) && IN(P + 10)) for (int rep_ = 0; rep_ < NREP(10); ++rep_) { NEWCTX(); build_moe_tables(c, l); pg8::Gemm g{(const bf16*)(c.ws + WS_U2F), (const bf16*)(c.ws + WS_W13), M, NEX * 512, 1024}; MoeOrder S; S.init(c, 2, false);
            EpiE1 E{c.ws + WS_H}; pg8::gemm_phase<EpiE1, MoeOrder, true, true, true>(c.lds, g, S, E); }
        SEAM(P + 10);
        if (HAS(11) && IN(P + 11)) for (int rep_ = 0; rep_ < NREP(11); ++rep_) { NEWCTX(); build_moe_tables(c, l); pg8::Gemm g{(const bf16*)(c.ws + WS_H), (const bf16*)(c.ws + WS_W2), M, NEX * 1024, 256}; MoeOrderT<true> S; S.init(c, 4, true);
            EpiE2 E{(unsigned char*)(c.ws + WS_Y), (bf16*)(c.ws + WS_XN), (const LAS int*)(c.lds + ETAB_OFF)}; pg8::gemm_phase<EpiE2, MoeOrderT<true>, true, false, true>(c.lds, g, S, E); }
        SEAM(P + 11);
        if (HAS(12) && IN(P + 12)) for (int rep_ = 0; rep_ < NREP(12); ++rep_) { NEWCTX(); combine_rows(c, l, DRY(12)); }
        SEAM(P + 12);
    }
#undef MODV_L
#undef IN
#undef SEAM
}

#ifndef MK_ONE_LAUNCH
#define MK_ONE_LAUNCH 1
#endif
extern "C" void kernel_launch(void* const* d_in, const int* in_sizes, int n_in, void* d_out, int out_size, void* d_ws, size_t ws_size, hipStream_t stream) {
    static int grid = 0;
    if (grid == 0) {
        if (n_in != N_IN || out_size != M * D || ws_size < WS_SSQ + 4 * MiB) { fprintf(stderr, "kernel_launch: unexpected shapes (n_in %d, out %d, ws %zu)\n", n_in, out_size, ws_size); grid = -1; return; }
        int dev = 0, cus = 0, per_cu = 0;
        if (hipGetDevice(&dev) != hipSuccess || hipDeviceGetAttribute(&cus, hipDeviceAttributeMultiprocessorCount, dev) != hipSuccess) { grid = -1; return; }
        if (hipFuncSetAttribute((const void*)mega_fwd, hipFuncAttributeMaxDynamicSharedMemorySize, LDS_BYTES) != hipSuccess) { fprintf(stderr, "kernel_launch: hipFuncSetAttribute failed\n"); grid = -1; return; }
        if (hipOccupancyMaxActiveBlocksPerMultiprocessor(&per_cu, (const void*)mega_fwd, NTHREADS, LDS_BYTES) != hipSuccess || per_cu < 1) fprintf(stderr, "kernel_launch: occupancy query says %d\n", per_cu);
        (void)hipGetLastError();
        grid = cus;
    }
    if (grid < 0) return;
    if (hipMemsetAsync((char*)d_ws + WS_CTL, 0, CTL_ZERO_BYTES, stream) != hipSuccess) return;
    Args a{};
    for (int i = 0; i < N_IN; ++i) a.in[i] = (const float*)d_in[i];
    a.out = (float*)d_out; a.ws = (unsigned char*)d_ws;
#if MK_ONE_LAUNCH
    a.ph_lo = 0; a.ph_hi = N_PHASES;
    hipLaunchKernelGGL(mega_fwd, dim3(grid), dim3(NTHREADS), LDS_BYTES, stream, a);
#else
    for (int p = 0; p < N_PHASES; ++p) { a.ph_lo = p; a.ph_hi = p + 1; hipLaunchKernelGGL(mega_fwd, dim3(grid), dim3(NTHREADS), LDS_BYTES, stream, a); }
#endif
}
```
